# Optimizing an MI355X kernel written in HIP

```python
import jax, jax.numpy as jnp
from jax import lax
import numpy as np

D_MODEL = 1024
BATCH = 8
SEQ = 4096
DEPTH = 1

D_CONV = 512
CONV_WIDTH = 31
N_HEADS = 8
HEAD_DIM = 64
N_KV = 2
HPG = N_HEADS // N_KV
D_ATTN = N_HEADS * HEAD_DIM
D_KV = N_KV * HEAD_DIM
N_BRANCH = 3
D_IN = 2 * D_CONV + D_ATTN + 2 * N_BRANCH * D_KV + N_BRANCH * N_HEADS
CMP_BLOCK = 32
CMP_STRIDE = 16
CMP_HIDDEN = 256
SEL_BLOCK = 64
SEL_TOP = 16
WINDOW = 512
Q_CHUNK = 64
D_FF = 4 * D_MODEL
EPS = 1e-6
NEG = -1e30
FORCE = 1e30

kernel_name = "hymba_conformer_nsa_hybrid"


def rmsnorm(x, g):
    xf = x.astype(jnp.float32)
    y = xf * lax.rsqrt(jnp.mean(xf * xf, axis=-1, keepdims=True) + EPS)
    return (y * g.astype(jnp.float32)).astype(x.dtype)


def layernorm(x, g, b):
    xf = x.astype(jnp.float32)
    mu = jnp.mean(xf, axis=-1, keepdims=True)
    var = jnp.mean(jnp.square(xf - mu), axis=-1, keepdims=True)
    y = (xf - mu) * lax.rsqrt(var + EPS)
    return (y * g.astype(jnp.float32) + b.astype(jnp.float32)).astype(x.dtype)


def alibi_slopes(n):
    return jnp.exp2(-8.0 * jnp.arange(1, n + 1, dtype=jnp.float32) / n)


def conformer_conv(u_val, u_gate, dw_w, dw_b, ln_g, ln_b):
    u = u_val * jax.nn.sigmoid(u_gate)
    y = lax.conv_general_dilated(
        u, dw_w.astype(u.dtype), window_strides=(1,), padding=[(CONV_WIDTH - 1, 0)],
        dimension_numbers=("NWC", "WIO", "NWC"), feature_group_count=D_CONV) + dw_b
    y = layernorm(y, ln_g, ln_b)
    return jax.nn.silu(y)


def compress(kv, pe, w1, w2):
    B, G, T, dh = kv.shape
    ch = kv.reshape(B, G, T // CMP_STRIDE, CMP_STRIDE, dh)
    blocks = jnp.concatenate([ch[:, :, :-1], ch[:, :, 1:]], axis=3) + pe
    flat = blocks.reshape(B, G, blocks.shape[2], CMP_BLOCK * dh)
    return jax.nn.gelu(flat @ w1) @ w2


def nsa_attention(q, k_cmp, v_cmp, k_sel, v_sel, k_win, v_win, gates,
                  ck_pe, ck_w1, ck_w2, cv_pe, cv_w1, cv_w2):
    B, G, _, T, dh = q.shape
    n_chunks = T // Q_CHUNK
    n_sel = T // SEL_BLOCK
    n_top = min(SEL_TOP, n_sel)
    kc = compress(k_cmp, ck_pe, ck_w1, ck_w2)
    vc = compress(v_cmp, cv_pe, cv_w1, cv_w2)
    n_cmp = kc.shape[2]
    c_idx = jnp.arange(n_cmp)
    cmp_pos = c_idx * CMP_STRIDE + (CMP_BLOCK - 1)
    j_idx = jnp.arange(n_sel)
    overlap = ((c_idx[:, None] * CMP_STRIDE < (j_idx[None, :] + 1) * SEL_BLOCK)
               & (c_idx[:, None] * CMP_STRIDE + CMP_BLOCK > j_idx[None, :] * SEL_BLOCK)
               ).astype(jnp.float32)
    kb = k_sel.reshape(B, G, n_sel, SEL_BLOCK, dh)
    vb = v_sel.reshape(B, G, n_sel, SEL_BLOCK, dh)
    kw = jnp.pad(k_win, ((0, 0), (0, 0), (WINDOW, 0), (0, 0)))
    vw = jnp.pad(v_win, ((0, 0), (0, 0), (WINDOW, 0), (0, 0)))
    slopes = alibi_slopes(N_HEADS).reshape(1, G, HPG, 1, 1)
    scale = HEAD_DIM ** -0.5
    bi = jnp.arange(B)[:, None, None, None]
    gi = jnp.arange(G)[None, :, None, None]

    def chunk(ci):
        q0 = ci * Q_CHUNK
        qc = lax.dynamic_slice_in_dim(q, q0, Q_CHUNK, axis=3) * scale
        gc = lax.dynamic_slice_in_dim(gates, q0, Q_CHUNK, axis=3)
        t = q0 + jnp.arange(Q_CHUNK)

        s = jnp.einsum("bghqd,bgcd->bghqc", qc, kc).astype(jnp.float32)
        dist = (t[:, None] - cmp_pos[None, :]).astype(jnp.float32)
        valid = dist >= 0
        s = jnp.where(valid, s - slopes * dist, NEG)
        p_cmp = jnp.where(valid, jax.nn.softmax(s, axis=-1), 0.0)
        o_cmp = jnp.einsum("bghqc,bgcd->bghqd", p_cmp, vc.astype(jnp.float32))

        imp = jnp.einsum("bghqc,cj->bgqj", p_cmp, overlap)
        jt = t // SEL_BLOCK
        future = j_idx[None, :] > jt[:, None]
        forced = ((j_idx[None, :] == 0) | (j_idx[None, :] == jt[:, None])
                  | (j_idx[None, :] == jt[:, None] - 1))
        imp = jnp.where(forced, FORCE, jnp.where(future, NEG, imp))
        _, idx = lax.top_k(imp, n_top)
        ks = kb[bi, gi, idx]
        vs = vb[bi, gi, idx]
        s_pos = idx[..., None] * SEL_BLOCK + jnp.arange(SEL_BLOCK)
        d = (t[None, None, :, None, None] - s_pos)[:, :, None].astype(jnp.float32)
        s = jnp.einsum("bghqd,bgqnkd->bghqnk", qc, ks).astype(jnp.float32)
        s = jnp.where(d >= 0, s - slopes[..., None] * d, NEG)
        s = s.reshape(B, G, HPG, Q_CHUNK, n_top * SEL_BLOCK)
        p_sel = jax.nn.softmax(s, axis=-1)
        o_sel = jnp.einsum("bghqm,bgqmd->bghqd", p_sel,
                           vs.reshape(B, G, Q_CHUNK, n_top * SEL_BLOCK, dh).astype(jnp.float32))

        kwc = lax.dynamic_slice_in_dim(kw, q0, WINDOW + Q_CHUNK, axis=2)
        vwc = lax.dynamic_slice_in_dim(vw, q0, WINDOW + Q_CHUNK, axis=2)
        w_pos = q0 - WINDOW + jnp.arange(WINDOW + Q_CHUNK)
        dw = (t[:, None] - w_pos[None, :]).astype(jnp.float32)
        valid_w = (dw >= 0) & (dw < WINDOW) & (w_pos >= 0)[None, :]
        s = jnp.einsum("bghqd,bgkd->bghqk", qc, kwc).astype(jnp.float32)
        s = jnp.where(valid_w, s - slopes * dw, NEG)
        p_win = jax.nn.softmax(s, axis=-1)
        o_win = jnp.einsum("bghqk,bgkd->bghqd", p_win, vwc.astype(jnp.float32))

        gf = gc.astype(jnp.float32)
        o = gf[..., 0:1] * o_cmp + gf[..., 1:2] * o_sel + gf[..., 2:3] * o_win
        return o.astype(q.dtype)

    outs = lax.map(chunk, jnp.arange(n_chunks))
    return outs.transpose(1, 0, 4, 2, 3, 5).reshape(B, T, N_HEADS * HEAD_DIM)


def hybrid_layer(x, norm1_g, w_in, dw_w, dw_b, cln_g, cln_b, ck_pe, ck_w1, ck_w2,
                 cv_pe, cv_w1, cv_w2, w_out, norm2_g, w_ff1, w_ff2):
    B, T, _ = x.shape
    h = rmsnorm(x, norm1_g)
    z = h @ w_in
    o1 = D_CONV
    o2 = 2 * D_CONV
    o3 = o2 + D_ATTN
    o4 = o3 + 2 * N_BRANCH * D_KV
    u_val, u_gate, q, kv, g = z[..., :o1], z[..., o1:o2], z[..., o2:o3], z[..., o3:o4], z[..., o4:]
    kv = kv.reshape(B, T, 2 * N_BRANCH, N_KV, HEAD_DIM).transpose(2, 0, 3, 1, 4)
    q = q.reshape(B, T, N_KV, HPG, HEAD_DIM).transpose(0, 2, 3, 1, 4)
    g = jax.nn.sigmoid(g).reshape(B, T, N_KV, HPG, N_BRANCH).transpose(0, 2, 3, 1, 4)
    conv_out = conformer_conv(u_val, u_gate, dw_w, dw_b, cln_g, cln_b)
    attn_out = nsa_attention(q, kv[0], kv[1], kv[2], kv[3], kv[4], kv[5], g,
                             ck_pe, ck_w1, ck_w2, cv_pe, cv_w1, cv_w2)
    x = x + jnp.concatenate([conv_out, attn_out], axis=-1) @ w_out
    h = rmsnorm(x, norm2_g)
    x = x + jnp.square(jax.nn.relu(h @ w_ff1)) @ w_ff2
    return x


def setup_inputs(seed: int = 0) -> dict:
    key = jax.random.key(seed)
    ks = jax.random.split(key, 20)
    L = DEPTH
    nrm = lambda k, shape, s: jax.random.normal(k, shape, jnp.float32) * s
    return {
        "x": jax.random.normal(ks[0], (BATCH, SEQ, D_MODEL), jnp.float32),
        "norm1_g": 1.0 + nrm(ks[1], (L, D_MODEL), 0.01),
        "w_in": nrm(ks[2], (L, D_MODEL, D_IN), D_MODEL ** -0.5),
        "dw_w": nrm(ks[3], (L, CONV_WIDTH, 1, D_CONV), CONV_WIDTH ** -0.5),
        "dw_b": nrm(ks[4], (L, D_CONV), 0.01),
        "cln_g": 1.0 + nrm(ks[5], (L, D_CONV), 0.01),
        "cln_b": nrm(ks[6], (L, D_CONV), 0.01),
        "ck_pe": nrm(ks[7], (L, CMP_BLOCK, HEAD_DIM), 0.1),
        "ck_w1": nrm(ks[8], (L, CMP_BLOCK * HEAD_DIM, CMP_HIDDEN), (CMP_BLOCK * HEAD_DIM) ** -0.5),
        "ck_w2": nrm(ks[9], (L, CMP_HIDDEN, HEAD_DIM), CMP_HIDDEN ** -0.5),
        "cv_pe": nrm(ks[10], (L, CMP_BLOCK, HEAD_DIM), 0.1),
        "cv_w1": nrm(ks[11], (L, CMP_BLOCK * HEAD_DIM, CMP_HIDDEN), (CMP_BLOCK * HEAD_DIM) ** -0.5),
        "cv_w2": nrm(ks[12], (L, CMP_HIDDEN, HEAD_DIM), CMP_HIDDEN ** -0.5),
        "w_out": nrm(ks[13], (L, D_CONV + D_ATTN, D_MODEL), (D_CONV + D_ATTN) ** -0.5),
        "norm2_g": 1.0 + nrm(ks[14], (L, D_MODEL), 0.01),
        "w_ff1": nrm(ks[15], (L, D_MODEL, D_FF), D_MODEL ** -0.5),
        "w_ff2": nrm(ks[16], (L, D_FF, D_MODEL), D_FF ** -0.5),
        "norm_f_g": 1.0 + nrm(ks[17], (D_MODEL,), 0.01),
    }


def reference(x, norm1_g, w_in, dw_w, dw_b, cln_g, cln_b, ck_pe, ck_w1, ck_w2,
              cv_pe, cv_w1, cv_w2, w_out, norm2_g, w_ff1, w_ff2, norm_f_g):
    for l in range(DEPTH):
        x = hybrid_layer(x, norm1_g[l], w_in[l], dw_w[l], dw_b[l], cln_g[l], cln_b[l],
                         ck_pe[l], ck_w1[l], ck_w2[l], cv_pe[l], cv_w1[l], cv_w2[l],
                         w_out[l], norm2_g[l], w_ff1[l], w_ff2[l])
    return rmsnorm(x, norm_f_g)
```

```cpp
#include <hip/hip_runtime.h>
#include <hip/hip_cooperative_groups.h>
#include <cstdio>
namespace cg = cooperative_groups;

#define LAS __attribute__((address_space(3)))
#define DI __device__ __forceinline__
typedef unsigned short bf16_t;
typedef short bf16x8 __attribute__((ext_vector_type(8)));
typedef short s16x4 __attribute__((ext_vector_type(4)));
typedef float f32x4 __attribute__((ext_vector_type(4)));
typedef float f32x2 __attribute__((ext_vector_type(2)));
typedef float f32x16 __attribute__((ext_vector_type(16)));
typedef unsigned u32x4 __attribute__((ext_vector_type(4)));
typedef unsigned u32x2 __attribute__((ext_vector_type(2)));
typedef __bf16 bf16v2 __attribute__((ext_vector_type(2)));

constexpr float LOG2E = 1.4426950408889634f;
constexpr float EPSN = 1e-6f;
constexpr int LDS_BYTES = 147456;
constexpr int MTOK = 32768, TSEQ = 4096, DM = 1024, DFF = 4096;
constexpr float QSCALE = 0.125f * LOG2E;

constexpr size_t MiB = 1024 * 1024;
constexpr size_t XCD_BAR_WORDS_C = 3456;
constexpr size_t OFF_WIN = 0;
constexpr size_t OFF_WOUT = OFF_WIN + 2560 * 1024 * 2;
constexpr size_t OFF_WFF1 = OFF_WOUT + 1024 * 1024 * 2;
constexpr size_t OFF_WFF2 = OFF_WFF1 + 4096 * 1024 * 2;
constexpr size_t OFF_CW1 = OFF_WFF2 + 4096 * 1024 * 2;
constexpr size_t OFF_CW2 = OFF_CW1 + 2 * 256 * 2048 * 2;
constexpr size_t OFF_CB1 = OFF_CW2 + 2 * 64 * 256 * 2;
constexpr size_t OFF_RS1 = OFF_CB1 + 2 * 256 * 4;
constexpr size_t OFF_SSQ2 = OFF_RS1 + MTOK * 4;
constexpr size_t OFF_SSQ3 = OFF_SSQ2 + MTOK * 4;
constexpr size_t OFF_GATES = OFF_SSQ3 + MTOK * 4;
constexpr size_t OFF_KC = OFF_GATES + (size_t)MTOK * 24 * 4;
constexpr size_t OFF_VC = OFF_KC + 16 * 256 * 64 * 2;
constexpr size_t OFF_BAR = OFF_VC + 16 * 256 * 64 * 2;
constexpr size_t OFF_PCNT = OFF_BAR + XCD_BAR_WORDS_C * 4;
constexpr size_t OFF_QCNT = OFF_PCNT + 256 * 256;
constexpr size_t OFF_B = 30 * MiB;
constexpr size_t OFF_H = 94 * MiB;
constexpr size_t OFF_XB = OFF_H;
constexpr size_t OFF_Q = OFF_H + 64 * MiB;
constexpr size_t OFF_KV = OFF_H + 96 * MiB;
constexpr size_t OFF_CAT = OFF_H + 256 * MiB;
constexpr size_t WS_END = OFF_CAT + 64 * MiB;
static_assert(OFF_QCNT + 8 * 256 <= OFF_B, "ws map");

struct Params {
  const float* x; const float* norm1_g; const float* w_in; const float* dw_w; const float* dw_b; const float* cln_g; const float* cln_b;
  const float* ck_pe; const float* ck_w1; const float* ck_w2; const float* cv_pe; const float* cv_w1; const float* cv_w2;
  const float* w_out; const float* norm2_g; const float* w_ff1; const float* w_ff2; const float* norm_f_g;
  float* out; unsigned char* ws;
};

DI unsigned pk2(float a, float b) { f32x2 v = {a, b}; bf16v2 r = __builtin_convertvector(v, bf16v2); return __builtin_bit_cast(unsigned, r); }
DI float bf2f(unsigned short u) { return __uint_as_float((unsigned)u << 16); }
DI float sigmoidf_(float v) { return __builtin_amdgcn_rcpf(1.0f + __builtin_amdgcn_exp2f(-v * LOG2E)); }
DI float gelu_tanh(float v) { const float u = 0.7978845608028654f * (v + 0.044715f * v * v * v); const float e = __builtin_amdgcn_exp2f(2.0f * LOG2E * u); const float th = 1.0f - 2.0f * __builtin_amdgcn_rcpf(e + 1.0f); return 0.5f * v * (1.0f + th); }
DI float wave_sum(float v) { v += __shfl_xor(v, 1); v += __shfl_xor(v, 2); v += __shfl_xor(v, 4); v += __shfl_xor(v, 8); v += __shfl_xor(v, 16); v += __shfl_xor(v, 32); return v; }

DI void st_nt(u32x4* p, u32x4 v) { __builtin_nontemporal_store(v, p); }
DI void st_nt(f32x4* p, f32x4 v) { __builtin_nontemporal_store(v, p); }
DI int get_tid() { int t = threadIdx.x; asm volatile("" : "+v"(t)); return t; }

#define XB_TMO      128
#define XB_XCNT(j)  (256  + 64 * (j))
#define XB_XSUB(j)  (1280 + 64 * (j))
#define XB_XGEN(j)  (2304 + 64 * (j))
#define XB_TOP      3328
#define XB_TOPGEN   3392
#define XCD_BAR_WORDS 3456
#define XB_SPIN_CAP (1u << 22)
DI unsigned xb_ld(unsigned* p) { return __hip_atomic_load(p, __ATOMIC_RELAXED, __HIP_MEMORY_SCOPE_AGENT); }
DI unsigned xb_add(unsigned* p, unsigned v) { return __hip_atomic_fetch_add(p, v, __ATOMIC_RELAXED, __HIP_MEMORY_SCOPE_AGENT); }
DI unsigned xb_xcc_id() { return (unsigned)__builtin_amdgcn_s_getreg((3 << 11) | 20) & 0xFu; }
#define XB_SPIN(cond, bar) do { unsigned _sp = 0; while (cond) { __builtin_amdgcn_s_sleep(1); \
    if ((++_sp & 255u) == 0u) { if (xb_ld(&(bar)[XB_TMO])) break; if (_sp > XB_SPIN_CAP) { atomicAdd(&(bar)[XB_TMO], 1u); break; } } } } while (0)
struct XcdBarrier { unsigned* bar; unsigned x; volatile LAS unsigned* st; };
DI XcdBarrier xcd_barrier_post(unsigned* bar, volatile LAS unsigned* st) {
  XcdBarrier b; b.bar = bar; b.x = xb_xcc_id(); b.st = st;
  if (threadIdx.x == 0) (void)xb_add(&bar[XB_XCNT(b.x)], 1u);
  return b;
}
DI void xcd_barrier_complete(unsigned* bar, unsigned x, unsigned& nloc, unsigned& nx) {
  const unsigned G = gridDim.x;
  unsigned sum, cnt, mine, sp = 0u;
  for (;;) {
    sum = 0u; cnt = 0u; mine = 0u;
#pragma unroll
    for (unsigned j = 0; j < 16; ++j) { const unsigned c = xb_ld(&bar[XB_XCNT(j)]); sum += c; cnt += (c > 0u) ? 1u : 0u; mine = (j == x) ? c : mine; }
    if (sum == G) break;
    __builtin_amdgcn_s_sleep(1);
    if ((++sp & 255u) == 0u) { if (xb_ld(&bar[XB_TMO])) break; if (sp > XB_SPIN_CAP) { atomicAdd(&bar[XB_TMO], 1u); break; } }
  }
  nloc = mine > 0u ? mine : 1u; nx = cnt > 0u ? cnt : 1u;
}
DI void xcd_barrier(const XcdBarrier& b) {
  asm volatile("s_waitcnt vmcnt(0)" ::: "memory");
  __syncthreads();
  if (threadIdx.x == 0) {
    unsigned* bar = b.bar;
    __builtin_amdgcn_s_waitcnt(0);
    unsigned nloc = b.st[0], nx = b.st[1];
    if (nloc == 0u) { xcd_barrier_complete(bar, b.x, nloc, nx); b.st[0] = nloc; b.st[1] = nx; }
    const unsigned old = xb_add(&bar[XB_XSUB(b.x)], 1u);
    const unsigned gen = old / nloc;
    if (old + 1u == (gen + 1u) * nloc) {
      __builtin_amdgcn_fence(__ATOMIC_RELEASE, "agent");
      asm volatile("s_waitcnt vmcnt(0)" ::: "memory");
      const unsigned og = xb_add(&bar[XB_TOP], 1u);
      const unsigned tg = og / nx;
      if (og + 1u == (tg + 1u) * nx) xb_add(&bar[XB_TOPGEN], 1u);
      else XB_SPIN(xb_ld(&bar[XB_TOPGEN]) == tg, bar);
      __builtin_amdgcn_fence(__ATOMIC_ACQUIRE, "agent");
      xb_add(&bar[XB_XGEN(b.x)], 1u);
      asm volatile("s_waitcnt vmcnt(0)" ::: "memory");
    } else {
      XB_SPIN(xb_ld(&bar[XB_XGEN(b.x)]) == gen, bar);
      __builtin_amdgcn_fence(__ATOMIC_ACQUIRE, "agent");
      asm volatile("s_waitcnt vmcnt(0)" ::: "memory");
    }
  }
  __syncthreads();
}
namespace pg8 {
constexpr int BM = 256, BK = 64, HALF = 128, HTB = HALF * BK * 2, STAGE_BYTES = 8 * HTB, NXCD = 8, WGM = 8;
DI int lds_byte(int r, int c) { const int st = (r >> 4) * 2 + (c >> 5), rr = r & 15, cc = c & 31, ob = rr * 64 + cc * 2; return st * 1024 + (ob ^ (((ob >> 9) & 1) << 5)); }
DI void stage_rc(int b, int& R, int& C) { const int st = b / 1024, sb = b % 1024, swz = sb ^ (((sb >> 9) & 1) << 5); R = (st >> 1) * 16 + swz / 64; C = (st & 1) * 32 + (swz % 64) / 2; }
DI int perm32(int rho) { const int n = rho >> 4, i = rho & 15; return 8 * (i >> 2) + 4 * n + (i & 3); }

struct Unit { int pm, pn; };
struct Gemm { const bf16_t* A; const bf16_t* Bt; int lda, ldb, K; size_t tstepA, tstepB; };

struct StaticOrder {
  int nM, nN, nwg, G, c;
  DI void init(int M, int N, int G_, int c_) { nM = M / BM; nN = N / BM; nwg = nM * nN; G = G_; c = c_; }
  DI bool next(int i, Unit& u) const {
    const long L = (long)i * G + c; if (L >= nwg) return false;
    int wgid = (int)L; { const int q = nwg / NXCD, r = nwg % NXCD, xcd = wgid % NXCD, off = wgid / NXCD; wgid = (xcd < r ? xcd * (q + 1) : r * (q + 1) + (xcd - r) * q) + off; }
    const int nig = WGM * nN, gid = wgid / nig, fm = gid * WGM, gsz = (nM - fm) < WGM ? (nM - fm) : WGM;
    u.pm = fm + ((wgid % nig) % gsz); u.pn = (wgid % nig) / gsz; return true;
  }
};
struct SingleUnit {
  int pm, pn;
  DI bool next(int i, Unit& u) const { if (i != 0) return false; u.pm = pm; u.pn = pn; return true; }
};

template <class Epi, class Sched, bool ALIGN_EPI = false, bool SP2 = false>
DI void gemm_phase(LAS unsigned char* lds, const Gemm g, const Sched& S, const Epi& E) {
  const int tid = get_tid(), wid = __builtin_amdgcn_readfirstlane(tid >> 6), lane = tid & 63, wr = wid >> 2, wc = wid & 3, fr = lane & 15, fq = lane >> 4;
  const int K = g.K, nt = K / BK;
  unsigned voffA[2], voffB[2];
#pragma unroll
  for (int i = 0; i < 2; ++i) { int R, C; stage_rc(tid * 16 + i * 8192, R, C); const int Rb = Epi::PERM ? ((R & ~31) + perm32(R & 31)) : R;
    voffA[i] = (unsigned)(R * g.lda + C) * 2u; voffB[i] = (unsigned)(Rb * g.ldb + C) * 2u; }
  const size_t kstep = (size_t)(BK * 2);
  const size_t hstepA = (size_t)HALF * g.lda * 2, hstepB = (size_t)HALF * g.ldb * 2;
  const unsigned ldsw = (unsigned)wid * 1024u;
  const int aoff = lds_byte(wr * 64 + fr, fq * 8), boff = lds_byte(wc * 32 + fr, fq * 8);
#define PG8_SA(b, h) (((b) * 2 + (h)) * HTB)
#define PG8_SB(b, h) ((4 + (b) * 2 + (h)) * HTB)
#define PG8_STAGE(bufoff, gbase, voff) do { _Pragma("unroll") for (int _i = 0; _i < 2; ++_i) \
    __builtin_amdgcn_global_load_lds((const unsigned*)((const char*)(gbase) + (voff)[_i]), (LAS unsigned*)(lds + (bufoff) + ldsw + _i * 8192), 16, 0, 0); } while (0)
#define PG8_LDA(dst, b, h) do { _Pragma("unroll") for (int m = 0; m < 4; ++m) _Pragma("unroll") for (int k = 0; k < 2; ++k) dst[m][k] = *(const LAS bf16x8*)(lds + PG8_SA(b, h) + aoff + m * 2048 + k * 1024); } while (0)
#define PG8_LDB(dst, b, h) do { _Pragma("unroll") for (int n = 0; n < 2; ++n) _Pragma("unroll") for (int k = 0; k < 2; ++k) dst[n][k] = *(const LAS bf16x8*)(lds + PG8_SB(b, h) + boff + n * 2048 + k * 1024); } while (0)
#define PG8_MMA(ai, bj, At, Bt) do { __builtin_amdgcn_s_setprio(1); _Pragma("unroll") for (int m = 0; m < 4; ++m) _Pragma("unroll") for (int n = 0; n < 2; ++n) _Pragma("unroll") for (int k = 0; k < 2; ++k) \
    acc[ai][bj][m][n] = __builtin_amdgcn_mfma_f32_16x16x32_bf16(Bt[n][k], At[m][k], acc[ai][bj][m][n], 0, 0, 0); __builtin_amdgcn_s_setprio(0); } while (0)
#define PG8_WAIT_V(n) asm volatile("s_waitcnt vmcnt(" #n ")" ::: "memory")
#define PG8_WAIT_L(n) asm volatile("s_waitcnt lgkmcnt(" #n ")" ::: "memory")
#define PG8_BAR __builtin_amdgcn_s_barrier()
#define PG8_SCHED __builtin_amdgcn_sched_barrier(0)
  Unit cur, nxt; int ui = 0;
  if (!S.next(0, cur)) return;
  f32x4 acc[2][2][4][2];
#pragma unroll
  for (int a = 0; a < 2; ++a)
#pragma unroll
    for (int b = 0; b < 2; ++b)
#pragma unroll
      for (int m = 0; m < 4; ++m)
#pragma unroll
        for (int n = 0; n < 2; ++n) acc[a][b][m][n] = (f32x4){0.f, 0.f, 0.f, 0.f};
  bf16x8 At[4][2], B0[2][2], B1[2][2];
  const char* cA = (const char*)g.A + (size_t)cur.pm * g.tstepA; const char* cB = (const char*)g.Bt + (size_t)cur.pn * g.tstepB;
  if constexpr (SP2) {
    PG8_STAGE(PG8_SB(0, 0), cB, voffB); PG8_STAGE(PG8_SB(0, 1), cB + hstepB, voffB); PG8_STAGE(PG8_SA(0, 0), cA, voffA); PG8_STAGE(PG8_SA(0, 1), cA + hstepA, voffA);
    if (wr == 1) PG8_BAR;
    PG8_WAIT_V(2); PG8_BAR;
    PG8_STAGE(PG8_SB(1, 0), cB + kstep, voffB); PG8_STAGE(PG8_SA(1, 0), cA + kstep, voffA); PG8_STAGE(PG8_SB(1, 1), cB + hstepB + kstep, voffB);
    PG8_WAIT_V(6); PG8_BAR;
  } else {
    PG8_STAGE(PG8_SB(0, 0), cB, voffB); PG8_STAGE(PG8_SA(0, 0), cA, voffA); PG8_STAGE(PG8_SB(0, 1), cB + hstepB, voffB); PG8_STAGE(PG8_SA(0, 1), cA + hstepA, voffA);
    if (wr == 1) PG8_BAR;
    PG8_WAIT_V(4); PG8_BAR;
    PG8_STAGE(PG8_SB(1, 0), cB + kstep, voffB); PG8_STAGE(PG8_SA(1, 0), cA + kstep, voffA); PG8_STAGE(PG8_SB(1, 1), cB + hstepB + kstep, voffB);
    PG8_WAIT_V(6); PG8_BAR;
  }
  for (;;) {
    const bool has_next = S.next(ui + 1, nxt);
    const char* nA = has_next ? (const char*)g.A + (size_t)nxt.pm * g.tstepA : cA; const char* nB = has_next ? (const char*)g.Bt + (size_t)nxt.pn * g.tstepB : cB;
    for (int t = 0; t < nt; t += 2) {
      const bool last = (t == nt - 2);
      const char* a1 = cA + (size_t)(t + 1) * kstep;
      const char* a2 = last ? nA : cA + (size_t)(t + 2) * kstep; const char* b2 = last ? nB : cB + (size_t)(t + 2) * kstep;
      const char* a3 = a2 + kstep; const char* b3 = b2 + kstep;
      if constexpr (SP2) {
        PG8_LDB(B0, 0, 0); PG8_LDB(B1, 0, 1); PG8_SCHED; PG8_LDA(At, 0, 0); PG8_STAGE(PG8_SA(1, 1), a1 + hstepA, voffA);
        PG8_WAIT_V(8); PG8_WAIT_L(0); PG8_BAR; PG8_MMA(0, 0, At, B0); PG8_MMA(0, 1, At, B1); PG8_BAR; PG8_SCHED;
        PG8_LDA(At, 0, 1); PG8_STAGE(PG8_SB(0, 0), b2, voffB); PG8_STAGE(PG8_SB(0, 1), b2 + hstepB, voffB); PG8_STAGE(PG8_SA(0, 0), a2, voffA);
        PG8_WAIT_V(8); PG8_WAIT_L(0); PG8_BAR; PG8_MMA(1, 0, At, B0); PG8_MMA(1, 1, At, B1); PG8_BAR; PG8_SCHED;
        PG8_LDB(B0, 1, 0); PG8_LDB(B1, 1, 1); PG8_SCHED; PG8_LDA(At, 1, 0); PG8_STAGE(PG8_SA(0, 1), a2 + hstepA, voffA);
        PG8_WAIT_V(8); PG8_WAIT_L(0); PG8_BAR; PG8_MMA(0, 0, At, B0); PG8_MMA(0, 1, At, B1); PG8_BAR; PG8_SCHED;
        PG8_LDA(At, 1, 1); PG8_STAGE(PG8_SB(1, 0), b3, voffB); PG8_STAGE(PG8_SB(1, 1), b3 + hstepB, voffB); PG8_STAGE(PG8_SA(1, 0), a3, voffA);
        PG8_WAIT_V(8); PG8_WAIT_L(0); PG8_BAR; PG8_MMA(1, 0, At, B0); PG8_MMA(1, 1, At, B1); PG8_BAR; PG8_SCHED;
      } else {
        PG8_LDB(B0, 0, 0); PG8_SCHED; PG8_LDA(At, 0, 0); PG8_STAGE(PG8_SA(1, 1), a1 + hstepA, voffA);
        PG8_WAIT_L(8); PG8_BAR; PG8_WAIT_L(0); PG8_MMA(0, 0, At, B0); PG8_BAR; PG8_SCHED;
        PG8_LDB(B1, 0, 1); PG8_STAGE(PG8_SB(0, 0), b2, voffB);
        PG8_BAR; PG8_WAIT_L(0); PG8_MMA(0, 1, At, B1); PG8_BAR;
        PG8_LDA(At, 0, 1); PG8_STAGE(PG8_SA(0, 0), a2, voffA);
        PG8_BAR; PG8_WAIT_L(0); PG8_MMA(1, 0, At, B0); PG8_BAR; PG8_SCHED;
        PG8_STAGE(PG8_SB(0, 1), b2 + hstepB, voffB);
        PG8_WAIT_V(6); PG8_BAR; PG8_MMA(1, 1, At, B1); PG8_BAR;
        PG8_LDB(B0, 1, 0); PG8_SCHED; PG8_LDA(At, 1, 0); PG8_STAGE(PG8_SA(0, 1), a2 + hstepA, voffA);
        PG8_WAIT_L(8); PG8_BAR; PG8_WAIT_L(0); PG8_MMA(0, 0, At, B0); PG8_BAR; PG8_SCHED;
        PG8_LDB(B1, 1, 1); PG8_STAGE(PG8_SB(1, 0), b3, voffB);
        PG8_BAR; PG8_WAIT_L(0); PG8_MMA(0, 1, At, B1); PG8_BAR;
        PG8_LDA(At, 1, 1); PG8_STAGE(PG8_SA(1, 0), a3, voffA);
        PG8_BAR; PG8_WAIT_L(0); PG8_MMA(1, 0, At, B0); PG8_BAR; PG8_SCHED;
        PG8_STAGE(PG8_SB(1, 1), b3 + hstepB, voffB);
        PG8_WAIT_V(6); PG8_BAR; PG8_MMA(1, 1, At, B1); PG8_BAR;
      }
    }
    if constexpr (ALIGN_EPI) { if (wr == 0) PG8_BAR; }
    if constexpr (!Epi::AFTER_DRAIN) { E(acc, cur, wr, wc, fr, fq); }
    if (!has_next) break;
#pragma unroll
    for (int a = 0; a < 2; ++a)
#pragma unroll
      for (int b = 0; b < 2; ++b)
#pragma unroll
        for (int m = 0; m < 4; ++m)
#pragma unroll
          for (int n = 0; n < 2; ++n) acc[a][b][m][n] = (f32x4){0.f, 0.f, 0.f, 0.f};
    cur = nxt; cA = nA; cB = nB; ++ui;
    if constexpr (ALIGN_EPI) { if (wr == 1) PG8_BAR; }
  }
  PG8_WAIT_V(0);
  if constexpr (!ALIGN_EPI) { if (wr == 0) PG8_BAR; }
  PG8_BAR;
  if constexpr (Epi::AFTER_DRAIN) { E.fused(acc, cur, wr, wc, fr, fq, lds, wid, lane); }
#undef PG8_SA
#undef PG8_SB
#undef PG8_STAGE
#undef PG8_LDA
#undef PG8_LDB
#undef PG8_MMA
#undef PG8_WAIT_V
#undef PG8_WAIT_L
#undef PG8_BAR
#undef PG8_SCHED
}
}

struct Epi1 {
  static constexpr bool PERM = true, AFTER_DRAIN = false;
  const float* rs; bf16_t* uv; bf16_t* q; bf16_t* kv; float* gates;
  DI void operator()(const f32x4 (&acc)[2][2][4][2], const pg8::Unit& u, int wr, int wc, int fr, int fq) const {
    const int pn = u.pn;
#pragma unroll
    for (int ai = 0; ai < 2; ++ai)
#pragma unroll
      for (int m = 0; m < 4; ++m) {
        const int r = u.pm * 256 + ai * 128 + wr * 64 + m * 16 + fr;
        const float s = rs[r];
#pragma unroll
        for (int bj = 0; bj < 2; ++bj) {
          const int cl = bj * 128 + wc * 32 + 8 * fq;
          f32x4 v0 = acc[ai][bj][m][0] * s, v1 = acc[ai][bj][m][1] * s;
          if (pn < 4) {
            u32x4 w; w.x = pk2(v0[0], v0[1]); w.y = pk2(v0[2], v0[3]); w.z = pk2(v1[0], v1[1]); w.w = pk2(v1[2], v1[3]);
            *(u32x4*)(uv + (size_t)r * 1024 + pn * 256 + cl) = w;
          } else if (pn < 6) {
            v0 = v0 * QSCALE; v1 = v1 * QSCALE;
            u32x4 w; w.x = pk2(v0[0], v0[1]); w.y = pk2(v0[2], v0[3]); w.z = pk2(v1[0], v1[1]); w.w = pk2(v1[2], v1[3]);
            *(u32x4*)(q + (size_t)r * 512 + (pn - 4) * 256 + cl) = w;
          } else if (pn < 9) {
            const int kvidx = (pn - 6) * 256 + cl, br = kvidx >> 7, gg = (kvidx >> 6) & 1, d = kvidx & 63, b = r >> 12, t = r & 4095;
            u32x4 w; w.x = pk2(v0[0], v0[1]); w.y = pk2(v0[2], v0[3]); w.z = pk2(v1[0], v1[1]); w.w = pk2(v1[2], v1[3]);
            *(u32x4*)(kv + ((size_t)(((br * 8 + b) * 2 + gg) * 4096 + t)) * 64 + d) = w;
          } else {
            if (cl < 24) {
              f32x4 g0, g1;
#pragma unroll
              for (int j = 0; j < 4; ++j) { g0[j] = sigmoidf_(v0[j]); g1[j] = sigmoidf_(v1[j]); }
              *(f32x4*)(gates + (size_t)r * 24 + cl) = g0; *(f32x4*)(gates + (size_t)r * 24 + cl + 4) = g1;
            }
          }
        }
      }
  }
};
template <bool WRITE_IO, bool WRITE_B> struct EpiRes {
  static constexpr bool PERM = true, AFTER_DRAIN = false;
  const bf16_t* base; float* io; bf16_t* xb; float* ssq;
  DI void operator()(const f32x4 (&acc)[2][2][4][2], const pg8::Unit& u, int wr, int wc, int fr, int fq) const {
#pragma unroll
    for (int ai = 0; ai < 2; ++ai)
#pragma unroll
      for (int m = 0; m < 4; ++m) {
        const int r = u.pm * 256 + ai * 128 + wr * 64 + m * 16 + fr;
        float ss = 0.f;
#pragma unroll
        for (int bj = 0; bj < 2; ++bj) {
          const size_t off = (size_t)r * 1024 + u.pn * 256 + bj * 128 + wc * 32 + 8 * fq;
          const u32x4 xw = *(const u32x4*)(base + off);
          const f32x4 b0 = (f32x4){__uint_as_float(xw.x << 16), __uint_as_float(xw.x & 0xffff0000u), __uint_as_float(xw.y << 16), __uint_as_float(xw.y & 0xffff0000u)};
          const f32x4 b1 = (f32x4){__uint_as_float(xw.z << 16), __uint_as_float(xw.z & 0xffff0000u), __uint_as_float(xw.w << 16), __uint_as_float(xw.w & 0xffff0000u)};
          const f32x4 v0 = acc[ai][bj][m][0] + b0, v1 = acc[ai][bj][m][1] + b1;
          if (WRITE_IO) { *(f32x4*)(io + off) = v0; *(f32x4*)(io + off + 4) = v1; }
          if (WRITE_B) { u32x4 w; w.x = pk2(v0[0], v0[1]); w.y = pk2(v0[2], v0[3]); w.z = pk2(v1[0], v1[1]); w.w = pk2(v1[2], v1[3]); *(u32x4*)(xb + off) = w; }
          ss += (v0[0] * v0[0] + v0[1] * v0[1]) + (v0[2] * v0[2] + v0[3] * v0[3]) + (v1[0] * v1[0] + v1[1] * v1[1]) + (v1[2] * v1[2] + v1[3] * v1[3]);
        }
        ss += __shfl_xor(ss, 16); ss += __shfl_xor(ss, 32);
        if (fq == 0) atomicAdd(ssq + r, ss);
      }
  }
};
struct EpiFF1 {
  static constexpr bool PERM = true, AFTER_DRAIN = false;
  const float* ssq; bf16_t* hid;
  DI void operator()(const f32x4 (&acc)[2][2][4][2], const pg8::Unit& u, int wr, int wc, int fr, int fq) const {
#pragma unroll
    for (int ai = 0; ai < 2; ++ai)
#pragma unroll
      for (int m = 0; m < 4; ++m) {
        const int r = u.pm * 256 + ai * 128 + wr * 64 + m * 16 + fr;
        const float s = __builtin_amdgcn_rsqf(ssq[r] * (1.0f / 1024.0f) + EPSN);
#pragma unroll
        for (int bj = 0; bj < 2; ++bj) {
          f32x4 v0 = acc[ai][bj][m][0] * s, v1 = acc[ai][bj][m][1] * s;
#pragma unroll
          for (int j = 0; j < 4; ++j) { const float a = fmaxf(v0[j], 0.f), b = fmaxf(v1[j], 0.f); v0[j] = a * a; v1[j] = b * b; }
          u32x4 w; w.x = pk2(v0[0], v0[1]); w.y = pk2(v0[2], v0[3]); w.z = pk2(v1[0], v1[1]); w.w = pk2(v1[2], v1[3]);
          st_nt((u32x4*)(hid + (size_t)r * 4096 + u.pn * 256 + bj * 128 + wc * 32 + 8 * fq), w);
        }
      }
  }
};
struct EpiFinal {
  static constexpr bool PERM = true, AFTER_DRAIN = false;
  const bf16_t* xb; float* io; float* ssq; unsigned* cnt; const float* gn; int fuse;
  DI void operator()(f32x4 (&acc)[2][2][4][2], const pg8::Unit& u, int wr, int wc, int fr, int fq) const {
#pragma unroll
    for (int ai = 0; ai < 2; ++ai)
#pragma unroll
      for (int m = 0; m < 4; ++m) {
        const int r = u.pm * 256 + ai * 128 + wr * 64 + m * 16 + fr;
        float ss = 0.f;
#pragma unroll
        for (int bj = 0; bj < 2; ++bj) {
          const size_t off = (size_t)r * 1024 + u.pn * 256 + bj * 128 + wc * 32 + 8 * fq;
          const u32x4 xw = *(const u32x4*)(xb + off);
          const f32x4 b0 = (f32x4){__uint_as_float(xw.x << 16), __uint_as_float(xw.x & 0xffff0000u), __uint_as_float(xw.y << 16), __uint_as_float(xw.y & 0xffff0000u)};
          const f32x4 b1 = (f32x4){__uint_as_float(xw.z << 16), __uint_as_float(xw.z & 0xffff0000u), __uint_as_float(xw.w << 16), __uint_as_float(xw.w & 0xffff0000u)};
          const f32x4 v0 = acc[ai][bj][m][0] + b0, v1 = acc[ai][bj][m][1] + b1;
          acc[ai][bj][m][0] = v0; acc[ai][bj][m][1] = v1;
          if (!fuse) { *(f32x4*)(io + off) = v0; *(f32x4*)(io + off + 4) = v1; }
          ss += (v0[0] * v0[0] + v0[1] * v0[1]) + (v0[2] * v0[2] + v0[3] * v0[3]) + (v1[0] * v1[0] + v1[1] * v1[1]) + (v1[2] * v1[2] + v1[3] * v1[3]);
        }
        ss += __shfl_xor(ss, 16); ss += __shfl_xor(ss, 32);
        if (fq == 0) atomicAdd(ssq + r, ss);
      }
    if (!fuse) return;
    asm volatile("s_waitcnt vmcnt(0)" ::: "memory");
    unsigned* c = cnt + 64 * (u.pm * 2 + wr);
    if (fr == 0 && fq == 0) __hip_atomic_fetch_add(c, 1u, __ATOMIC_RELAXED, __HIP_MEMORY_SCOPE_AGENT);
    { unsigned sp = 0; while ((unsigned)__builtin_amdgcn_readfirstlane(__hip_atomic_load(c, __ATOMIC_RELAXED, __HIP_MEMORY_SCOPE_AGENT)) < 16u) { __builtin_amdgcn_s_sleep(2); if (++sp > (1u << 22)) break; } }
    f32x4 g[2][2];
#pragma unroll
    for (int bj = 0; bj < 2; ++bj)
#pragma unroll
      for (int n = 0; n < 2; ++n) g[bj][n] = *(const f32x4*)(gn + u.pn * 256 + bj * 128 + wc * 32 + 8 * fq + 4 * n);
#pragma unroll
    for (int ai = 0; ai < 2; ++ai)
#pragma unroll
      for (int m = 0; m < 4; ++m) {
        const int r = u.pm * 256 + ai * 128 + wr * 64 + m * 16 + fr;
        const float s = __builtin_amdgcn_rsqf(__hip_atomic_load(ssq + r, __ATOMIC_RELAXED, __HIP_MEMORY_SCOPE_AGENT) * (1.0f / 1024.0f) + EPSN);
#pragma unroll
        for (int bj = 0; bj < 2; ++bj) {
          const size_t off = (size_t)r * 1024 + u.pn * 256 + bj * 128 + wc * 32 + 8 * fq;
          st_nt((f32x4*)(io + off), acc[ai][bj][m][0] * s * g[bj][0]); st_nt((f32x4*)(io + off + 4), acc[ai][bj][m][1] * s * g[bj][1]);
        }
      }
  }
};
constexpr int HSTR = 528;
struct EpiCmp {
  static constexpr bool PERM = false, AFTER_DRAIN = true;
  const float* bias1; const bf16_t* w2t; bf16_t* outp;
  DI void fused(const f32x4 (&acc)[2][2][4][2], const pg8::Unit& u, int wr, int wc, int fr, int fq, LAS unsigned char* lds, int wid, int lane) const {
#pragma unroll
    for (int bj = 0; bj < 2; ++bj)
#pragma unroll
      for (int n = 0; n < 2; ++n) {
        const int c = bj * 128 + wc * 32 + n * 16 + 4 * fq;
        const f32x4 bv = *(const f32x4*)(bias1 + c);
#pragma unroll
        for (int ai = 0; ai < 2; ++ai)
#pragma unroll
          for (int m = 0; m < 4; ++m) {
            const int r = ai * 128 + wr * 64 + m * 16 + fr;
            const f32x4 v = acc[ai][bj][m][n] + bv;
            u32x2 w; w.x = pk2(gelu_tanh(v[0]), gelu_tanh(v[1])); w.y = pk2(gelu_tanh(v[2]), gelu_tanh(v[3]));
            *(LAS u32x2*)(lds + r * HSTR + c * 2) = w;
          }
      }
    __syncthreads();
    f32x4 o[2][4];
#pragma unroll
    for (int mb = 0; mb < 2; ++mb)
#pragma unroll
      for (int nb = 0; nb < 4; ++nb) o[mb][nb] = (f32x4){0.f, 0.f, 0.f, 0.f};
    bf16x8 wf[8][4];
#pragma unroll
    for (int ks = 0; ks < 8; ++ks)
#pragma unroll
      for (int nb = 0; nb < 4; ++nb) wf[ks][nb] = *(const bf16x8*)(w2t + (16 * nb + fr) * 256 + 32 * ks + 8 * fq);
#pragma unroll
    for (int ks = 0; ks < 8; ++ks) {
      bf16x8 hf[2];
#pragma unroll
      for (int mb = 0; mb < 2; ++mb) hf[mb] = *(const LAS bf16x8*)(lds + (32 * wid + 16 * mb + fr) * HSTR + (32 * ks + 8 * fq) * 2);
#pragma unroll
      for (int mb = 0; mb < 2; ++mb)
#pragma unroll
        for (int nb = 0; nb < 4; ++nb) o[mb][nb] = __builtin_amdgcn_mfma_f32_16x16x32_bf16(wf[ks][nb], hf[mb], o[mb][nb], 0, 0, 0);
    }
#pragma unroll
    for (int mb = 0; mb < 2; ++mb)
#pragma unroll
      for (int nb = 0; nb < 4; ++nb) {
        const int row = 32 * wid + 16 * mb + fr;
        u32x2 w; w.x = pk2(o[mb][nb][0], o[mb][nb][1]); w.y = pk2(o[mb][nb][2], o[mb][nb][3]);
        *(u32x2*)(outp + ((size_t)u.pm * 256 + row) * 64 + 16 * nb + 4 * fq) = w;
      }
    __syncthreads();
  }
};

struct TJob { const float* src; bf16_t* dst; const float* g; int K, N, kt, nt; };
DI TJob transpose_job(const Params& p, int job) {
  unsigned char* ws = p.ws; TJob t;
  if (job < 640) t = TJob{p.w_in, (bf16_t*)(ws + OFF_WIN), p.norm1_g, 1024, 2328, job / 40, job % 40};
  else if (job < 896) { const int j = job - 640; t = TJob{p.w_out, (bf16_t*)(ws + OFF_WOUT), nullptr, 1024, 1024, j / 16, j % 16}; }
  else if (job < 1920) { const int j = job - 896; t = TJob{p.w_ff1, (bf16_t*)(ws + OFF_WFF1), p.norm2_g, 1024, 4096, j / 64, j % 64}; }
  else if (job < 2944) { const int j = job - 1920; t = TJob{p.w_ff2, (bf16_t*)(ws + OFF_WFF2), nullptr, 4096, 1024, j / 16, j % 16}; }
  else if (job < 3072) { const int j = job - 2944; t = TJob{p.ck_w1, (bf16_t*)(ws + OFF_CW1), nullptr, 2048, 256, j / 4, j % 4}; }
  else if (job < 3200) { const int j = job - 3072; t = TJob{p.cv_w1, (bf16_t*)(ws + OFF_CW1) + 256 * 2048, nullptr, 2048, 256, j / 4, j % 4}; }
  else if (job < 3204) { const int j = job - 3200; t = TJob{p.ck_w2, (bf16_t*)(ws + OFF_CW2), nullptr, 256, 64, j, 0}; }
  else { const int j = job - 3204; t = TJob{p.cv_w2, (bf16_t*)(ws + OFF_CW2) + 64 * 256, nullptr, 256, 64, j, 0}; }
  return t;
}
DI void transpose_pair(const TJob& ta, const TJob& tb, bool has_b, LAS float* tl) {
  const int tid = get_tid();
  f32x4 va[2], vb[2];
#pragma unroll
  for (int i = 0; i < 2; ++i) {
    const int idx = tid + 512 * i, row = idx >> 4, c4 = idx & 15;
    { const int n = ta.nt * 64 + 4 * c4; va[i] = (f32x4){0.f, 0.f, 0.f, 0.f}; if (n < ta.N) va[i] = *(const f32x4*)(ta.src + (size_t)(ta.kt * 64 + row) * ta.N + n); if (ta.g) va[i] = va[i] * ta.g[ta.kt * 64 + row]; }
    vb[i] = (f32x4){0.f, 0.f, 0.f, 0.f};
    if (has_b) { const int n = tb.nt * 64 + 4 * c4; if (n < tb.N) vb[i] = *(const f32x4*)(tb.src + (size_t)(tb.kt * 64 + row) * tb.N + n); if (tb.g) vb[i] = vb[i] * tb.g[tb.kt * 64 + row]; }
  }
#pragma unroll
  for (int i = 0; i < 2; ++i) {
    const int idx = tid + 512 * i, row = idx >> 4, c4 = idx & 15;
#pragma unroll
    for (int e = 0; e < 4; ++e) { tl[row * 65 + 4 * c4 + e] = va[i][e]; tl[4160 + row * 65 + 4 * c4 + e] = vb[i][e]; }
  }
  __syncthreads();
  {
    const int nrow = tid >> 3, kc = tid & 7;
    float e[8];
#pragma unroll
    for (int j = 0; j < 8; ++j) e[j] = tl[(8 * kc + j) * 65 + nrow];
    u32x4 w; w.x = pk2(e[0], e[1]); w.y = pk2(e[2], e[3]); w.z = pk2(e[4], e[5]); w.w = pk2(e[6], e[7]);
    *(u32x4*)(ta.dst + (size_t)(ta.nt * 64 + nrow) * ta.K + ta.kt * 64 + 8 * kc) = w;
    if (has_b) {
#pragma unroll
      for (int j = 0; j < 8; ++j) e[j] = tl[4160 + (8 * kc + j) * 65 + nrow];
      w.x = pk2(e[0], e[1]); w.y = pk2(e[2], e[3]); w.z = pk2(e[4], e[5]); w.w = pk2(e[6], e[7]);
      *(u32x4*)(tb.dst + (size_t)(tb.nt * 64 + nrow) * tb.K + tb.kt * 64 + 8 * kc) = w;
    }
  }
  __syncthreads();
}

DI void p0_prologue(const Params& p, LAS unsigned char* lds) {
  const int tid = get_tid(), lane = tid & 63, wid = tid >> 6, G = gridDim.x, bx = blockIdx.x;
  unsigned char* ws = p.ws;
  {
    bf16_t* xb = (bf16_t*)(ws + OFF_XB); float* rs1 = (float*)(ws + OFF_RS1);
    for (int r0 = (bx * 8 + wid) * 4; r0 < MTOK; r0 += G * 32) {
      f32x4 a[4][2], c[4][2];
#pragma unroll
      for (int rr = 0; rr < 4; ++rr)
#pragma unroll
        for (int i = 0; i < 2; ++i) { const float* s = p.x + (size_t)(r0 + rr) * 1024 + (lane + 64 * i) * 8; a[rr][i] = __builtin_nontemporal_load((const f32x4*)s); c[rr][i] = __builtin_nontemporal_load((const f32x4*)(s + 4)); }
#pragma unroll
      for (int rr = 0; rr < 4; ++rr) {
        float ss = 0.f;
#pragma unroll
        for (int i = 0; i < 2; ++i) {
          const f32x4 av = a[rr][i], bv = c[rr][i];
          ss += (av[0] * av[0] + av[1] * av[1]) + (av[2] * av[2] + av[3] * av[3]) + (bv[0] * bv[0] + bv[1] * bv[1]) + (bv[2] * bv[2] + bv[3] * bv[3]);
          u32x4 w; w.x = pk2(av[0], av[1]); w.y = pk2(av[2], av[3]); w.z = pk2(bv[0], bv[1]); w.w = pk2(bv[2], bv[3]);
          *(u32x4*)(xb + (size_t)(r0 + rr) * 1024 + (lane + 64 * i) * 8) = w;
        }
        ss = wave_sum(ss);
        if (lane == 0) rs1[r0 + rr] = __builtin_amdgcn_rsqf(ss * (1.0f / 1024.0f) + EPSN);
      }
    }
  }
  { float* z = (float*)(ws + OFF_SSQ2); for (int i = bx * 512 + tid; i < 2 * MTOK; i += G * 512) z[i] = 0.f; }
  for (int pair = bx; pair < 256; pair += G) {
    LAS float* red = (LAS float*)lds;
    const int kv = pair >> 7, n = (pair & 127) * 2 + (tid & 1), ksl = tid >> 1;
    const float* pe = kv ? p.cv_pe : p.ck_pe; const float* w1 = kv ? p.cv_w1 : p.ck_w1;
    float s = 0.f;
#pragma unroll
    for (int k = 0; k < 8; ++k) s += pe[ksl * 8 + k] * w1[(size_t)(ksl * 8 + k) * 256 + n];
    s += __shfl_xor(s, 2); s += __shfl_xor(s, 4); s += __shfl_xor(s, 8); s += __shfl_xor(s, 16); s += __shfl_xor(s, 32);
    if (lane < 2) red[wid * 2 + lane] = s;
    __syncthreads();
    if (tid < 2) { float t = 0.f; for (int i = 0; i < 8; ++i) t += red[i * 2 + tid]; ((float*)(ws + OFF_CB1))[kv * 256 + (pair & 127) * 2 + tid] = t; }
    __syncthreads();
  }
  for (int job = bx; job < 3208; job += 2 * G) {
    const bool has_b = (job + G) < 3208;
    const TJob ta = transpose_job(p, job), tb = transpose_job(p, has_b ? job + G : job);
    transpose_pair(ta, tb, has_b, (LAS float*)lds);
  }
}

constexpr int USTR = 1040;
constexpr int YSTR = 516;
constexpr int C_WOFF = 66560;
DI void conv_load_taps(const Params& p, LAS unsigned char* lds) {
  LAS float* Wp = (LAS float*)(lds + C_WOFF);
  for (int idx = get_tid(); idx < 32 * 256; idx += 512) {
    const int w = idx >> 8, cp = idx & 255;
    f32x2 t = (f32x2){0.f, 0.f};
    if (w < 31) t = *(const f32x2*)(p.dw_w + w * 512 + 2 * cp);
    *(LAS f32x2*)(Wp + ((w >> 2) * 256 + cp) * 8 + (w & 3) * 2) = t;
  }
}
DI void conv_tile(const Params& p, LAS unsigned char* lds, int tile) {
  const int tid = get_tid(), lane = tid & 63, wid = tid >> 6;
  const int b = tile >> 7, t0 = (tile & 127) * 32;
  const bf16_t* uv = (const bf16_t*)(p.ws + OFF_B);
  bf16_t* cat = (bf16_t*)(p.ws + OFF_CAT);
  LAS unsigned char* U = lds; LAS float* Y = (LAS float*)lds;
  const LAS float* Wp = (const LAS float*)(lds + C_WOFF);
  {
    u32x4 vv[8], gv[8];
#pragma unroll
    for (int it = 0; it < 8; ++it) {
      const int idx = tid + 512 * it, row = idx >> 6, ch = idx & 63, t = t0 - 30 + row;
      const int tc = t < 0 ? 0 : (row < 62 ? t : t0);
      const size_t m = (size_t)b * 4096 + tc;
      vv[it] = *(const u32x4*)(uv + m * 1024 + ch * 8); gv[it] = *(const u32x4*)(uv + m * 1024 + 512 + ch * 8);
    }
#pragma unroll
    for (int it = 0; it < 8; ++it) {
      const int idx = tid + 512 * it, row = idx >> 6, ch = idx & 63, t = t0 - 30 + row;
      u32x4 w = (u32x4){0u, 0u, 0u, 0u};
      if (t >= 0 && row < 62) {
#pragma unroll
        for (int j = 0; j < 4; ++j) {
          const float v0 = __uint_as_float(vv[it][j] << 16), v1 = __uint_as_float(vv[it][j] & 0xffff0000u), g0 = __uint_as_float(gv[it][j] << 16), g1 = __uint_as_float(gv[it][j] & 0xffff0000u);
          w[j] = pk2(v0 * sigmoidf_(g0), v1 * sigmoidf_(g1));
        }
      }
      if (row < 63) *(LAS u32x4*)(U + row * USTR + ch * 16) = w;
    }
  }
  __syncthreads();
  const int half = tid >> 8, cp = tid & 255;
  float a0[16], a1[16];
  {
    const f32x2 bias = *(const f32x2*)(p.dw_b + 2 * cp);
#pragma unroll
    for (int o = 0; o < 16; ++o) { a0[o] = bias.x; a1[o] = bias.y; }
#pragma unroll
    for (int og = 0; og < 2; ++og) {
      const LAS unsigned char* ub = U + (half * 16 + og * 8) * USTR + cp * 4;
#pragma unroll 1
      for (int w4 = 0; w4 < 8; ++w4) {
        const f32x4 wa = *(const LAS f32x4*)(Wp + (w4 * 256 + cp) * 8), wb = *(const LAS f32x4*)(Wp + (w4 * 256 + cp) * 8 + 4);
        const float wt0[4] = {wa[0], wa[2], wb[0], wb[2]}, wt1[4] = {wa[1], wa[3], wb[1], wb[3]};
        float u0[11], u1[11];
#pragma unroll
        for (int r = 0; r < 11; ++r) { const unsigned uu = *(const LAS unsigned*)(ub + (w4 * 4 + r) * USTR); u0[r] = __uint_as_float(uu << 16); u1[r] = __uint_as_float(uu & 0xffff0000u); }
#pragma unroll
        for (int o = 0; o < 8; ++o)
#pragma unroll
          for (int k = 0; k < 4; ++k) { a0[og * 8 + o] += u0[o + k] * wt0[k]; a1[og * 8 + o] += u1[o + k] * wt1[k]; }
      }
    }
  }
  __syncthreads();
#pragma unroll
  for (int o = 0; o < 16; ++o) *(LAS f32x2*)(Y + (half * 16 + o) * YSTR + 2 * cp) = (f32x2){a0[o], a1[o]};
  __syncthreads();
  {
    const f32x4 g0 = *(const f32x4*)(p.cln_g + lane * 8), g1 = *(const f32x4*)(p.cln_g + lane * 8 + 4), b0 = *(const f32x4*)(p.cln_b + lane * 8), b1 = *(const f32x4*)(p.cln_b + lane * 8 + 4);
#pragma unroll
    for (int i = 0; i < 4; ++i) {
      const int tok = wid * 4 + i;
      const f32x4 y0 = *(const LAS f32x4*)(Y + tok * YSTR + lane * 8), y1 = *(const LAS f32x4*)(Y + tok * YSTR + lane * 8 + 4);
      float s = (y0[0] + y0[1]) + (y0[2] + y0[3]) + (y1[0] + y1[1]) + (y1[2] + y1[3]);
      s = wave_sum(s);
      const float mu = s * (1.0f / 512.0f);
      const f32x4 d0 = y0 - mu, d1 = y1 - mu;
      float q = (d0[0] * d0[0] + d0[1] * d0[1]) + (d0[2] * d0[2] + d0[3] * d0[3]) + (d1[0] * d1[0] + d1[1] * d1[1]) + (d1[2] * d1[2] + d1[3] * d1[3]);
      q = wave_sum(q);
      const float rstd = __builtin_amdgcn_rsqf(q * (1.0f / 512.0f) + EPSN);
      f32x4 o0 = d0 * rstd * g0 + b0, o1 = d1 * rstd * g1 + b1;
#pragma unroll
      for (int j = 0; j < 4; ++j) { o0[j] = o0[j] * sigmoidf_(o0[j]); o1[j] = o1[j] * sigmoidf_(o1[j]); }
      u32x4 w; w.x = pk2(o0[0], o0[1]); w.y = pk2(o0[2], o0[3]); w.z = pk2(o1[0], o1[1]); w.w = pk2(o1[2], o1[3]);
      *(u32x4*)(cat + ((size_t)b * 4096 + t0 + tok) * 1024 + lane * 8) = w;
    }
  }
  __syncthreads();
}

constexpr int KVSTR = 144;
constexpr int VSTR = 144;
constexpr int A_GRP = 4 * 64 * KVSTR;
constexpr int A_KOFF = 0, A_VOFF = 2 * 64 * KVSTR;
constexpr int A_SLAB = 2 * A_GRP;
constexpr int SLAB_FLOATS = 32 * 65;
constexpr int A_SEL = A_SLAB + 8 * SLAB_FLOATS * 4;
constexpr int A_OR = A_SEL + 512;
constexpr int A_CNT = A_OR + 16;
constexpr int A_NXT = A_CNT + 32;
static_assert(A_NXT + 32 <= LDS_BYTES - 16, "attention LDS map");

DI void group_sync(LAS unsigned* cnt, unsigned& tgt, int lane) {
  tgt += 4u;
  __builtin_amdgcn_fence(__ATOMIC_RELEASE, "workgroup");
  if (lane == 0) __hip_atomic_fetch_add(cnt, 1u, __ATOMIC_RELAXED, __HIP_MEMORY_SCOPE_WORKGROUP);
  while ((int)(__hip_atomic_load(cnt, __ATOMIC_RELAXED, __HIP_MEMORY_SCOPE_WORKGROUP) - tgt) < 0) __builtin_amdgcn_s_sleep(0);
  __builtin_amdgcn_fence(__ATOMIC_ACQUIRE, "workgroup");
}

constexpr float ATT_THR = 8.0f;
template <int KIND, bool MASKED>
DI void attn_scores(LAS unsigned char* kbuf, int jc, const bf16x8 (&qf)[4], float slope2, float sc, int tq, int jt, unsigned long long mymask, float mref, f32x16 (&S)[2], int q, int h) {
  float base2; int kmin = -1, kmax = 64;
  if (KIND <= 1) {
    const int lim = 64 * jt + tq - 31 - 1024 * jc - 64 * h;
    base2 = -slope2 * (float)lim - mref; kmax = lim >> 4;
  } else {
    base2 = slope2 * (float)(64 * (jc - jt) + 4 * h - tq) - mref;
    if (MASKED && jc == jt) kmax = tq - 4 * h;
    if (MASKED && KIND == 3 && jc == jt - 8) kmin = tq - 4 * h;
    if (KIND == 2) base2 = ((mymask >> jc) & 1ull) ? base2 : -1e30f;
  }
  bf16x8 kf[2][4];
#pragma unroll
  for (int kb = 0; kb < 2; ++kb)
#pragma unroll
    for (int ks = 0; ks < 4; ++ks) kf[kb][ks] = *(const LAS bf16x8*)(kbuf + (32 * kb + q) * KVSTR + 32 * ks + 16 * h);
  __builtin_amdgcn_sched_barrier(0);
#pragma unroll
  for (int kb = 0; kb < 2; ++kb)
#pragma unroll
    for (int i = 0; i < 16; ++i) S[kb][i] = __builtin_fmaf(sc, (float)(32 * kb + 8 * (i >> 2) + (i & 3)), base2);
#pragma unroll
  for (int ks = 0; ks < 4; ++ks)
#pragma unroll
    for (int kb = 0; kb < 2; ++kb) S[kb] = __builtin_amdgcn_mfma_f32_32x32x16_bf16(kf[kb][ks], qf[ks], S[kb], 0, 0, 0);
  if (MASKED) {
    const unsigned range = (unsigned)(kmax - kmin);
#pragma unroll
    for (int kb = 0; kb < 2; ++kb)
#pragma unroll
      for (int i = 0; i < 16; ++i) {
        const int keyc = 32 * kb + 8 * (i >> 2) + (i & 3);
        const bool ok = (kmax > kmin) && ((unsigned)(keyc - kmin - 1) < range);
        S[kb][i] = ok ? S[kb][i] : -INFINITY;
      }
  }
}
DI float attn_exp_sum(f32x16 (&S)[2]) {
  float pa = 0.f, pb = 0.f;
#pragma unroll
  for (int i = 0; i < 16; ++i) {
    const float p0 = __builtin_amdgcn_exp2f(S[0][i]), p1 = __builtin_amdgcn_exp2f(S[1][i]);
    S[0][i] = p0; S[1][i] = p1; pa += p0; asm volatile("" : "+v"(pa)); pb += p1; asm volatile("" : "+v"(pb));
  }
  return pa + pb;
}
constexpr float ATT_SUM_CAP = 16777216.0f;
template <int KIND, bool MASKED>
DI void attn_tile(LAS unsigned char* kbuf, LAS unsigned char* vbuf, int jc, const bf16x8 (&qf)[4], float slope2, float sc, int tq, int jt, unsigned long long mymask,
                  float& m_run, float& l_run, float l2inv, f32x16 (&O)[2], LAS float* slab, int q, int h, int q4, int p4, int g1) {
  f32x16 S[2];
  attn_scores<KIND, MASKED>(kbuf, jc, qf, slope2, sc, tq, jt, mymask, (KIND == 1) ? (m_run - l2inv) : m_run, S, q, h);
  s16x4 vlo[2][2][2], vhi[2][2][2];
  if (KIND != 0) {
#pragma unroll
    for (int kb = 0; kb < 2; ++kb)
#pragma unroll
      for (int s = 0; s < 2; ++s)
#pragma unroll
        for (int db = 0; db < 2; ++db) {
          LAS unsigned char* va = vbuf + (32 * kb + 16 * s + 4 * h + q4) * VSTR + (32 * db + 16 * g1) * 2 + 8 * p4;
          vlo[kb][s][db] = __builtin_amdgcn_ds_read_tr16_b64_v4i16((LAS s16x4*)va);
          vhi[kb][s][db] = __builtin_amdgcn_ds_read_tr16_b64_v4i16((LAS s16x4*)(va + 8 * VSTR));
        }
    __builtin_amdgcn_sched_barrier(0);
  }
  if (KIND != 1) {
    float ps = attn_exp_sum(S);
    if (__any(!(ps < ATT_SUM_CAP))) {
      asm volatile("s_nop 0" ::: "memory");
      attn_scores<KIND, MASKED>(kbuf, jc, qf, slope2, sc, tq, jt, mymask, m_run, S, q, h);
      float mx = fmaxf(S[0][0], S[1][0]);
#pragma unroll
      for (int i = 1; i < 16; ++i) mx = fmaxf(fmaxf(mx, S[0][i]), S[1][i]);
      mx = fmaxf(mx, __shfl_xor(mx, 32));
      const float d = fmaxf(mx, 0.f), alpha = __builtin_amdgcn_exp2f(-d);
      m_run += d; l_run *= alpha;
#pragma unroll
      for (int kb = 0; kb < 2; ++kb)
#pragma unroll
        for (int i = 0; i < 16; ++i) S[kb][i] -= d;
      if (KIND != 0) {
#pragma unroll
        for (int db = 0; db < 2; ++db)
#pragma unroll
          for (int i = 0; i < 16; ++i) O[db][i] *= alpha;
      }
      ps = attn_exp_sum(S);
    }
    l_run += ps;
  } else {
#pragma unroll
    for (int kb = 0; kb < 2; ++kb)
#pragma unroll
      for (int i = 0; i < 16; ++i) S[kb][i] = __builtin_amdgcn_exp2f(S[kb][i]);
#pragma unroll
    for (int kb = 0; kb < 2; ++kb)
#pragma unroll
      for (int gi = 0; gi < 4; ++gi) {
        const int jm = 16 * jc + 8 * kb + 2 * gi + h;
        float s4 = S[kb][4 * gi] + S[kb][4 * gi + 1]; asm volatile("" : "+v"(s4)); s4 += S[kb][4 * gi + 2]; asm volatile("" : "+v"(s4)); s4 += S[kb][4 * gi + 3];
        __hip_atomic_fetch_add(slab + q * 65 + jm, s4, __ATOMIC_RELAXED, __HIP_MEMORY_SCOPE_WORKGROUP);
        __hip_atomic_fetch_add(slab + q * 65 + jm + 1, S[kb][4 * gi + 3], __ATOMIC_RELAXED, __HIP_MEMORY_SCOPE_WORKGROUP);
      }
  }
  if (KIND != 0) {
#pragma unroll
    for (int kb = 0; kb < 2; ++kb)
#pragma unroll
      for (int s = 0; s < 2; ++s) {
        u32x4 pw;
        pw.x = pk2(S[kb][8 * s + 0], S[kb][8 * s + 1]); pw.y = pk2(S[kb][8 * s + 2], S[kb][8 * s + 3]);
        pw.z = pk2(S[kb][8 * s + 4], S[kb][8 * s + 5]); pw.w = pk2(S[kb][8 * s + 6], S[kb][8 * s + 7]);
        const bf16x8 pf = __builtin_bit_cast(bf16x8, pw);
#pragma unroll
        for (int db = 0; db < 2; ++db) {
          const bf16x8 vf = __builtin_shufflevector(vlo[kb][s][db], vhi[kb][s][db], 0, 1, 2, 3, 4, 5, 6, 7);
          O[db] = __builtin_amdgcn_mfma_f32_32x32x16_bf16(vf, pf, O[db], 0, 0, 0);
        }
      }
  }
}

template <int KIND>
DI void attn_branch(LAS unsigned char* gl, LAS unsigned* cnt, unsigned& tgt, const bf16_t* Kg, const bf16_t* Vg, unsigned long long tmask, const bf16x8 (&qf)[4], float slope2, int tq, int jt,
                    unsigned long long mymask, float& m_run, float& l_run, float invl, f32x16 (&O)[2], LAS float* slab) {
  const int gt = get_tid() & 255, lane = gt & 63, q = lane & 31, h = lane >> 5;
  const int i16 = lane & 15, q4 = i16 >> 2, p4 = i16 & 3, g1 = (lane >> 4) & 1;
  const float sc = (KIND <= 1) ? slope2 * 16.0f : slope2;
  const int woff = (gt >> 3) * KVSTR + (gt & 7) * 16;
  int j = __builtin_ctzll(tmask); tmask &= tmask - 1;
  const u32x4 z4 = (u32x4){0u, 0u, 0u, 0u};
  u32x4 ka = *(const u32x4*)(Kg + (size_t)j * 4096 + gt * 8), kb = *(const u32x4*)(Kg + (size_t)j * 4096 + 2048 + gt * 8), va = z4, vb = z4;
  if (KIND != 0) { va = *(const u32x4*)(Vg + (size_t)j * 4096 + gt * 8); vb = *(const u32x4*)(Vg + (size_t)j * 4096 + 2048 + gt * 8); }
  int buf = 0;
  for (;;) {
    LAS unsigned char* kbuf = gl + A_KOFF + buf * (64 * KVSTR); LAS unsigned char* vbuf = gl + A_VOFF + buf * (64 * VSTR);
    *(LAS u32x4*)(kbuf + woff) = ka; *(LAS u32x4*)(kbuf + 32 * KVSTR + woff) = kb;
    if (KIND != 0) { *(LAS u32x4*)(vbuf + woff) = va; *(LAS u32x4*)(vbuf + 32 * VSTR + woff) = vb; }
    group_sync(cnt, tgt, lane);
    const int jc = j;
    const bool more = (tmask != 0ull);
    if (more) {
      j = __builtin_ctzll(tmask); tmask &= tmask - 1;
      ka = *(const u32x4*)(Kg + (size_t)j * 4096 + gt * 8); kb = *(const u32x4*)(Kg + (size_t)j * 4096 + 2048 + gt * 8);
      if (KIND != 0) { va = *(const u32x4*)(Vg + (size_t)j * 4096 + gt * 8); vb = *(const u32x4*)(Vg + (size_t)j * 4096 + 2048 + gt * 8); }
    }
    if (KIND <= 1 || jc == jt || (KIND == 3 && jc == jt - 8)) attn_tile<KIND, true>(kbuf, vbuf, jc, qf, slope2, sc, tq, jt, mymask, m_run, l_run, invl, O, slab, q, h, q4, p4, g1);
    else attn_tile<KIND, (KIND <= 1)>(kbuf, vbuf, jc, qf, slope2, sc, tq, jt, mymask, m_run, l_run, invl, O, slab, q, h, q4, p4, g1);
    buf ^= 1;
    if (!more) break;
  }
  group_sync(cnt, tgt, lane);
}

DI int queue_pop(unsigned* qbase, unsigned xcc) {
  for (unsigned qq = 0; qq < 8u; ++qq) {
    const unsigned x2 = (xcc + qq) & 7u;
    const unsigned i = __hip_atomic_fetch_add(qbase + 64 * x2, 1u, __ATOMIC_RELAXED, __HIP_MEMORY_SCOPE_AGENT);
    if (i < 256u) return (int)(x2 * 256u + i);
  }
  return -1;
}
DI void attn_item(const Params& p, LAS unsigned char* lds, int grp, unsigned& tgt, int enc, int& nenc, unsigned xcc) {
  const int gt = get_tid() & 255, lane = gt & 63, hh = __builtin_amdgcn_readfirstlane(gt >> 6), q = lane & 31, h = lane >> 5;
  const int bg = 2 * (enc >> 8) + ((enc >> 7) & 1), jt32 = 127 - (enc & 127);
  int popv = -1;
  if (gt == 0) popv = queue_pop((unsigned*)(p.ws + OFF_QCNT), xcc);
  const int b = bg >> 1, g = bg & 1, head = g * 4 + hh, jt = jt32 >> 1, tq = (jt32 & 1) * 32 + q, t = jt * 64 + tq;
  const size_t mrow = (size_t)b * 4096 + t;
  const bf16_t* Qp = (const bf16_t*)(p.ws + OFF_Q);
  const bf16_t* KV = (const bf16_t*)(p.ws + OFF_KV);
  const float* gates = (const float*)(p.ws + OFF_GATES);
  bf16_t* cat = (bf16_t*)(p.ws + OFF_CAT);
  float* osc = (float*)(p.ws + OFF_B) + mrow * 512 + head * 64 + 4 * h;
  LAS unsigned char* gl = lds + grp * A_GRP;
  LAS float* slab = (LAS float*)(lds + A_SLAB) + (grp * 4 + hh) * SLAB_FLOATS;
  LAS unsigned long long* selm = (LAS unsigned long long*)(lds + A_SEL) + grp * 32;
  LAS unsigned long long* orm = (LAS unsigned long long*)(lds + A_OR) + grp;
  LAS unsigned* cnt = (LAS unsigned*)(lds + A_CNT + 16 * grp);
  for (int i = lane; i < SLAB_FLOATS; i += 64) slab[i] = 0.f;
  if (gt == 0) *orm = 0ull;
  bf16x8 qf[4];
#pragma unroll
  for (int ks = 0; ks < 4; ++ks) qf[ks] = *(const bf16x8*)(Qp + mrow * 512 + head * 64 + 16 * ks + 8 * h);
  const float slope2 = __builtin_amdgcn_exp2f(-(float)(head + 1)) * LOG2E;
  const float g_cmp = gates[mrow * 24 + head * 3 + 0], g_sel = gates[mrow * 24 + head * 3 + 1], g_win = gates[mrow * 24 + head * 3 + 2];
  const size_t bgoff = (size_t)bg * 4096 * 64;
  const bf16_t* Ksel = KV + (size_t)2 * 16 * 4096 * 64 + bgoff; const bf16_t* Vsel = KV + (size_t)3 * 16 * 4096 * 64 + bgoff;
  const bf16_t* Kwin = KV + (size_t)4 * 16 * 4096 * 64 + bgoff; const bf16_t* Vwin = KV + (size_t)5 * 16 * 4096 * 64 + bgoff;
  const bf16_t* Kc = (const bf16_t*)(p.ws + OFF_KC) + (size_t)bg * 256 * 64; const bf16_t* Vc = (const bf16_t*)(p.ws + OFF_VC) + (size_t)bg * 256 * 64;
  f32x16 O[2];
#pragma unroll
  for (int db = 0; db < 2; ++db)
#pragma unroll
    for (int i = 0; i < 16; ++i) O[db][i] = 0.f;
  {
    const int ncmp = 4 * jt + 2 * (jt32 & 1) + 1, ntile = (ncmp + 63) >> 6;
    const unsigned long long cm = (1ull << ntile) - 1ull;
    float m_run = 0.f, l_run = 0.f;
    attn_branch<0>(gl, cnt, tgt, Kc, Vc, cm, qf, slope2, tq, jt, 0ull, m_run, l_run, 0.f, O, slab);
    const float lt = l_run + __shfl_xor(l_run, 32);
    const float invl = (lt > 0.f) ? __builtin_amdgcn_logf(1.0f / lt) : -INFINITY;
    attn_branch<1>(gl, cnt, tgt, Kc, Vc, cm, qf, slope2, tq, jt, 0ull, m_run, l_run, invl, O, slab);
#pragma unroll
    for (int db = 0; db < 2; ++db)
#pragma unroll
      for (int gi = 0; gi < 4; ++gi) {
        *(f32x4*)(osc + 32 * db + 8 * gi) = (f32x4){O[db][4 * gi], O[db][4 * gi + 1], O[db][4 * gi + 2], O[db][4 * gi + 3]} * g_cmp;
        O[db][4 * gi] = 0.f; O[db][4 * gi + 1] = 0.f; O[db][4 * gi + 2] = 0.f; O[db][4 * gi + 3] = 0.f;
      }
  }
  {
    const LAS float* slabs = (const LAS float*)(lds + A_SLAB) + grp * 4 * SLAB_FLOATS;
    unsigned long long worm = 0ull;
    for (int tt = 0; tt < 8; ++tt) {
      const int tok = hh * 8 + tt;
      float v = 0.f;
#pragma unroll
      for (int h2 = 0; h2 < 4; ++h2) v += slabs[h2 * SLAB_FLOATS + tok * 65 + lane];
      if (lane == 0 || lane == jt || lane == jt - 1) v = 1e30f; else if (lane > jt) v = -1e30f;
      unsigned key = __float_as_uint(v); key = (key & 0x80000000u) ? ~key : (key | 0x80000000u);
      unsigned prefix = 0u;
#pragma unroll
      for (int bit = 31; bit >= 0; --bit) {
        const unsigned cand = prefix | (1u << bit);
        const unsigned long long mge = __ballot(key >= cand);
        prefix = (__popcll(mge) >= 16) ? cand : prefix;
      }
      const unsigned long long mgt = __ballot(key > prefix), meq = __ballot(key == prefix);
      const int need = 16 - __popcll(mgt);
      const int rank_eq = __popcll(meq & ((1ull << lane) - 1ull));
      const unsigned long long msk = mgt | __ballot((key == prefix) && (rank_eq < need));
      if (lane == 0) selm[tok] = msk;
      worm |= msk;
    }
    if (lane == 0) atomicOr((unsigned long long*)orm, worm);
  }
  if (gt == 0) *(LAS int*)(lds + A_NXT + 16 * grp) = popv;
  group_sync(cnt, tgt, lane);
  nenc = *(const LAS int*)(lds + A_NXT + 16 * grp);
  const unsigned long long mymask = selm[q];
  const unsigned long long ormask = *orm;
  const unsigned long long causal = (jt >= 63) ? ~0ull : ((2ull << jt) - 1ull);
  const int jlo = jt >= 8 ? jt - 8 : 0;
  {
    float m_run = 0.f, l_run = 0.f;
    attn_branch<2>(gl, cnt, tgt, Ksel, Vsel, ormask & causal, qf, slope2, tq, jt, mymask, m_run, l_run, 0.f, O, slab);
    const float lt = l_run + __shfl_xor(l_run, 32);
    const float sc = lt > 0.f ? g_sel / lt : 0.f;
#pragma unroll
    for (int db = 0; db < 2; ++db)
#pragma unroll
      for (int gi = 0; gi < 4; ++gi) {
        const f32x4 pv = *(const f32x4*)(osc + 32 * db + 8 * gi);
        *(f32x4*)(osc + 32 * db + 8 * gi) = pv + (f32x4){O[db][4 * gi], O[db][4 * gi + 1], O[db][4 * gi + 2], O[db][4 * gi + 3]} * sc;
        O[db][4 * gi] = 0.f; O[db][4 * gi + 1] = 0.f; O[db][4 * gi + 2] = 0.f; O[db][4 * gi + 3] = 0.f;
      }
  }
  {
    const unsigned long long wm = causal & ~((1ull << jlo) - 1ull);
    float m_run = 0.f, l_run = 0.f;
    attn_branch<3>(gl, cnt, tgt, Kwin, Vwin, wm, qf, slope2, tq, jt, 0ull, m_run, l_run, 0.f, O, slab);
    const float lt = l_run + __shfl_xor(l_run, 32);
    const float sc = lt > 0.f ? g_win / lt : 0.f;
#pragma unroll
    for (int db = 0; db < 2; ++db)
#pragma unroll
      for (int gi = 0; gi < 4; ++gi) {
        const f32x4 v = *(const f32x4*)(osc + 32 * db + 8 * gi) + (f32x4){O[db][4 * gi], O[db][4 * gi + 1], O[db][4 * gi + 2], O[db][4 * gi + 3]} * sc;
        u32x2 w; w.x = pk2(v[0], v[1]); w.y = pk2(v[2], v[3]);
        *(u32x2*)(cat + mrow * 1024 + 512 + head * 64 + 32 * db + 8 * gi + 4 * h) = w;
      }
  }
}

__global__ void __launch_bounds__(512, 2) fwd_megakernel(Params p) {
  extern __shared__ __attribute__((aligned(16))) unsigned char smem[];
  LAS unsigned char* lds = (LAS unsigned char*)smem;
  cg::grid_group grid = cg::this_grid();
  const int G = gridDim.x, bx = blockIdx.x;
  unsigned char* ws = p.ws;
  if (p.ws == nullptr) grid.sync();
  volatile LAS unsigned* bst = (volatile LAS unsigned*)(lds + LDS_BYTES - 16);
  if (threadIdx.x == 0) { bst[0] = 0u; bst[1] = 0u; }
  __syncthreads();
  const XcdBarrier gbar = xcd_barrier_post((unsigned*)(ws + OFF_BAR), bst);

  p0_prologue(p, lds);
  xcd_barrier(gbar);

  {
    pg8::Gemm g{(const bf16_t*)(ws + OFF_XB), (const bf16_t*)(ws + OFF_WIN), 1024, 1024, 1024, (size_t)256 * 1024 * 2, (size_t)256 * 1024 * 2};
    pg8::StaticOrder S; S.init(MTOK, 2560, G, bx);
    Epi1 E{(const float*)(ws + OFF_RS1), (bf16_t*)(ws + OFF_B), (bf16_t*)(ws + OFF_Q), (bf16_t*)(ws + OFF_KV), (float*)(ws + OFF_GATES)};
    pg8::gemm_phase<Epi1, pg8::StaticOrder, true, true>(lds, g, S, E);
  }
  xcd_barrier(gbar);

  {
    const int ncmp = (G > 64) ? 32 : 0;
    if (bx < ncmp) {
      const int kv = bx >> 4, pm = bx & 15;
      pg8::Gemm g{(const bf16_t*)(ws + OFF_KV) + (size_t)kv * 16 * 4096 * 64, (const bf16_t*)(ws + OFF_CW1) + (size_t)kv * 256 * 2048, 1024, 2048, 2048, (size_t)4096 * 64 * 2, 0};
      pg8::SingleUnit S{pm, 0};
      EpiCmp E{(const float*)(ws + OFF_CB1) + kv * 256, (const bf16_t*)(ws + OFF_CW2) + kv * 64 * 256, (bf16_t*)(ws + (kv ? OFF_VC : OFF_KC))};
      pg8::gemm_phase<EpiCmp, pg8::SingleUnit, false, true>(lds, g, S, E);
    } else {
      conv_load_taps(p, lds);
      for (int tile = bx - ncmp; tile < 1024; tile += G - ncmp) conv_tile(p, lds, tile);
    }
    if (ncmp == 0) {
      for (int un = bx; un < 32; un += G) {
        const int kv = un >> 4, pm = un & 15;
        pg8::Gemm g{(const bf16_t*)(ws + OFF_KV) + (size_t)kv * 16 * 4096 * 64, (const bf16_t*)(ws + OFF_CW1) + (size_t)kv * 256 * 2048, 1024, 2048, 2048, (size_t)4096 * 64 * 2, 0};
        pg8::SingleUnit S{pm, 0};
        EpiCmp E{(const float*)(ws + OFF_CB1) + kv * 256, (const bf16_t*)(ws + OFF_CW2) + kv * 64 * 256, (bf16_t*)(ws + (kv ? OFF_VC : OFF_KC))};
        pg8::gemm_phase<EpiCmp, pg8::SingleUnit, false, true>(lds, g, S, E);
      }
    }
  }
  xcd_barrier(gbar);

  {
    const int tid3 = get_tid(), grp = __builtin_amdgcn_readfirstlane(tid3 >> 8);
    if (tid3 < 2) *(LAS unsigned*)(lds + A_CNT + 16 * tid3) = 0u;
    __syncthreads();
    unsigned tgt = 0u;
    const int gt3 = tid3 & 255, lane3 = tid3 & 63;
    const unsigned xcc = xb_xcc_id();
    LAS unsigned* cnt3 = (LAS unsigned*)(lds + A_CNT + 16 * grp);
    if (gt3 == 0) *(LAS int*)(lds + A_NXT + 16 * grp) = queue_pop((unsigned*)(ws + OFF_QCNT), xcc);
    group_sync(cnt3, tgt, lane3);
    int enc = *(const LAS int*)(lds + A_NXT + 16 * grp);
    group_sync(cnt3, tgt, lane3);
    while (enc >= 0) { int nenc = -1; attn_item(p, lds, grp, tgt, enc, nenc, xcc); enc = nenc; }
  }
  xcd_barrier(gbar);

  {
    pg8::Gemm g{(const bf16_t*)(ws + OFF_CAT), (const bf16_t*)(ws + OFF_WOUT), 1024, 1024, 1024, (size_t)256 * 1024 * 2, (size_t)256 * 1024 * 2};
    pg8::StaticOrder S; S.init(MTOK, 1024, G, bx);
    EpiRes<false, true> E{(const bf16_t*)(ws + OFF_XB), p.out, (bf16_t*)(ws + OFF_B), (float*)(ws + OFF_SSQ2)};
    pg8::gemm_phase<EpiRes<false, true>, pg8::StaticOrder, true, true>(lds, g, S, E);
  }
  xcd_barrier(gbar);

  {
    pg8::Gemm g{(const bf16_t*)(ws + OFF_B), (const bf16_t*)(ws + OFF_WFF1), 1024, 1024, 1024, (size_t)256 * 1024 * 2, (size_t)256 * 1024 * 2};
    pg8::StaticOrder S; S.init(MTOK, 4096, G, bx);
    EpiFF1 E{(const float*)(ws + OFF_SSQ2), (bf16_t*)(ws + OFF_H)};
    pg8::gemm_phase<EpiFF1, pg8::StaticOrder, true, true>(lds, g, S, E);
  }
  xcd_barrier(gbar);

  const int fuse_final = (G == 256) ? 1 : 0;
  {
    pg8::Gemm g{(const bf16_t*)(ws + OFF_H), (const bf16_t*)(ws + OFF_WFF2), 4096, 4096, 4096, (size_t)256 * 4096 * 2, (size_t)256 * 4096 * 2};
    pg8::StaticOrder S; S.init(MTOK, 1024, G, bx);
    EpiFinal E{(const bf16_t*)(ws + OFF_B), p.out, (float*)(ws + OFF_SSQ3), (unsigned*)(ws + OFF_PCNT), p.norm_f_g, fuse_final};
    pg8::gemm_phase<EpiFinal, pg8::StaticOrder, true, true>(lds, g, S, E);
  }
  if (!fuse_final) {
    xcd_barrier(gbar);
    const int tid = get_tid(), lane = tid & 63, wid = tid >> 6;
    const float* ssq = (const float*)(ws + OFF_SSQ3);
    f32x4 gn[4];
#pragma unroll
    for (int i = 0; i < 4; ++i) gn[i] = *(const f32x4*)(p.norm_f_g + (lane + 64 * i) * 4);
    for (int r = bx * 8 + wid; r < MTOK; r += G * 8) {
      const float s = __builtin_amdgcn_rsqf(ssq[r] * (1.0f / 1024.0f) + EPSN);
      float* row = p.out + (size_t)r * 1024;
#pragma unroll
      for (int i = 0; i < 4; ++i) { f32x4 v = *(const f32x4*)(row + (lane + 64 * i) * 4); v = v * s * gn[i]; *(f32x4*)(row + (lane + 64 * i) * 4) = v; }
    }
  }
}

extern "C" void kernel_launch(void* const* d_in, const int* in_sizes, int n_in, void* d_out, int out_size, void* d_ws, size_t ws_size, hipStream_t stream) {
  constexpr size_t kDynLds = LDS_BYTES;
  static int grid_blocks = 0;
  if (!grid_blocks) {
    int dev = 0, cus = 0, per_cu = 0;
    (void)hipGetDevice(&dev);
    (void)hipDeviceGetAttribute(&cus, hipDeviceAttributeMultiprocessorCount, dev);
    (void)hipFuncSetAttribute((const void*)fwd_megakernel, hipFuncAttributeMaxDynamicSharedMemorySize, (int)kDynLds);
    (void)hipOccupancyMaxActiveBlocksPerMultiprocessor(&per_cu, (const void*)fwd_megakernel, 512, kDynLds);
    if (per_cu < 1) fprintf(stderr, "kernel_launch: occupancy query says %d blocks per CU\n", per_cu);
    grid_blocks = cus > 0 ? cus : 256;
    if (ws_size < WS_END) fprintf(stderr, "kernel_launch: workspace too small: %zu < %zu\n", ws_size, (size_t)WS_END);
  }
  (void)hipMemsetAsync((unsigned char*)d_ws + OFF_BAR, 0, XCD_BAR_WORDS * 4 + 256 * 256 + 8 * 256, stream);
  Params p{};
  p.x = (const float*)d_in[0]; p.norm1_g = (const float*)d_in[1]; p.w_in = (const float*)d_in[2]; p.dw_w = (const float*)d_in[3]; p.dw_b = (const float*)d_in[4];
  p.cln_g = (const float*)d_in[5]; p.cln_b = (const float*)d_in[6]; p.ck_pe = (const float*)d_in[7]; p.ck_w1 = (const float*)d_in[8]; p.ck_w2 = (const float*)d_in[9];
  p.cv_pe = (const float*)d_in[10]; p.cv_w1 = (const float*)d_in[11]; p.cv_w2 = (const float*)d_in[12]; p.w_out = (const float*)d_in[13]; p.norm2_g = (const float*)d_in[14];
  p.w_ff1 = (const float*)d_in[15]; p.w_ff2 = (const float*)d_in[16]; p.norm_f_g = (const float*)d_in[17];
  p.out = (float*)d_out; p.ws = (unsigned char*)d_ws;
  void* args[] = {&p};
  hipError_t e = hipLaunchCooperativeKernel((const void*)fwd_megakernel, dim3(grid_blocks), dim3(512), args, kDynLds, stream);
  if (e != hipSuccess) fprintf(stderr, "cooperative launch failed: %s (grid %d)\n", hipGetErrorString(e), grid_blocks);
}
```

```cpp
#include <hip/hip_runtime.h>
#include <hip/hip_cooperative_groups.h>
#include <cstdio>
namespace cg = cooperative_groups;

#define LAS __attribute__((address_space(3)))
#define DI __device__ __forceinline__
typedef unsigned short bf16_t;
typedef short bf16x8 __attribute__((ext_vector_type(8)));
typedef short s16x4 __attribute__((ext_vector_type(4)));
typedef float f32x4 __attribute__((ext_vector_type(4)));
typedef float f32x2 __attribute__((ext_vector_type(2)));
typedef float f32x16 __attribute__((ext_vector_type(16)));
typedef unsigned u32x4 __attribute__((ext_vector_type(4)));
typedef unsigned u32x2 __attribute__((ext_vector_type(2)));
typedef __bf16 bf16v2 __attribute__((ext_vector_type(2)));

constexpr float LOG2E = 1.4426950408889634f;
constexpr float EPSN = 1e-6f;
constexpr int LDS_BYTES = 147456;
constexpr int MTOK = 32768, TSEQ = 4096, DM = 1024, DFF = 4096;
constexpr float QSCALE = 0.125f * LOG2E;

constexpr size_t MiB = 1024 * 1024;
constexpr size_t XCD_BAR_WORDS_C = 3456;
constexpr size_t OFF_WIN = 0;
constexpr size_t OFF_WOUT = OFF_WIN + 2560 * 1024 * 2;
constexpr size_t OFF_WFF1 = OFF_WOUT + 1024 * 1024 * 2;
constexpr size_t OFF_WFF2 = OFF_WFF1 + 4096 * 1024 * 2;
constexpr size_t OFF_CW1 = OFF_WFF2 + 4096 * 1024 * 2;
constexpr size_t OFF_CW2 = OFF_CW1 + 2 * 256 * 2048 * 2;
constexpr size_t OFF_CB1 = OFF_CW2 + 2 * 64 * 256 * 2;
constexpr size_t OFF_RS1 = OFF_CB1 + 2 * 256 * 4;
constexpr size_t OFF_SSQ2 = OFF_RS1 + MTOK * 4;
constexpr size_t OFF_SSQ3 = OFF_SSQ2 + MTOK * 4;
constexpr size_t OFF_GATES = OFF_SSQ3 + MTOK * 4;
constexpr size_t OFF_KC = OFF_GATES + (size_t)MTOK * 24 * 4;
constexpr size_t OFF_VC = OFF_KC + 16 * 256 * 64 * 2;
constexpr size_t OFF_BAR = OFF_VC + 16 * 256 * 64 * 2;
constexpr size_t OFF_PCNT = OFF_BAR + XCD_BAR_WORDS_C * 4;
constexpr size_t OFF_QCNT = OFF_PCNT + 256 * 256;
constexpr size_t OFF_B = 30 * MiB;
constexpr size_t OFF_H = 94 * MiB;
constexpr size_t OFF_XB = OFF_H;
constexpr size_t OFF_Q = OFF_H + 64 * MiB;
constexpr size_t OFF_KV = OFF_H + 96 * MiB;
constexpr size_t OFF_CAT = OFF_H + 256 * MiB;
constexpr size_t WS_END = OFF_CAT + 64 * MiB;
static_assert(OFF_QCNT + 8 * 256 <= OFF_B, "ws map");

struct Params {
  const float* x; const float* norm1_g; const float* w_in; const float* dw_w; const float* dw_b; const float* cln_g; const float* cln_b;
  const float* ck_pe; const float* ck_w1; const float* ck_w2; const float* cv_pe; const float* cv_w1; const float* cv_w2;
  const float* w_out; const float* norm2_g; const float* w_ff1; const float* w_ff2; const float* norm_f_g;
  float* out; unsigned char* ws;
};

DI unsigned pk2(float a, float b) { f32x2 v = {a, b}; bf16v2 r = __builtin_convertvector(v, bf16v2); return __builtin_bit_cast(unsigned, r); }
DI float bf2f(unsigned short u) { return __uint_as_float((unsigned)u << 16); }
DI float sigmoidf_(float v) { return __builtin_amdgcn_rcpf(1.0f + __builtin_amdgcn_exp2f(-v * LOG2E)); }
DI float gelu_tanh(float v) { const float u = 0.7978845608028654f * (v + 0.044715f * v * v * v); const float e = __builtin_amdgcn_exp2f(2.0f * LOG2E * u); const float th = 1.0f - 2.0f * __builtin_amdgcn_rcpf(e + 1.0f); return 0.5f * v * (1.0f + th); }
DI float wave_sum(float v) { v += __shfl_xor(v, 1); v += __shfl_xor(v, 2); v += __shfl_xor(v, 4); v += __shfl_xor(v, 8); v += __shfl_xor(v, 16); v += __shfl_xor(v, 32); return v; }

DI void st_nt(u32x4* p, u32x4 v) { __builtin_nontemporal_store(v, p); }
DI void st_nt(f32x4* p, f32x4 v) { __builtin_nontemporal_store(v, p); }
DI int get_tid() { int t = threadIdx.x; asm volatile("" : "+v"(t)); return t; }

#define XB_TMO      128
#define XB_XCNT(j)  (256  + 64 * (j))
#define XB_XSUB(j)  (1280 + 64 * (j))
#define XB_XGEN(j)  (2304 + 64 * (j))
#define XB_TOP      3328
#define XB_TOPGEN   3392
#define XCD_BAR_WORDS 3456
#define XB_SPIN_CAP (1u << 22)
DI unsigned xb_ld(unsigned* p) { return __hip_atomic_load(p, __ATOMIC_RELAXED, __HIP_MEMORY_SCOPE_AGENT); }
DI unsigned xb_add(unsigned* p, unsigned v) { return __hip_atomic_fetch_add(p, v, __ATOMIC_RELAXED, __HIP_MEMORY_SCOPE_AGENT); }
DI unsigned xb_xcc_id() { return (unsigned)__builtin_amdgcn_s_getreg((3 << 11) | 20) & 0xFu; }
#define XB_SPIN(cond, bar) do { unsigned _sp = 0; while (cond) { __builtin_amdgcn_s_sleep(1); \
    if ((++_sp & 255u) == 0u) { if (xb_ld(&(bar)[XB_TMO])) break; if (_sp > XB_SPIN_CAP) { atomicAdd(&(bar)[XB_TMO], 1u); break; } } } } while (0)
struct XcdBarrier { unsigned* bar; unsigned x; volatile LAS unsigned* st; };
DI XcdBarrier xcd_barrier_post(unsigned* bar, volatile LAS unsigned* st) {
  XcdBarrier b; b.bar = bar; b.x = xb_xcc_id(); b.st = st;
  if (threadIdx.x == 0) (void)xb_add(&bar[XB_XCNT(b.x)], 1u);
  return b;
}
DI void xcd_barrier_complete(unsigned* bar, unsigned x, unsigned& nloc, unsigned& nx) {
  const unsigned G = gridDim.x;
  unsigned sum, cnt, mine, sp = 0u;
  for (;;) {
    sum = 0u; cnt = 0u; mine = 0u;
#pragma unroll
    for (unsigned j = 0; j < 16; ++j) { const unsigned c = xb_ld(&bar[XB_XCNT(j)]); sum += c; cnt += (c > 0u) ? 1u : 0u; mine = (j == x) ? c : mine; }
    if (sum == G) break;
    __builtin_amdgcn_s_sleep(1);
    if ((++sp & 255u) == 0u) { if (xb_ld(&bar[XB_TMO])) break; if (sp > XB_SPIN_CAP) { atomicAdd(&bar[XB_TMO], 1u); break; } }
  }
  nloc = mine > 0u ? mine : 1u; nx = cnt > 0u ? cnt : 1u;
}
DI void xcd_barrier(const XcdBarrier& b) {
  asm volatile("s_waitcnt vmcnt(0)" ::: "memory");
  __syncthreads();
  if (threadIdx.x == 0) {
    unsigned* bar = b.bar;
    __builtin_amdgcn_s_waitcnt(0);
    unsigned nloc = b.st[0], nx = b.st[1];
    if (nloc == 0u) { xcd_barrier_complete(bar, b.x, nloc, nx); b.st[0] = nloc; b.st[1] = nx; }
    const unsigned old = xb_add(&bar[XB_XSUB(b.x)], 1u);
    const unsigned gen = old / nloc;
    if (old + 1u == (gen + 1u) * nloc) {
      __builtin_amdgcn_fence(__ATOMIC_RELEASE, "agent");
      asm volatile("s_waitcnt vmcnt(0)" ::: "memory");
      const unsigned og = xb_add(&bar[XB_TOP], 1u);
      const unsigned tg = og / nx;
      if (og + 1u == (tg + 1u) * nx) xb_add(&bar[XB_TOPGEN], 1u);
      else XB_SPIN(xb_ld(&bar[XB_TOPGEN]) == tg, bar);
      __builtin_amdgcn_fence(__ATOMIC_ACQUIRE, "agent");
      xb_add(&bar[XB_XGEN(b.x)], 1u);
      asm volatile("s_waitcnt vmcnt(0)" ::: "memory");
    } else {
      XB_SPIN(xb_ld(&bar[XB_XGEN(b.x)]) == gen, bar);
      __builtin_amdgcn_fence(__ATOMIC_ACQUIRE, "agent");
      asm volatile("s_waitcnt vmcnt(0)" ::: "memory");
    }
  }
  __syncthreads();
}
namespace pg8 {
constexpr int BM = 256, BK = 64, HALF = 128, HTB = HALF * BK * 2, STAGE_BYTES = 8 * HTB, NXCD = 8, WGM = 8;
DI int lds_byte(int r, int c) { const int st = (r >> 4) * 2 + (c >> 5), rr = r & 15, cc = c & 31, ob = rr * 64 + cc * 2; return st * 1024 + (ob ^ (((ob >> 9) & 1) << 5)); }
DI void stage_rc(int b, int& R, int& C) { const int st = b / 1024, sb = b % 1024, swz = sb ^ (((sb >> 9) & 1) << 5); R = (st >> 1) * 16 + swz / 64; C = (st & 1) * 32 + (swz % 64) / 2; }
DI int perm32(int rho) { const int n = rho >> 4, i = rho & 15; return 8 * (i >> 2) + 4 * n + (i & 3); }

struct Unit { int pm, pn; };
struct Gemm { const bf16_t* A; const bf16_t* Bt; int lda, ldb, K; size_t tstepA, tstepB; };

struct StaticOrder {
  int nM, nN, nwg, G, c;
  DI void init(int M, int N, int G_, int c_) { nM = M / BM; nN = N / BM; nwg = nM * nN; G = G_; c = c_; }
  DI bool next(int i, Unit& u) const {
    const long L = (long)i * G + c; if (L >= nwg) return false;
    int wgid = (int)L; { const int q = nwg / NXCD, r = nwg % NXCD, xcd = wgid % NXCD, off = wgid / NXCD; wgid = (xcd < r ? xcd * (q + 1) : r * (q + 1) + (xcd - r) * q) + off; }
    const int nig = WGM * nN, gid = wgid / nig, fm = gid * WGM, gsz = (nM - fm) < WGM ? (nM - fm) : WGM;
    u.pm = fm + ((wgid % nig) % gsz); u.pn = (wgid % nig) / gsz; return true;
  }
};
struct SingleUnit {
  int pm, pn;
  DI bool next(int i, Unit& u) const { if (i != 0) return false; u.pm = pm; u.pn = pn; return true; }
};

template <class Epi, class Sched, bool ALIGN_EPI = false, bool SP2 = false>
DI void gemm_phase(LAS unsigned char* lds, const Gemm g, const Sched& S, const Epi& E) {
  const int tid = get_tid(), wid = __builtin_amdgcn_readfirstlane(tid >> 6), lane = tid & 63, wr = wid >> 2, wc = wid & 3, fr = lane & 15, fq = lane >> 4;
  const int K = g.K, nt = K / BK;
  unsigned voffA[2], voffB[2];
#pragma unroll
  for (int i = 0; i < 2; ++i) { int R, C; stage_rc(tid * 16 + i * 8192, R, C); const int Rb = Epi::PERM ? ((R & ~31) + perm32(R & 31)) : R;
    voffA[i] = (unsigned)(R * g.lda + C) * 2u; voffB[i] = (unsigned)(Rb * g.ldb + C) * 2u; }
  const size_t kstep = (size_t)(BK * 2);
  const size_t hstepA = (size_t)HALF * g.lda * 2, hstepB = (size_t)HALF * g.ldb * 2;
  const unsigned ldsw = (unsigned)wid * 1024u;
  const int aoff = lds_byte(wr * 64 + fr, fq * 8), boff = lds_byte(wc * 32 + fr, fq * 8);
#define PG8_SA(b, h) (((b) * 2 + (h)) * HTB)
#define PG8_SB(b, h) ((4 + (b) * 2 + (h)) * HTB)
#define PG8_STAGE(bufoff, gbase, voff) do { _Pragma("unroll") for (int _i = 0; _i < 2; ++_i) \
    __builtin_amdgcn_global_load_lds((const unsigned*)((const char*)(gbase) + (voff)[_i]), (LAS unsigned*)(lds + (bufoff) + ldsw + _i * 8192), 16, 0, 0); } while (0)
#define PG8_LDA(dst, b, h) do { _Pragma("unroll") for (int m = 0; m < 4; ++m) _Pragma("unroll") for (int k = 0; k < 2; ++k) dst[m][k] = *(const LAS bf16x8*)(lds + PG8_SA(b, h) + aoff + m * 2048 + k * 1024); } while (0)
#define PG8_LDB(dst, b, h) do { _Pragma("unroll") for (int n = 0; n < 2; ++n) _Pragma("unroll") for (int k = 0; k < 2; ++k) dst[n][k] = *(const LAS bf16x8*)(lds + PG8_SB(b, h) + boff + n * 2048 + k * 1024); } while (0)
#define PG8_MMA(ai, bj, At, Bt) do { __builtin_amdgcn_s_setprio(1); _Pragma("unroll") for (int m = 0; m < 4; ++m) _Pragma("unroll") for (int n = 0; n < 2; ++n) _Pragma("unroll") for (int k = 0; k < 2; ++k) \
    acc[ai][bj][m][n] = __builtin_amdgcn_mfma_f32_16x16x32_bf16(Bt[n][k], At[m][k], acc[ai][bj][m][n], 0, 0, 0); __builtin_amdgcn_s_setprio(0); } while (0)
#define PG8_WAIT_V(n) asm volatile("s_waitcnt vmcnt(" #n ")" ::: "memory")
#define PG8_WAIT_L(n) asm volatile("s_waitcnt lgkmcnt(" #n ")" ::: "memory")
#define PG8_BAR __builtin_amdgcn_s_barrier()
#define PG8_SCHED __builtin_amdgcn_sched_barrier(0)
  Unit cur, nxt; int ui = 0;
  if (!S.next(0, cur)) return;
  f32x4 acc[2][2][4][2];
#pragma unroll
  for (int a = 0; a < 2; ++a)
#pragma unroll
    for (int b = 0; b < 2; ++b)
#pragma unroll
      for (int m = 0; m < 4; ++m)
#pragma unroll
        for (int n = 0; n < 2; ++n) acc[a][b][m][n] = (f32x4){0.f, 0.f, 0.f, 0.f};
  bf16x8 At[4][2], B0[2][2], B1[2][2];
  const char* cA = (const char*)g.A + (size_t)cur.pm * g.tstepA; const char* cB = (const char*)g.Bt + (size_t)cur.pn * g.tstepB;
  if constexpr (SP2) {
    PG8_STAGE(PG8_SB(0, 0), cB, voffB); PG8_STAGE(PG8_SB(0, 1), cB + hstepB, voffB); PG8_STAGE(PG8_SA(0, 0), cA, voffA); PG8_STAGE(PG8_SA(0, 1), cA + hstepA, voffA);
    if (wr == 1) PG8_BAR;
    PG8_WAIT_V(2); PG8_BAR;
    PG8_STAGE(PG8_SB(1, 0), cB + kstep, voffB); PG8_STAGE(PG8_SA(1, 0), cA + kstep, voffA); PG8_STAGE(PG8_SB(1, 1), cB + hstepB + kstep, voffB);
    PG8_WAIT_V(6); PG8_BAR;
  } else {
    PG8_STAGE(PG8_SB(0, 0), cB, voffB); PG8_STAGE(PG8_SA(0, 0), cA, voffA); PG8_STAGE(PG8_SB(0, 1), cB + hstepB, voffB); PG8_STAGE(PG8_SA(0, 1), cA + hstepA, voffA);
    if (wr == 1) PG8_BAR;
    PG8_WAIT_V(4); PG8_BAR;
    PG8_STAGE(PG8_SB(1, 0), cB + kstep, voffB); PG8_STAGE(PG8_SA(1, 0), cA + kstep, voffA); PG8_STAGE(PG8_SB(1, 1), cB + hstepB + kstep, voffB);
    PG8_WAIT_V(6); PG8_BAR;
  }
  for (;;) {
    const bool has_next = S.next(ui + 1, nxt);
    const char* nA = has_next ? (const char*)g.A + (size_t)nxt.pm * g.tstepA : cA; const char* nB = has_next ? (const char*)g.Bt + (size_t)nxt.pn * g.tstepB : cB;
    for (int t = 0; t < nt; t += 2) {
      const bool last = (t == nt - 2);
      const char* a1 = cA + (size_t)(t + 1) * kstep;
      const char* a2 = last ? nA : cA + (size_t)(t + 2) * kstep; const char* b2 = last ? nB : cB + (size_t)(t + 2) * kstep;
      const char* a3 = a2 + kstep; const char* b3 = b2 + kstep;
      if constexpr (SP2) {
        PG8_LDB(B0, 0, 0); PG8_LDB(B1, 0, 1); PG8_SCHED; PG8_LDA(At, 0, 0); PG8_STAGE(PG8_SA(1, 1), a1 + hstepA, voffA);
        PG8_WAIT_V(8); PG8_WAIT_L(0); PG8_BAR; PG8_MMA(0, 0, At, B0); PG8_MMA(0, 1, At, B1); PG8_BAR; PG8_SCHED;
        PG8_LDA(At, 0, 1); PG8_STAGE(PG8_SB(0, 0), b2, voffB); PG8_STAGE(PG8_SB(0, 1), b2 + hstepB, voffB); PG8_STAGE(PG8_SA(0, 0), a2, voffA);
        PG8_WAIT_V(8); PG8_WAIT_L(0); PG8_BAR; PG8_MMA(1, 0, At, B0); PG8_MMA(1, 1, At, B1); PG8_BAR; PG8_SCHED;
        PG8_LDB(B0, 1, 0); PG8_LDB(B1, 1, 1); PG8_SCHED; PG8_LDA(At, 1, 0); PG8_STAGE(PG8_SA(0, 1), a2 + hstepA, voffA);
        PG8_WAIT_V(8); PG8_WAIT_L(0); PG8_BAR; PG8_MMA(0, 0, At, B0); PG8_MMA(0, 1, At, B1); PG8_BAR; PG8_SCHED;
        PG8_LDA(At, 1, 1); PG8_STAGE(PG8_SB(1, 0), b3, voffB); PG8_STAGE(PG8_SB(1, 1), b3 + hstepB, voffB); PG8_STAGE(PG8_SA(1, 0), a3, voffA);
        PG8_WAIT_V(8); PG8_WAIT_L(0); PG8_BAR; PG8_MMA(1, 0, At, B0); PG8_MMA(1, 1, At, B1); PG8_BAR; PG8_SCHED;
      } else {
        PG8_LDB(B0, 0, 0); PG8_SCHED; PG8_LDA(At, 0, 0); PG8_STAGE(PG8_SA(1, 1), a1 + hstepA, voffA);
        PG8_WAIT_L(8); PG8_BAR; PG8_WAIT_L(0); PG8_MMA(0, 0, At, B0); PG8_BAR; PG8_SCHED;
        PG8_LDB(B1, 0, 1); PG8_STAGE(PG8_SB(0, 0), b2, voffB);
        PG8_BAR; PG8_WAIT_L(0); PG8_MMA(0, 1, At, B1); PG8_BAR;
        PG8_LDA(At, 0, 1); PG8_STAGE(PG8_SA(0, 0), a2, voffA);
        PG8_BAR; PG8_WAIT_L(0); PG8_MMA(1, 0, At, B0); PG8_BAR; PG8_SCHED;
        PG8_STAGE(PG8_SB(0, 1), b2 + hstepB, voffB);
        PG8_WAIT_V(6); PG8_BAR; PG8_MMA(1, 1, At, B1); PG8_BAR;
        PG8_LDB(B0, 1, 0); PG8_SCHED; PG8_LDA(At, 1, 0); PG8_STAGE(PG8_SA(0, 1), a2 + hstepA, voffA);
        PG8_WAIT_L(8); PG8_BAR; PG8_WAIT_L(0); PG8_MMA(0, 0, At, B0); PG8_BAR; PG8_SCHED;
        PG8_LDB(B1, 1, 1); PG8_STAGE(PG8_SB(1, 0), b3, voffB);
        PG8_BAR; PG8_WAIT_L(0); PG8_MMA(0, 1, At, B1); PG8_BAR;
        PG8_LDA(At, 1, 1); PG8_STAGE(PG8_SA(1, 0), a3, voffA);
        PG8_BAR; PG8_WAIT_L(0); PG8_MMA(1, 0, At, B0); PG8_BAR; PG8_SCHED;
        PG8_STAGE(PG8_SB(1, 1), b3 + hstepB, voffB);
        PG8_WAIT_V(6); PG8_BAR; PG8_MMA(1, 1, At, B1); PG8_BAR;
      }
    }
    if constexpr (ALIGN_EPI) { if (wr == 0) PG8_BAR; }
    if constexpr (!Epi::AFTER_DRAIN) { E(acc, cur, wr, wc, fr, fq); }
    if (!has_next) break;
#pragma unroll
    for (int a = 0; a < 2; ++a)
#pragma unroll
      for (int b = 0; b < 2; ++b)
#pragma unroll
        for (int m = 0; m < 4; ++m)
#pragma unroll
          for (int n = 0; n < 2; ++n) acc[a][b][m][n] = (f32x4){0.f, 0.f, 0.f, 0.f};
    cur = nxt; cA = nA; cB = nB; ++ui;
    if constexpr (ALIGN_EPI) { if (wr == 1) PG8_BAR; }
  }
  PG8_WAIT_V(0);
  if constexpr (!ALIGN_EPI) { if (wr == 0) PG8_BAR; }
  PG8_BAR;
  if constexpr (Epi::AFTER_DRAIN) { E.fused(acc, cur, wr, wc, fr, fq, lds, wid, lane); }
#undef PG8_SA
#undef PG8_SB
#undef PG8_STAGE
#undef PG8_LDA
#undef PG8_LDB
#undef PG8_MMA
#undef PG8_WAIT_V
#undef PG8_WAIT_L
#undef PG8_BAR
#undef PG8_SCHED
}
}

struct Epi1 {
  static constexpr bool PERM = true, AFTER_DRAIN = false;
  const float* rs; bf16_t* uv; bf16_t* q; bf16_t* kv; float* gates;
  DI void operator()(const f32x4 (&acc)[2][2][4][2], const pg8::Unit& u, int wr, int wc, int fr, int fq) const {
    const int pn = u.pn;
#pragma unroll
    for (int ai = 0; ai < 2; ++ai)
#pragma unroll
      for (int m = 0; m < 4; ++m) {
        const int r = u.pm * 256 + ai * 128 + wr * 64 + m * 16 + fr;
        const float s = rs[r];
#pragma unroll
        for (int bj = 0; bj < 2; ++bj) {
          const int cl = bj * 128 + wc * 32 + 8 * fq;
          f32x4 v0 = acc[ai][bj][m][0] * s, v1 = acc[ai][bj][m][1] * s;
          if (pn < 4) {
            u32x4 w; w.x = pk2(v0[0], v0[1]); w.y = pk2(v0[2], v0[3]); w.z = pk2(v1[0], v1[1]); w.w = pk2(v1[2], v1[3]);
            *(u32x4*)(uv + (size_t)r * 1024 + pn * 256 + cl) = w;
          } else if (pn < 6) {
            v0 = v0 * QSCALE; v1 = v1 * QSCALE;
            u32x4 w; w.x = pk2(v0[0], v0[1]); w.y = pk2(v0[2], v0[3]); w.z = pk2(v1[0], v1[1]); w.w = pk2(v1[2], v1[3]);
            *(u32x4*)(q + (size_t)r * 512 + (pn - 4) * 256 + cl) = w;
          } else if (pn < 9) {
            const int kvidx = (pn - 6) * 256 + cl, br = kvidx >> 7, gg = (kvidx >> 6) & 1, d = kvidx & 63, b = r >> 12, t = r & 4095;
            u32x4 w; w.x = pk2(v0[0], v0[1]); w.y = pk2(v0[2], v0[3]); w.z = pk2(v1[0], v1[1]); w.w = pk2(v1[2], v1[3]);
            *(u32x4*)(kv + ((size_t)(((br * 8 + b) * 2 + gg) * 4096 + t)) * 64 + d) = w;
          } else {
            if (cl < 24) {
              f32x4 g0, g1;
#pragma unroll
              for (int j = 0; j < 4; ++j) { g0[j] = sigmoidf_(v0[j]); g1[j] = sigmoidf_(v1[j]); }
              *(f32x4*)(gates + (size_t)r * 24 + cl) = g0; *(f32x4*)(gates + (size_t)r * 24 + cl + 4) = g1;
            }
          }
        }
      }
  }
};
template <bool WRITE_IO, bool WRITE_B> struct EpiRes {
  static constexpr bool PERM = true, AFTER_DRAIN = false;
  const bf16_t* base; float* io; bf16_t* xb; float* ssq;
  DI void operator()(const f32x4 (&acc)[2][2][4][2], const pg8::Unit& u, int wr, int wc, int fr, int fq) const {
#pragma unroll
    for (int ai = 0; ai < 2; ++ai)
#pragma unroll
      for (int m = 0; m < 4; ++m) {
        const int r = u.pm * 256 + ai * 128 + wr * 64 + m * 16 + fr;
        float ss = 0.f;
#pragma unroll
        for (int bj = 0; bj < 2; ++bj) {
          const size_t off = (size_t)r * 1024 + u.pn * 256 + bj * 128 + wc * 32 + 8 * fq;
          const u32x4 xw = *(const u32x4*)(base + off);
          const f32x4 b0 = (f32x4){__uint_as_float(xw.x << 16), __uint_as_float(xw.x & 0xffff0000u), __uint_as_float(xw.y << 16), __uint_as_float(xw.y & 0xffff0000u)};
          const f32x4 b1 = (f32x4){__uint_as_float(xw.z << 16), __uint_as_float(xw.z & 0xffff0000u), __uint_as_float(xw.w << 16), __uint_as_float(xw.w & 0xffff0000u)};
          const f32x4 v0 = acc[ai][bj][m][0] + b0, v1 = acc[ai][bj][m][1] + b1;
          if (WRITE_IO) { *(f32x4*)(io + off) = v0; *(f32x4*)(io + off + 4) = v1; }
          if (WRITE_B) { u32x4 w; w.x = pk2(v0[0], v0[1]); w.y = pk2(v0[2], v0[3]); w.z = pk2(v1[0], v1[1]); w.w = pk2(v1[2], v1[3]); *(u32x4*)(xb + off) = w; }
          ss += (v0[0] * v0[0] + v0[1] * v0[1]) + (v0[2] * v0[2] + v0[3] * v0[3]) + (v1[0] * v1[0] + v1[1] * v1[1]) + (v1[2] * v1[2] + v1[3] * v1[3]);
        }
        ss += __shfl_xor(ss, 16); ss += __shfl_xor(ss, 32);
        if (fq == 0) atomicAdd(ssq + r, ss);
      }
  }
};
struct EpiFF1 {
  static constexpr bool PERM = true, AFTER_DRAIN = false;
  const float* ssq; bf16_t* hid;
  DI void operator()(const f32x4 (&acc)[2][2][4][2], const pg8::Unit& u, int wr, int wc, int fr, int fq) const {
#pragma unroll
    for (int ai = 0; ai < 2; ++ai)
#pragma unroll
      for (int m = 0; m < 4; ++m) {
        const int r = u.pm * 256 + ai * 128 + wr * 64 + m * 16 + fr;
        const float s = __builtin_amdgcn_rsqf(ssq[r] * (1.0f / 1024.0f) + EPSN);
#pragma unroll
        for (int bj = 0; bj < 2; ++bj) {
          f32x4 v0 = acc[ai][bj][m][0] * s, v1 = acc[ai][bj][m][1] * s;
#pragma unroll
          for (int j = 0; j < 4; ++j) { const float a = fmaxf(v0[j], 0.f), b = fmaxf(v1[j], 0.f); v0[j] = a * a; v1[j] = b * b; }
          u32x4 w; w.x = pk2(v0[0], v0[1]); w.y = pk2(v0[2], v0[3]); w.z = pk2(v1[0], v1[1]); w.w = pk2(v1[2], v1[3]);
          st_nt((u32x4*)(hid + (size_t)r * 4096 + u.pn * 256 + bj * 128 + wc * 32 + 8 * fq), w);
        }
      }
  }
};
struct EpiFinal {
  static constexpr bool PERM = true, AFTER_DRAIN = false;
  const bf16_t* xb; float* io; float* ssq; unsigned* cnt; const float* gn; int fuse;
  DI void operator()(f32x4 (&acc)[2][2][4][2], const pg8::Unit& u, int wr, int wc, int fr, int fq) const {
#pragma unroll
    for (int ai = 0; ai < 2; ++ai)
#pragma unroll
      for (int m = 0; m < 4; ++m) {
        const int r = u.pm * 256 + ai * 128 + wr * 64 + m * 16 + fr;
        float ss = 0.f;
#pragma unroll
        for (int bj = 0; bj < 2; ++bj) {
          const size_t off = (size_t)r * 1024 + u.pn * 256 + bj * 128 + wc * 32 + 8 * fq;
          const u32x4 xw = *(const u32x4*)(xb + off);
          const f32x4 b0 = (f32x4){__uint_as_float(xw.x << 16), __uint_as_float(xw.x & 0xffff0000u), __uint_as_float(xw.y << 16), __uint_as_float(xw.y & 0xffff0000u)};
          const f32x4 b1 = (f32x4){__uint_as_float(xw.z << 16), __uint_as_float(xw.z & 0xffff0000u), __uint_as_float(xw.w << 16), __uint_as_float(xw.w & 0xffff0000u)};
          const f32x4 v0 = acc[ai][bj][m][0] + b0, v1 = acc[ai][bj][m][1] + b1;
          acc[ai][bj][m][0] = v0; acc[ai][bj][m][1] = v1;
          if (!fuse) { *(f32x4*)(io + off) = v0; *(f32x4*)(io + off + 4) = v1; }
          ss += (v0[0] * v0[0] + v0[1] * v0[1]) + (v0[2] * v0[2] + v0[3] * v0[3]) + (v1[0] * v1[0] + v1[1] * v1[1]) + (v1[2] * v1[2] + v1[3] * v1[3]);
        }
        ss += __shfl_xor(ss, 16); ss += __shfl_xor(ss, 32);
        if (fq == 0) atomicAdd(ssq + r, ss);
      }
    if (!fuse) return;
    asm volatile("s_waitcnt vmcnt(0)" ::: "memory");
    unsigned* c = cnt + 64 * (u.pm * 2 + wr);
    if (fr == 0 && fq == 0) __hip_atomic_fetch_add(c, 1u, __ATOMIC_RELAXED, __HIP_MEMORY_SCOPE_AGENT);
    { unsigned sp = 0; while ((unsigned)__builtin_amdgcn_readfirstlane(__hip_atomic_load(c, __ATOMIC_RELAXED, __HIP_MEMORY_SCOPE_AGENT)) < 16u) { __builtin_amdgcn_s_sleep(2); if (++sp > (1u << 22)) break; } }
    f32x4 g[2][2];
#pragma unroll
    for (int bj = 0; bj < 2; ++bj)
#pragma unroll
      for (int n = 0; n < 2; ++n) g[bj][n] = *(const f32x4*)(gn + u.pn * 256 + bj * 128 + wc * 32 + 8 * fq + 4 * n);
#pragma unroll
    for (int ai = 0; ai < 2; ++ai)
#pragma unroll
      for (int m = 0; m < 4; ++m) {
        const int r = u.pm * 256 + ai * 128 + wr * 64 + m * 16 + fr;
        const float s = __builtin_amdgcn_rsqf(__hip_atomic_load(ssq + r, __ATOMIC_RELAXED, __HIP_MEMORY_SCOPE_AGENT) * (1.0f / 1024.0f) + EPSN);
#pragma unroll
        for (int bj = 0; bj < 2; ++bj) {
          const size_t off = (size_t)r * 1024 + u.pn * 256 + bj * 128 + wc * 32 + 8 * fq;
          st_nt((f32x4*)(io + off), acc[ai][bj][m][0] * s * g[bj][0]); st_nt((f32x4*)(io + off + 4), acc[ai][bj][m][1] * s * g[bj][1]);
        }
      }
  }
};
constexpr int HSTR = 528;
struct EpiCmp {
  static constexpr bool PERM = false, AFTER_DRAIN = true;
  const float* bias1; const bf16_t* w2t; bf16_t* outp;
  DI void fused(const f32x4 (&acc)[2][2][4][2], const pg8::Unit& u, int wr, int wc, int fr, int fq, LAS unsigned char* lds, int wid, int lane) const {
#pragma unroll
    for (int bj = 0; bj < 2; ++bj)
#pragma unroll
      for (int n = 0; n < 2; ++n) {
        const int c = bj * 128 + wc * 32 + n * 16 + 4 * fq;
        const f32x4 bv = *(const f32x4*)(bias1 + c);
#pragma unroll
        for (int ai = 0; ai < 2; ++ai)
#pragma unroll
          for (int m = 0; m < 4; ++m) {
            const int r = ai * 128 + wr * 64 + m * 16 + fr;
            const f32x4 v = acc[ai][bj][m][n] + bv;
            u32x2 w; w.x = pk2(gelu_tanh(v[0]), gelu_tanh(v[1])); w.y = pk2(gelu_tanh(v[2]), gelu_tanh(v[3]));
            *(LAS u32x2*)(lds + r * HSTR + c * 2) = w;
          }
      }
    __syncthreads();
    f32x4 o[2][4];
#pragma unroll
    for (int mb = 0; mb < 2; ++mb)
#pragma unroll
      for (int nb = 0; nb < 4; ++nb) o[mb][nb] = (f32x4){0.f, 0.f, 0.f, 0.f};
    bf16x8 wf[8][4];
#pragma unroll
    for (int ks = 0; ks < 8; ++ks)
#pragma unroll
      for (int nb = 0; nb < 4; ++nb) wf[ks][nb] = *(const bf16x8*)(w2t + (16 * nb + fr) * 256 + 32 * ks + 8 * fq);
#pragma unroll
    for (int ks = 0; ks < 8; ++ks) {
      bf16x8 hf[2];
#pragma unroll
      for (int mb = 0; mb < 2; ++mb) hf[mb] = *(const LAS bf16x8*)(lds + (32 * wid + 16 * mb + fr) * HSTR + (32 * ks + 8 * fq) * 2);
#pragma unroll
      for (int mb = 0; mb < 2; ++mb)
#pragma unroll
        for (int nb = 0; nb < 4; ++nb) o[mb][nb] = __builtin_amdgcn_mfma_f32_16x16x32_bf16(wf[ks][nb], hf[mb], o[mb][nb], 0, 0, 0);
    }
#pragma unroll
    for (int mb = 0; mb < 2; ++mb)
#pragma unroll
      for (int nb = 0; nb < 4; ++nb) {
        const int row = 32 * wid + 16 * mb + fr;
        u32x2 w; w.x = pk2(o[mb][nb][0], o[mb][nb][1]); w.y = pk2(o[mb][nb][2], o[mb][nb][3]);
        *(u32x2*)(outp + ((size_t)u.pm * 256 + row) * 64 + 16 * nb + 4 * fq) = w;
      }
    __syncthreads();
  }
};

struct TJob { const float* src; bf16_t* dst; const float* g; int K, N, kt, nt; };
DI TJob transpose_job(const Params& p, int job) {
  unsigned char* ws = p.ws; TJob t;
  if (job < 640) t = TJob{p.w_in, (bf16_t*)(ws + OFF_WIN), p.norm1_g, 1024, 2328, job / 40, job % 40};
  else if (job < 896) { const int j = job - 640; t = TJob{p.w_out, (bf16_t*)(ws + OFF_WOUT), nullptr, 1024, 1024, j / 16, j % 16}; }
  else if (job < 1920) { const int j = job - 896; t = TJob{p.w_ff1, (bf16_t*)(ws + OFF_WFF1), p.norm2_g, 1024, 4096, j / 64, j % 64}; }
  else if (job < 2944) { const int j = job - 1920; t = TJob{p.w_ff2, (bf16_t*)(ws + OFF_WFF2), nullptr, 4096, 1024, j / 16, j % 16}; }
  else if (job < 3072) { const int j = job - 2944; t = TJob{p.ck_w1, (bf16_t*)(ws + OFF_CW1), nullptr, 2048, 256, j / 4, j % 4}; }
  else if (job < 3200) { const int j = job - 3072; t = TJob{p.cv_w1, (bf16_t*)(ws + OFF_CW1) + 256 * 2048, nullptr, 2048, 256, j / 4, j % 4}; }
  else if (job < 3204) { const int j = job - 3200; t = TJob{p.ck_w2, (bf16_t*)(ws + OFF_CW2), nullptr, 256, 64, j, 0}; }
  else { const int j = job - 3204; t = TJob{p.cv_w2, (bf16_t*)(ws + OFF_CW2) + 64 * 256, nullptr, 256, 64, j, 0}; }
  return t;
}
DI void transpose_pair(const TJob& ta, const TJob& tb, bool has_b, LAS float* tl) {
  const int tid = get_tid();
  f32x4 va[2], vb[2];
#pragma unroll
  for (int i = 0; i < 2; ++i) {
    const int idx = tid + 512 * i, row = idx >> 4, c4 = idx & 15;
    { const int n = ta.nt * 64 + 4 * c4; va[i] = (f32x4){0.f, 0.f, 0.f, 0.f}; if (n < ta.N) va[i] = *(const f32x4*)(ta.src + (size_t)(ta.kt * 64 + row) * ta.N + n); if (ta.g) va[i] = va[i] * ta.g[ta.kt * 64 + row]; }
    vb[i] = (f32x4){0.f, 0.f, 0.f, 0.f};
    if (has_b) { const int n = tb.nt * 64 + 4 * c4; if (n < tb.N) vb[i] = *(const f32x4*)(tb.src + (size_t)(tb.kt * 64 + row) * tb.N + n); if (tb.g) vb[i] = vb[i] * tb.g[tb.kt * 64 + row]; }
  }
#pragma unroll
  for (int i = 0; i < 2; ++i) {
    const int idx = tid + 512 * i, row = idx >> 4, c4 = idx & 15;
#pragma unroll
    for (int e = 0; e < 4; ++e) { tl[row * 65 + 4 * c4 + e] = va[i][e]; tl[4160 + row * 65 + 4 * c4 + e] = vb[i][e]; }
  }
  __syncthreads();
  {
    const int nrow = tid >> 3, kc = tid & 7;
    float e[8];
#pragma unroll
    for (int j = 0; j < 8; ++j) e[j] = tl[(8 * kc + j) * 65 + nrow];
    u32x4 w; w.x = pk2(e[0], e[1]); w.y = pk2(e[2], e[3]); w.z = pk2(e[4], e[5]); w.w = pk2(e[6], e[7]);
    *(u32x4*)(ta.dst + (size_t)(ta.nt * 64 + nrow) * ta.K + ta.kt * 64 + 8 * kc) = w;
    if (has_b) {
#pragma unroll
      for (int j = 0; j < 8; ++j) e[j] = tl[4160 + (8 * kc + j) * 65 + nrow];
      w.x = pk2(e[0], e[1]); w.y = pk2(e[2], e[3]); w.z = pk2(e[4], e[5]); w.w = pk2(e[6], e[7]);
      *(u32x4*)(tb.dst + (size_t)(tb.nt * 64 + nrow) * tb.K + tb.kt * 64 + 8 * kc) = w;
    }
  }
  __syncthreads();
}

DI void p0_prologue(const Params& p, LAS unsigned char* lds) {
  const int tid = get_tid(), lane = tid & 63, wid = tid >> 6, G = gridDim.x, bx = blockIdx.x;
  unsigned char* ws = p.ws;
  {
    bf16_t* xb = (bf16_t*)(ws + OFF_XB); float* rs1 = (float*)(ws + OFF_RS1);
    for (int r0 = (bx * 8 + wid) * 4; r0 < MTOK; r0 += G * 32) {
      f32x4 a[4][2], c[4][2];
#pragma unroll
      for (int rr = 0; rr < 4; ++rr)
#pragma unroll
        for (int i = 0; i < 2; ++i) { const float* s = p.x + (size_t)(r0 + rr) * 1024 + (lane + 64 * i) * 8; a[rr][i] = __builtin_nontemporal_load((const f32x4*)s); c[rr][i] = __builtin_nontemporal_load((const f32x4*)(s + 4)); }
#pragma unroll
      for (int rr = 0; rr < 4; ++rr) {
        float ss = 0.f;
#pragma unroll
        for (int i = 0; i < 2; ++i) {
          const f32x4 av = a[rr][i], bv = c[rr][i];
          ss += (av[0] * av[0] + av[1] * av[1]) + (av[2] * av[2] + av[3] * av[3]) + (bv[0] * bv[0] + bv[1] * bv[1]) + (bv[2] * bv[2] + bv[3] * bv[3]);
          u32x4 w; w.x = pk2(av[0], av[1]); w.y = pk2(av[2], av[3]); w.z = pk2(bv[0], bv[1]); w.w = pk2(bv[2], bv[3]);
          *(u32x4*)(xb + (size_t)(r0 + rr) * 1024 + (lane + 64 * i) * 8) = w;
        }
        ss = wave_sum(ss);
        if (lane == 0) rs1[r0 + rr] = __builtin_amdgcn_rsqf(ss * (1.0f / 1024.0f) + EPSN);
      }
    }
  }
  { float* z = (float*)(ws + OFF_SSQ2); for (int i = bx * 512 + tid; i < 2 * MTOK; i += G * 512) z[i] = 0.f; }
  for (int pair = bx; pair < 256; pair += G) {
    LAS float* red = (LAS float*)lds;
    const int kv = pair >> 7, n = (pair & 127) * 2 + (tid & 1), ksl = tid >> 1;
    const float* pe = kv ? p.cv_pe : p.ck_pe; const float* w1 = kv ? p.cv_w1 : p.ck_w1;
    float s = 0.f;
#pragma unroll
    for (int k = 0; k < 8; ++k) s += pe[ksl * 8 + k] * w1[(size_t)(ksl * 8 + k) * 256 + n];
    s += __shfl_xor(s, 2); s += __shfl_xor(s, 4); s += __shfl_xor(s, 8); s += __shfl_xor(s, 16); s += __shfl_xor(s, 32);
    if (lane < 2) red[wid * 2 + lane] = s;
    __syncthreads();
    if (tid < 2) { float t = 0.f; for (int i = 0; i < 8; ++i) t += red[i * 2 + tid]; ((float*)(ws + OFF_CB1))[kv * 256 + (pair & 127) * 2 + tid] = t; }
    __syncthreads();
  }
  for (int job = bx; job < 3208; job += 2 * G) {
    const bool has_b = (job + G) < 3208;
    const TJob ta = transpose_job(p, job), tb = transpose_job(p, has_b ? job + G : job);
    transpose_pair(ta, tb, has_b, (LAS float*)lds);
  }
}

constexpr int USTR = 1040;
constexpr int YSTR = 516;
constexpr int C_WOFF = 66560;
DI void conv_load_taps(const Params& p, LAS unsigned char* lds) {
  LAS float* Wp = (LAS float*)(lds + C_WOFF);
  for (int idx = get_tid(); idx < 32 * 256; idx += 512) {
    const int w = idx >> 8, cp = idx & 255;
    f32x2 t = (f32x2){0.f, 0.f};
    if (w < 31) t = *(const f32x2*)(p.dw_w + w * 512 + 2 * cp);
    *(LAS f32x2*)(Wp + ((w >> 2) * 256 + cp) * 8 + (w & 3) * 2) = t;
  }
}
DI void conv_tile(const Params& p, LAS unsigned char* lds, int tile) {
  const int tid = get_tid(), lane = tid & 63, wid = tid >> 6;
  const int b = tile >> 7, t0 = (tile & 127) * 32;
  const bf16_t* uv = (const bf16_t*)(p.ws + OFF_B);
  bf16_t* cat = (bf16_t*)(p.ws + OFF_CAT);
  LAS unsigned char* U = lds; LAS float* Y = (LAS float*)lds;
  const LAS float* Wp = (const LAS float*)(lds + C_WOFF);
  {
    u32x4 vv[8], gv[8];
#pragma unroll
    for (int it = 0; it < 8; ++it) {
      const int idx = tid + 512 * it, row = idx >> 6, ch = idx & 63, t = t0 - 30 + row;
      const int tc = t < 0 ? 0 : (row < 62 ? t : t0);
      const size_t m = (size_t)b * 4096 + tc;
      vv[it] = *(const u32x4*)(uv + m * 1024 + ch * 8); gv[it] = *(const u32x4*)(uv + m * 1024 + 512 + ch * 8);
    }
#pragma unroll
    for (int it = 0; it < 8; ++it) {
      const int idx = tid + 512 * it, row = idx >> 6, ch = idx & 63, t = t0 - 30 + row;
      u32x4 w = (u32x4){0u, 0u, 0u, 0u};
      if (t >= 0 && row < 62) {
#pragma unroll
        for (int j = 0; j < 4; ++j) {
          const float v0 = __uint_as_float(vv[it][j] << 16), v1 = __uint_as_float(vv[it][j] & 0xffff0000u), g0 = __uint_as_float(gv[it][j] << 16), g1 = __uint_as_float(gv[it][j] & 0xffff0000u);
          w[j] = pk2(v0 * sigmoidf_(g0), v1 * sigmoidf_(g1));
        }
      }
      if (row < 63) *(LAS u32x4*)(U + row * USTR + ch * 16) = w;
    }
  }
  __syncthreads();
  const int half = tid >> 8, cp = tid & 255;
  float a0[16], a1[16];
  {
    const f32x2 bias = *(const f32x2*)(p.dw_b + 2 * cp);
#pragma unroll
    for (int o = 0; o < 16; ++o) { a0[o] = bias.x; a1[o] = bias.y; }
#pragma unroll
    for (int og = 0; og < 2; ++og) {
      const LAS unsigned char* ub = U + (half * 16 + og * 8) * USTR + cp * 4;
#pragma unroll 1
      for (int w4 = 0; w4 < 8; ++w4) {
        const f32x4 wa = *(const LAS f32x4*)(Wp + (w4 * 256 + cp) * 8), wb = *(const LAS f32x4*)(Wp + (w4 * 256 + cp) * 8 + 4);
        const float wt0[4] = {wa[0], wa[2], wb[0], wb[2]}, wt1[4] = {wa[1], wa[3], wb[1], wb[3]};
        float u0[11], u1[11];
#pragma unroll
        for (int r = 0; r < 11; ++r) { const unsigned uu = *(const LAS unsigned*)(ub + (w4 * 4 + r) * USTR); u0[r] = __uint_as_float(uu << 16); u1[r] = __uint_as_float(uu & 0xffff0000u); }
#pragma unroll
        for (int o = 0; o < 8; ++o)
#pragma unroll
          for (int k = 0; k < 4; ++k) { a0[og * 8 + o] += u0[o + k] * wt0[k]; a1[og * 8 + o] += u1[o + k] * wt1[k]; }
      }
    }
  }
  __syncthreads();
#pragma unroll
  for (int o = 0; o < 16; ++o) *(LAS f32x2*)(Y + (half * 16 + o) * YSTR + 2 * cp) = (f32x2){a0[o], a1[o]};
  __syncthreads();
  {
    const f32x4 g0 = *(const f32x4*)(p.cln_g + lane * 8), g1 = *(const f32x4*)(p.cln_g + lane * 8 + 4), b0 = *(const f32x4*)(p.cln_b + lane * 8), b1 = *(const f32x4*)(p.cln_b + lane * 8 + 4);
#pragma unroll
    for (int i = 0; i < 4; ++i) {
      const int tok = wid * 4 + i;
      const f32x4 y0 = *(const LAS f32x4*)(Y + tok * YSTR + lane * 8), y1 = *(const LAS f32x4*)(Y + tok * YSTR + lane * 8 + 4);
      float s = (y0[0] + y0[1]) + (y0[2] + y0[3]) + (y1[0] + y1[1]) + (y1[2] + y1[3]);
      s = wave_sum(s);
      const float mu = s * (1.0f / 512.0f);
      const f32x4 d0 = y0 - mu, d1 = y1 - mu;
      float q = (d0[0] * d0[0] + d0[1] * d0[1]) + (d0[2] * d0[2] + d0[3] * d0[3]) + (d1[0] * d1[0] + d1[1] * d1[1]) + (d1[2] * d1[2] + d1[3] * d1[3]);
      q = wave_sum(q);
      const float rstd = __builtin_amdgcn_rsqf(q * (1.0f / 512.0f) + EPSN);
      f32x4 o0 = d0 * rstd * g0 + b0, o1 = d1 * rstd * g1 + b1;
#pragma unroll
      for (int j = 0; j < 4; ++j) { o0[j] = o0[j] * sigmoidf_(o0[j]); o1[j] = o1[j] * sigmoidf_(o1[j]); }
      u32x4 w; w.x = pk2(o0[0], o0[1]); w.y = pk2(o0[2], o0[3]); w.z = pk2(o1[0], o1[1]); w.w = pk2(o1[2], o1[3]);
      *(u32x4*)(cat + ((size_t)b * 4096 + t0 + tok) * 1024 + lane * 8) = w;
    }
  }
  __syncthreads();
}

constexpr int KVSTR = 144;
constexpr int VSTR = 144;
constexpr int A_GRP = 4 * 64 * KVSTR;
constexpr int A_KOFF = 0, A_VOFF = 2 * 64 * KVSTR;
constexpr int A_SLAB = 2 * A_GRP;
constexpr int SLAB_FLOATS = 32 * 65;
constexpr int A_SEL = A_SLAB + 8 * SLAB_FLOATS * 4;
constexpr int A_OR = A_SEL + 512;
constexpr int A_CNT = A_OR + 16;
constexpr int A_NXT = A_CNT + 32;
constexpr int A_LINV = A_NXT + 32;
static_assert(A_LINV + 1024 <= LDS_BYTES - 16, "attention LDS map");

DI void group_sync(LAS unsigned* cnt, unsigned& tgt, int lane) {
  tgt += 4u;
  __builtin_amdgcn_fence(__ATOMIC_RELEASE, "workgroup");
  if (lane == 0) __hip_atomic_fetch_add(cnt, 1u, __ATOMIC_RELAXED, __HIP_MEMORY_SCOPE_WORKGROUP);
  while ((int)(__hip_atomic_load(cnt, __ATOMIC_RELAXED, __HIP_MEMORY_SCOPE_WORKGROUP) - tgt) < 0) __builtin_amdgcn_s_sleep(0);
  __builtin_amdgcn_fence(__ATOMIC_ACQUIRE, "workgroup");
}

constexpr float ATT_THR = 8.0f;
template <int KIND, bool MASKED>
DI void attn_scores(LAS unsigned char* kbuf, int jc, const bf16x8 (&qf)[4], float slope2, float sc, int tq, int jt, unsigned long long mymask, float mref, f32x16 (&S)[2], int q, int h) {
  float base2; int kmin = -1, kmax = 64;
  if (KIND <= 1) {
    const int lim = 64 * jt + tq - 31 - 1024 * jc - 64 * h;
    base2 = -slope2 * (float)lim - mref; kmax = lim >> 4;
  } else {
    base2 = slope2 * (float)(64 * (jc - jt) + 4 * h - tq) - mref;
    if (MASKED && jc == jt) kmax = tq - 4 * h;
    if (MASKED && KIND == 3 && jc == jt - 8) kmin = tq - 4 * h;
    if (KIND == 2) base2 = ((mymask >> jc) & 1ull) ? base2 : -1e30f;
  }
#pragma unroll
  for (int kb = 0; kb < 2; ++kb) {
#pragma unroll
    for (int i = 0; i < 16; ++i) S[kb][i] = __builtin_fmaf(sc, (float)(32 * kb + 8 * (i >> 2) + (i & 3)), base2);
#pragma unroll
    for (int ks = 0; ks < 4; ++ks) {
      const bf16x8 kf = *(const LAS bf16x8*)(kbuf + (32 * kb + q) * KVSTR + 32 * ks + 16 * h);
      S[kb] = __builtin_amdgcn_mfma_f32_32x32x16_bf16(kf, qf[ks], S[kb], 0, 0, 0);
    }
  }
  if (MASKED) {
    const unsigned range = (unsigned)(kmax - kmin);
#pragma unroll
    for (int kb = 0; kb < 2; ++kb)
#pragma unroll
      for (int i = 0; i < 16; ++i) {
        const int keyc = 32 * kb + 8 * (i >> 2) + (i & 3);
        const bool ok = (kmax > kmin) && ((unsigned)(keyc - kmin - 1) < range);
        S[kb][i] = ok ? S[kb][i] : -INFINITY;
      }
  }
}
DI float attn_exp_sum(f32x16 (&S)[2]) {
  float ps = 0.f;
#pragma unroll
  for (int kb = 0; kb < 2; ++kb)
#pragma unroll
    for (int i = 0; i < 16; ++i) { const float pv = __builtin_amdgcn_exp2f(S[kb][i]); S[kb][i] = pv; ps += pv; asm volatile("" : "+v"(ps)); }
  return ps;
}
constexpr float ATT_SUM_CAP = 16777216.0f;
template <int KIND, bool MASKED>
DI void attn_tile(LAS unsigned char* kbuf, LAS unsigned char* vbuf, int jc, const bf16x8 (&qf)[4], float slope2, float sc, int tq, int jt, unsigned long long mymask,
                  float& m_run, float& l_run, float l2inv, f32x16 (&O)[2], LAS float* slab, int q, int h, int q4, int p4, int g1) {
  f32x16 S[2];
  attn_scores<KIND, MASKED>(kbuf, jc, qf, slope2, sc, tq, jt, mymask, m_run, S, q, h);
  {
    float ps = attn_exp_sum(S);
    if (__any(!(ps < ATT_SUM_CAP))) {
      asm volatile("s_nop 0" ::: "memory");
      attn_scores<KIND, MASKED>(kbuf, jc, qf, slope2, sc, tq, jt, mymask, m_run, S, q, h);
      float mx = fmaxf(S[0][0], S[1][0]);
#pragma unroll
      for (int i = 1; i < 16; ++i) mx = fmaxf(fmaxf(mx, S[0][i]), S[1][i]);
      mx = fmaxf(mx, __shfl_xor(mx, 32));
      const float d = fmaxf(mx, 0.f), alpha = __builtin_amdgcn_exp2f(-d);
      m_run += d; l_run *= alpha;
#pragma unroll
      for (int kb = 0; kb < 2; ++kb)
#pragma unroll
        for (int i = 0; i < 16; ++i) S[kb][i] -= d;
      if (KIND != 0) {
#pragma unroll
        for (int db = 0; db < 2; ++db)
#pragma unroll
          for (int i = 0; i < 16; ++i) O[db][i] *= alpha;
      }
      if (KIND == 1) { for (int jj = h; jj < 65; jj += 2) slab[q * 65 + jj] *= alpha; }
      ps = attn_exp_sum(S);
    }
    l_run += ps;
  }
  if (KIND == 1) {
#pragma unroll
    for (int kb = 0; kb < 2; ++kb)
#pragma unroll
      for (int gi = 0; gi < 4; ++gi) {
        const int jm = 16 * jc + 8 * kb + 2 * gi + h;
        float s4 = S[kb][4 * gi] + S[kb][4 * gi + 1]; asm volatile("" : "+v"(s4)); s4 += S[kb][4 * gi + 2]; asm volatile("" : "+v"(s4)); s4 += S[kb][4 * gi + 3];
        __hip_atomic_fetch_add(slab + q * 65 + jm, s4, __ATOMIC_RELAXED, __HIP_MEMORY_SCOPE_WORKGROUP);
        __hip_atomic_fetch_add(slab + q * 65 + jm + 1, S[kb][4 * gi + 3], __ATOMIC_RELAXED, __HIP_MEMORY_SCOPE_WORKGROUP);
      }
  }
  if (KIND != 0) {
#pragma unroll
    for (int kb = 0; kb < 2; ++kb)
#pragma unroll
      for (int s = 0; s < 2; ++s) {
        u32x4 pw;
        pw.x = pk2(S[kb][8 * s + 0], S[kb][8 * s + 1]); pw.y = pk2(S[kb][8 * s + 2], S[kb][8 * s + 3]);
        pw.z = pk2(S[kb][8 * s + 4], S[kb][8 * s + 5]); pw.w = pk2(S[kb][8 * s + 6], S[kb][8 * s + 7]);
        const bf16x8 pf = __builtin_bit_cast(bf16x8, pw);
#pragma unroll
        for (int db = 0; db < 2; ++db) {
          LAS unsigned char* va = vbuf + (32 * kb + 16 * s + 4 * h + q4) * VSTR + (32 * db + 16 * g1) * 2 + 8 * p4;
          const s16x4 lo = __builtin_amdgcn_ds_read_tr16_b64_v4i16((LAS s16x4*)va);
          const s16x4 hi = __builtin_amdgcn_ds_read_tr16_b64_v4i16((LAS s16x4*)(va + 8 * VSTR));
          const bf16x8 vf = __builtin_shufflevector(lo, hi, 0, 1, 2, 3, 4, 5, 6, 7);
          O[db] = __builtin_amdgcn_mfma_f32_32x32x16_bf16(vf, pf, O[db], 0, 0, 0);
        }
      }
  }
}

template <int KIND>
DI void attn_branch(LAS unsigned char* gl, LAS unsigned* cnt, unsigned& tgt, const bf16_t* Kg, const bf16_t* Vg, unsigned long long tmask, const bf16x8 (&qf)[4], float slope2, int tq, int jt,
                    unsigned long long mymask, float& m_run, float& l_run, float invl, f32x16 (&O)[2], LAS float* slab) {
  const int gt = get_tid() & 255, lane = gt & 63, q = lane & 31, h = lane >> 5;
  const int i16 = lane & 15, q4 = i16 >> 2, p4 = i16 & 3, g1 = (lane >> 4) & 1;
  const float sc = (KIND <= 1) ? slope2 * 16.0f : slope2;
  const int woff = (gt >> 3) * KVSTR + (gt & 7) * 16;
  int j = __builtin_ctzll(tmask); tmask &= tmask - 1;
  const u32x4 z4 = (u32x4){0u, 0u, 0u, 0u};
  u32x4 ka = *(const u32x4*)(Kg + (size_t)j * 4096 + gt * 8), kb = *(const u32x4*)(Kg + (size_t)j * 4096 + 2048 + gt * 8), va = z4, vb = z4;
  if (KIND != 0) { va = *(const u32x4*)(Vg + (size_t)j * 4096 + gt * 8); vb = *(const u32x4*)(Vg + (size_t)j * 4096 + 2048 + gt * 8); }
  int buf = 0;
  for (;;) {
    LAS unsigned char* kbuf = gl + A_KOFF + buf * (64 * KVSTR); LAS unsigned char* vbuf = gl + A_VOFF + buf * (64 * VSTR);
    *(LAS u32x4*)(kbuf + woff) = ka; *(LAS u32x4*)(kbuf + 32 * KVSTR + woff) = kb;
    if (KIND != 0) { *(LAS u32x4*)(vbuf + woff) = va; *(LAS u32x4*)(vbuf + 32 * VSTR + woff) = vb; }
    group_sync(cnt, tgt, lane);
    const int jc = j;
    const bool more = (tmask != 0ull);
    if (more) {
      j = __builtin_ctzll(tmask); tmask &= tmask - 1;
      ka = *(const u32x4*)(Kg + (size_t)j * 4096 + gt * 8); kb = *(const u32x4*)(Kg + (size_t)j * 4096 + 2048 + gt * 8);
      if (KIND != 0) { va = *(const u32x4*)(Vg + (size_t)j * 4096 + gt * 8); vb = *(const u32x4*)(Vg + (size_t)j * 4096 + 2048 + gt * 8); }
    }
    if (KIND <= 1 || jc == jt || (KIND == 3 && jc == jt - 8)) attn_tile<KIND, true>(kbuf, vbuf, jc, qf, slope2, sc, tq, jt, mymask, m_run, l_run, invl, O, slab, q, h, q4, p4, g1);
    else attn_tile<KIND, (KIND <= 1)>(kbuf, vbuf, jc, qf, slope2, sc, tq, jt, mymask, m_run, l_run, invl, O, slab, q, h, q4, p4, g1);
    buf ^= 1;
    if (!more) break;
  }
  group_sync(cnt, tgt, lane);
}

DI int queue_pop(unsigned* qbase, unsigned xcc) {
  for (unsigned qq = 0; qq < 8u; ++qq) {
    const unsigned x2 = (xcc + qq) & 7u;
    const unsigned i = __hip_atomic_fetch_add(qbase + 64 * x2, 1u, __ATOMIC_RELAXED, __HIP_MEMORY_SCOPE_AGENT);
    if (i < 256u) return (int)(x2 * 256u + i);
  }
  return -1;
}
DI void attn_item(const Params& p, LAS unsigned char* lds, int grp, unsigned& tgt, int enc, int& nenc, unsigned xcc) {
  const int gt = get_tid() & 255, lane = gt & 63, hh = __builtin_amdgcn_readfirstlane(gt >> 6), q = lane & 31, h = lane >> 5;
  const int bg = 2 * (enc >> 8) + (enc & 1), jt32 = 127 - ((enc & 255) >> 1);
  int popv = -1;
  if (gt == 0) popv = queue_pop((unsigned*)(p.ws + OFF_QCNT), xcc);
  const int b = bg >> 1, g = bg & 1, head = g * 4 + hh, jt = jt32 >> 1, tq = (jt32 & 1) * 32 + q, t = jt * 64 + tq;
  const size_t mrow = (size_t)b * 4096 + t;
  const bf16_t* Qp = (const bf16_t*)(p.ws + OFF_Q);
  const bf16_t* KV = (const bf16_t*)(p.ws + OFF_KV);
  const float* gates = (const float*)(p.ws + OFF_GATES);
  bf16_t* cat = (bf16_t*)(p.ws + OFF_CAT);
  float* osc = (float*)(p.ws + OFF_B) + mrow * 512 + head * 64 + 4 * h;
  LAS unsigned char* gl = lds + grp * A_GRP;
  LAS float* slab = (LAS float*)(lds + A_SLAB) + (grp * 4 + hh) * SLAB_FLOATS;
  LAS unsigned long long* selm = (LAS unsigned long long*)(lds + A_SEL) + grp * 32;
  LAS unsigned long long* orm = (LAS unsigned long long*)(lds + A_OR) + grp;
  LAS unsigned* cnt = (LAS unsigned*)(lds + A_CNT + 16 * grp);
  for (int i = lane; i < SLAB_FLOATS; i += 64) slab[i] = 0.f;
  if (gt == 0) *orm = 0ull;
  bf16x8 qf[4];
#pragma unroll
  for (int ks = 0; ks < 4; ++ks) qf[ks] = *(const bf16x8*)(Qp + mrow * 512 + head * 64 + 16 * ks + 8 * h);
  const float slope2 = __builtin_amdgcn_exp2f(-(float)(head + 1)) * LOG2E;
  const float g_cmp = gates[mrow * 24 + head * 3 + 0], g_sel = gates[mrow * 24 + head * 3 + 1], g_win = gates[mrow * 24 + head * 3 + 2];
  const size_t bgoff = (size_t)bg * 4096 * 64;
  const bf16_t* Ksel = KV + (size_t)2 * 16 * 4096 * 64 + bgoff; const bf16_t* Vsel = KV + (size_t)3 * 16 * 4096 * 64 + bgoff;
  const bf16_t* Kwin = KV + (size_t)4 * 16 * 4096 * 64 + bgoff; const bf16_t* Vwin = KV + (size_t)5 * 16 * 4096 * 64 + bgoff;
  const bf16_t* Kc = (const bf16_t*)(p.ws + OFF_KC) + (size_t)bg * 256 * 64; const bf16_t* Vc = (const bf16_t*)(p.ws + OFF_VC) + (size_t)bg * 256 * 64;
  f32x16 O[2];
#pragma unroll
  for (int db = 0; db < 2; ++db)
#pragma unroll
    for (int i = 0; i < 16; ++i) O[db][i] = 0.f;
  {
    const int ncmp = 4 * jt + 2 * (jt32 & 1) + 1, ntile = (ncmp + 63) >> 6;
    const unsigned long long cm = (1ull << ntile) - 1ull;
    float m_run = 0.f, l_run = 0.f;
    attn_branch<1>(gl, cnt, tgt, Kc, Vc, cm, qf, slope2, tq, jt, 0ull, m_run, l_run, 0.f, O, slab);
    const float lt = l_run + __shfl_xor(l_run, 32);
    const float invl = lt > 0.f ? __builtin_amdgcn_rcpf(lt) : 0.f;
    if (h == 0) ((LAS float*)(lds + A_LINV))[(grp * 4 + hh) * 32 + q] = invl;
    const float gsc = g_cmp * invl;
#pragma unroll
    for (int db = 0; db < 2; ++db)
#pragma unroll
      for (int gi = 0; gi < 4; ++gi) {
        *(f32x4*)(osc + 32 * db + 8 * gi) = (f32x4){O[db][4 * gi], O[db][4 * gi + 1], O[db][4 * gi + 2], O[db][4 * gi + 3]} * gsc;
        O[db][4 * gi] = 0.f; O[db][4 * gi + 1] = 0.f; O[db][4 * gi + 2] = 0.f; O[db][4 * gi + 3] = 0.f;
      }
  }
  group_sync(cnt, tgt, lane);
  {
    const LAS float* slabs = (const LAS float*)(lds + A_SLAB) + grp * 4 * SLAB_FLOATS;
    unsigned long long worm = 0ull;
    for (int tt = 0; tt < 8; ++tt) {
      const int tok = hh * 8 + tt;
      float v = 0.f;
#pragma unroll
      for (int h2 = 0; h2 < 4; ++h2) v += slabs[h2 * SLAB_FLOATS + tok * 65 + lane] * ((const LAS float*)(lds + A_LINV))[(grp * 4 + h2) * 32 + tok];
      if (lane == 0 || lane == jt || lane == jt - 1) v = 1e30f; else if (lane > jt) v = -1e30f;
      unsigned key = __float_as_uint(v); key = (key & 0x80000000u) ? ~key : (key | 0x80000000u);
      unsigned prefix = 0u;
#pragma unroll
      for (int bit = 31; bit >= 0; --bit) {
        const unsigned cand = prefix | (1u << bit);
        const unsigned long long mge = __ballot(key >= cand);
        prefix = (__popcll(mge) >= 16) ? cand : prefix;
      }
      const unsigned long long mgt = __ballot(key > prefix), meq = __ballot(key == prefix);
      const int need = 16 - __popcll(mgt);
      const int rank_eq = __popcll(meq & ((1ull << lane) - 1ull));
      const unsigned long long msk = mgt | __ballot((key == prefix) && (rank_eq < need));
      if (lane == 0) selm[tok] = msk;
      worm |= msk;
    }
    if (lane == 0) atomicOr((unsigned long long*)orm, worm);
  }
  if (gt == 0) *(LAS int*)(lds + A_NXT + 16 * grp) = popv;
  group_sync(cnt, tgt, lane);
  nenc = *(const LAS int*)(lds + A_NXT + 16 * grp);
  const unsigned long long mymask = selm[q];
  const unsigned long long ormask = *orm;
  const unsigned long long causal = (jt >= 63) ? ~0ull : ((2ull << jt) - 1ull);
  const int jlo = jt >= 8 ? jt - 8 : 0;
  {
    float m_run = 0.f, l_run = 0.f;
    attn_branch<2>(gl, cnt, tgt, Ksel, Vsel, ormask & causal, qf, slope2, tq, jt, mymask, m_run, l_run, 0.f, O, slab);
    const float lt = l_run + __shfl_xor(l_run, 32);
    const float sc = lt > 0.f ? g_sel / lt : 0.f;
#pragma unroll
    for (int db = 0; db < 2; ++db)
#pragma unroll
      for (int gi = 0; gi < 4; ++gi) {
        const f32x4 pv = *(const f32x4*)(osc + 32 * db + 8 * gi);
        *(f32x4*)(osc + 32 * db + 8 * gi) = pv + (f32x4){O[db][4 * gi], O[db][4 * gi + 1], O[db][4 * gi + 2], O[db][4 * gi + 3]} * sc;
        O[db][4 * gi] = 0.f; O[db][4 * gi + 1] = 0.f; O[db][4 * gi + 2] = 0.f; O[db][4 * gi + 3] = 0.f;
      }
  }
  {
    const unsigned long long wm = causal & ~((1ull << jlo) - 1ull);
    float m_run = 0.f, l_run = 0.f;
    attn_branch<3>(gl, cnt, tgt, Kwin, Vwin, wm, qf, slope2, tq, jt, 0ull, m_run, l_run, 0.f, O, slab);
    const float lt = l_run + __shfl_xor(l_run, 32);
    const float sc = lt > 0.f ? g_win / lt : 0.f;
#pragma unroll
    for (int db = 0; db < 2; ++db)
#pragma unroll
      for (int gi = 0; gi < 4; ++gi) {
        const f32x4 v = *(const f32x4*)(osc + 32 * db + 8 * gi) + (f32x4){O[db][4 * gi], O[db][4 * gi + 1], O[db][4 * gi + 2], O[db][4 * gi + 3]} * sc;
        u32x2 w; w.x = pk2(v[0], v[1]); w.y = pk2(v[2], v[3]);
        *(u32x2*)(cat + mrow * 1024 + 512 + head * 64 + 32 * db + 8 * gi + 4 * h) = w;
      }
  }
}

__global__ void __launch_bounds__(512, 2) fwd_megakernel(Params p) {
  extern __shared__ __attribute__((aligned(16))) unsigned char smem[];
  LAS unsigned char* lds = (LAS unsigned char*)smem;
  cg::grid_group grid = cg::this_grid();
  const int G = gridDim.x, bx = blockIdx.x;
  unsigned char* ws = p.ws;
  if (p.ws == nullptr) grid.sync();
  volatile LAS unsigned* bst = (volatile LAS unsigned*)(lds + LDS_BYTES - 16);
  if (threadIdx.x == 0) { bst[0] = 0u; bst[1] = 0u; }
  __syncthreads();
  const XcdBarrier gbar = xcd_barrier_post((unsigned*)(ws + OFF_BAR), bst);

  p0_prologue(p, lds);
  xcd_barrier(gbar);

  {
    pg8::Gemm g{(const bf16_t*)(ws + OFF_XB), (const bf16_t*)(ws + OFF_WIN), 1024, 1024, 1024, (size_t)256 * 1024 * 2, (size_t)256 * 1024 * 2};
    pg8::StaticOrder S; S.init(MTOK, 2560, G, bx);
    Epi1 E{(const float*)(ws + OFF_RS1), (bf16_t*)(ws + OFF_B), (bf16_t*)(ws + OFF_Q), (bf16_t*)(ws + OFF_KV), (float*)(ws + OFF_GATES)};
    pg8::gemm_phase<Epi1, pg8::StaticOrder, true, true>(lds, g, S, E);
  }
  xcd_barrier(gbar);

  {
    const int ncmp = (G > 64) ? 32 : 0;
    if (bx < ncmp) {
      const int kv = bx >> 4, pm = bx & 15;
      pg8::Gemm g{(const bf16_t*)(ws + OFF_KV) + (size_t)kv * 16 * 4096 * 64, (const bf16_t*)(ws + OFF_CW1) + (size_t)kv * 256 * 2048, 1024, 2048, 2048, (size_t)4096 * 64 * 2, 0};
      pg8::SingleUnit S{pm, 0};
      EpiCmp E{(const float*)(ws + OFF_CB1) + kv * 256, (const bf16_t*)(ws + OFF_CW2) + kv * 64 * 256, (bf16_t*)(ws + (kv ? OFF_VC : OFF_KC))};
      pg8::gemm_phase<EpiCmp, pg8::SingleUnit, false, true>(lds, g, S, E);
    } else {
      conv_load_taps(p, lds);
      for (int tile = bx - ncmp; tile < 1024; tile += G - ncmp) conv_tile(p, lds, tile);
    }
    if (ncmp == 0) {
      for (int un = bx; un < 32; un += G) {
        const int kv = un >> 4, pm = un & 15;
        pg8::Gemm g{(const bf16_t*)(ws + OFF_KV) + (size_t)kv * 16 * 4096 * 64, (const bf16_t*)(ws + OFF_CW1) + (size_t)kv * 256 * 2048, 1024, 2048, 2048, (size_t)4096 * 64 * 2, 0};
        pg8::SingleUnit S{pm, 0};
        EpiCmp E{(const float*)(ws + OFF_CB1) + kv * 256, (const bf16_t*)(ws + OFF_CW2) + kv * 64 * 256, (bf16_t*)(ws + (kv ? OFF_VC : OFF_KC))};
        pg8::gemm_phase<EpiCmp, pg8::SingleUnit, false, true>(lds, g, S, E);
      }
    }
  }
  xcd_barrier(gbar);

  {
    const int tid3 = get_tid(), grp = __builtin_amdgcn_readfirstlane(tid3 >> 8);
    if (tid3 < 2) *(LAS unsigned*)(lds + A_CNT + 16 * tid3) = 0u;
    __syncthreads();
    unsigned tgt = 0u;
    const int gt3 = tid3 & 255, lane3 = tid3 & 63;
    const unsigned xcc = xb_xcc_id();
    LAS unsigned* cnt3 = (LAS unsigned*)(lds + A_CNT + 16 * grp);
    if (gt3 == 0) *(LAS int*)(lds + A_NXT + 16 * grp) = queue_pop((unsigned*)(ws + OFF_QCNT), xcc);
    group_sync(cnt3, tgt, lane3);
    int enc = *(const LAS int*)(lds + A_NXT + 16 * grp);
    group_sync(cnt3, tgt, lane3);
    while (enc >= 0) { int nenc = -1; attn_item(p, lds, grp, tgt, enc, nenc, xcc); enc = nenc; }
  }
  xcd_barrier(gbar);

  {
    pg8::Gemm g{(const bf16_t*)(ws + OFF_CAT), (const bf16_t*)(ws + OFF_WOUT), 1024, 1024, 1024, (size_t)256 * 1024 * 2, (size_t)256 * 1024 * 2};
    pg8::StaticOrder S; S.init(MTOK, 1024, G, bx);
    EpiRes<false, true> E{(const bf16_t*)(ws + OFF_XB), p.out, (bf16_t*)(ws + OFF_B), (float*)(ws + OFF_SSQ2)};
    pg8::gemm_phase<EpiRes<false, true>, pg8::StaticOrder, true, true>(lds, g, S, E);
  }
  xcd_barrier(gbar);

  {
    pg8::Gemm g{(const bf16_t*)(ws + OFF_B), (const bf16_t*)(ws + OFF_WFF1), 1024, 1024, 1024, (size_t)256 * 1024 * 2, (size_t)256 * 1024 * 2};
    pg8::StaticOrder S; S.init(MTOK, 4096, G, bx);
    EpiFF1 E{(const float*)(ws + OFF_SSQ2), (bf16_t*)(ws + OFF_H)};
    pg8::gemm_phase<EpiFF1, pg8::StaticOrder, true, true>(lds, g, S, E);
  }
  xcd_barrier(gbar);

  const int fuse_final = (G == 256) ? 1 : 0;
  {
    pg8::Gemm g{(const bf16_t*)(ws + OFF_H), (const bf16_t*)(ws + OFF_WFF2), 4096, 4096, 4096, (size_t)256 * 4096 * 2, (size_t)256 * 4096 * 2};
    pg8::StaticOrder S; S.init(MTOK, 1024, G, bx);
    EpiFinal E{(const bf16_t*)(ws + OFF_B), p.out, (float*)(ws + OFF_SSQ3), (unsigned*)(ws + OFF_PCNT), p.norm_f_g, fuse_final};
    pg8::gemm_phase<EpiFinal, pg8::StaticOrder, true, true>(lds, g, S, E);
  }
  if (!fuse_final) {
    xcd_barrier(gbar);
    const int tid = get_tid(), lane = tid & 63, wid = tid >> 6;
    const float* ssq = (const float*)(ws + OFF_SSQ3);
    f32x4 gn[4];
#pragma unroll
    for (int i = 0; i < 4; ++i) gn[i] = *(const f32x4*)(p.norm_f_g + (lane + 64 * i) * 4);
    for (int r = bx * 8 + wid; r < MTOK; r += G * 8) {
      const float s = __builtin_amdgcn_rsqf(ssq[r] * (1.0f / 1024.0f) + EPSN);
      float* row = p.out + (size_t)r * 1024;
#pragma unroll
      for (int i = 0; i < 4; ++i) { f32x4 v = *(const f32x4*)(row + (lane + 64 * i) * 4); v = v * s * gn[i]; *(f32x4*)(row + (lane + 64 * i) * 4) = v; }
    }
  }
}

extern "C" void kernel_launch(void* const* d_in, const int* in_sizes, int n_in, void* d_out, int out_size, void* d_ws, size_t ws_size, hipStream_t stream) {
  constexpr size_t kDynLds = LDS_BYTES;
  static int grid_blocks = 0;
  if (!grid_blocks) {
    int dev = 0, cus = 0, per_cu = 0;
    (void)hipGetDevice(&dev);
    (void)hipDeviceGetAttribute(&cus, hipDeviceAttributeMultiprocessorCount, dev);
    (void)hipFuncSetAttribute((const void*)fwd_megakernel, hipFuncAttributeMaxDynamicSharedMemorySize, (int)kDynLds);
    (void)hipOccupancyMaxActiveBlocksPerMultiprocessor(&per_cu, (const void*)fwd_megakernel, 512, kDynLds);
    if (per_cu < 1) fprintf(stderr, "kernel_launch: occupancy query says %d blocks per CU\n", per_cu);
    grid_blocks = cus > 0 ? cus : 256;
    if (ws_size < WS_END) fprintf(stderr, "kernel_launch: workspace too small: %zu < %zu\n", ws_size, (size_t)WS_END);
  }
  (void)hipMemsetAsync((unsigned char*)d_ws + OFF_BAR, 0, XCD_BAR_WORDS * 4 + 256 * 256 + 8 * 256, stream);
  Params p{};
  p.x = (const float*)d_in[0]; p.norm1_g = (const float*)d_in[1]; p.w_in = (const float*)d_in[2]; p.dw_w = (const float*)d_in[3]; p.dw_b = (const float*)d_in[4];
  p.cln_g = (const float*)d_in[5]; p.cln_b = (const float*)d_in[6]; p.ck_pe = (const float*)d_in[7]; p.ck_w1 = (const float*)d_in[8]; p.ck_w2 = (const float*)d_in[9];
  p.cv_pe = (const float*)d_in[10]; p.cv_w1 = (const float*)d_in[11]; p.cv_w2 = (const float*)d_in[12]; p.w_out = (const float*)d_in[13]; p.norm2_g = (const float*)d_in[14];
  p.w_ff1 = (const float*)d_in[15]; p.w_ff2 = (const float*)d_in[16]; p.norm_f_g = (const float*)d_in[17];
  p.out = (float*)d_out; p.ws = (unsigned char*)d_ws;
  void* args[] = {&p};
  hipError_t e = hipLaunchCooperativeKernel((const void*)fwd_megakernel, dim3(grid_blocks), dim3(512), args, kDynLds, stream);
  if (e != hipSuccess) fprintf(stderr, "cooperative launch failed: %s (grid %d)\n", hipGetErrorString(e), grid_blocks);
}
```

```cpp
#include <hip/hip_runtime.h>
#include <hip/hip_cooperative_groups.h>
#include <cstdio>
namespace cg = cooperative_groups;

#define LAS __attribute__((address_space(3)))
#define DI __device__ __forceinline__
typedef unsigned short bf16_t;
typedef short bf16x8 __attribute__((ext_vector_type(8)));
typedef short s16x4 __attribute__((ext_vector_type(4)));
typedef float f32x4 __attribute__((ext_vector_type(4)));
typedef float f32x2 __attribute__((ext_vector_type(2)));
typedef float f32x16 __attribute__((ext_vector_type(16)));
typedef unsigned u32x4 __attribute__((ext_vector_type(4)));
typedef unsigned u32x2 __attribute__((ext_vector_type(2)));
typedef __bf16 bf16v2 __attribute__((ext_vector_type(2)));

constexpr float LOG2E = 1.4426950408889634f;
constexpr float EPSN = 1e-6f;
constexpr int LDS_BYTES = 147456;
constexpr int MTOK = 32768, TSEQ = 4096, DM = 1024, DFF = 4096;
constexpr float QSCALE = 0.125f * LOG2E;

constexpr size_t MiB = 1024 * 1024;
constexpr size_t XCD_BAR_WORDS_C = 3456;
constexpr size_t OFF_WIN = 0;
constexpr size_t OFF_WOUT = OFF_WIN + 2560 * 1024 * 2;
constexpr size_t OFF_WFF1 = OFF_WOUT + 1024 * 1024 * 2;
constexpr size_t OFF_WFF2 = OFF_WFF1 + 4096 * 1024 * 2;
constexpr size_t OFF_CW1 = OFF_WFF2 + 4096 * 1024 * 2;
constexpr size_t OFF_CW2 = OFF_CW1 + 2 * 256 * 2048 * 2;
constexpr size_t OFF_CB1 = OFF_CW2 + 2 * 64 * 256 * 2;
constexpr size_t OFF_RS1 = OFF_CB1 + 2 * 256 * 4;
constexpr size_t OFF_SSQ2 = OFF_RS1 + MTOK * 4;
constexpr size_t OFF_SSQ3 = OFF_SSQ2 + MTOK * 4;
constexpr size_t OFF_GATES = OFF_SSQ3 + MTOK * 4;
constexpr size_t OFF_KC = OFF_GATES + (size_t)MTOK * 24 * 4;
constexpr size_t OFF_VC = OFF_KC + 16 * 256 * 64 * 2;
constexpr size_t OFF_BAR = OFF_VC + 16 * 256 * 64 * 2;
constexpr size_t OFF_PCNT = OFF_BAR + XCD_BAR_WORDS_C * 4;
constexpr size_t OFF_QCNT = OFF_PCNT + 256 * 256;
constexpr size_t OFF_B = 30 * MiB;
constexpr size_t OFF_H = 94 * MiB;
constexpr size_t OFF_XB = OFF_H;
constexpr size_t OFF_Q = OFF_H + 64 * MiB;
constexpr size_t OFF_KV = OFF_H + 96 * MiB;
constexpr size_t OFF_CAT = OFF_H + 256 * MiB;
constexpr size_t WS_END = OFF_CAT + 64 * MiB;
static_assert(OFF_QCNT + 8 * 256 <= OFF_B, "ws map");

struct Params {
  const float* x; const float* norm1_g; const float* w_in; const float* dw_w; const float* dw_b; const float* cln_g; const float* cln_b;
  const float* ck_pe; const float* ck_w1; const float* ck_w2; const float* cv_pe; const float* cv_w1; const float* cv_w2;
  const float* w_out; const float* norm2_g; const float* w_ff1; const float* w_ff2; const float* norm_f_g;
  float* out; unsigned char* ws;
};

DI unsigned pk2(float a, float b) { f32x2 v = {a, b}; bf16v2 r = __builtin_convertvector(v, bf16v2); return __builtin_bit_cast(unsigned, r); }
DI float bf2f(unsigned short u) { return __uint_as_float((unsigned)u << 16); }
DI float sigmoidf_(float v) { return __builtin_amdgcn_rcpf(1.0f + __builtin_amdgcn_exp2f(-v * LOG2E)); }
DI float gelu_tanh(float v) { const float u = 0.7978845608028654f * (v + 0.044715f * v * v * v); const float e = __builtin_amdgcn_exp2f(2.0f * LOG2E * u); const float th = 1.0f - 2.0f * __builtin_amdgcn_rcpf(e + 1.0f); return 0.5f * v * (1.0f + th); }
DI float wave_sum(float v) { v += __shfl_xor(v, 1); v += __shfl_xor(v, 2); v += __shfl_xor(v, 4); v += __shfl_xor(v, 8); v += __shfl_xor(v, 16); v += __shfl_xor(v, 32); return v; }

DI void st_nt(u32x4* p, u32x4 v) { __builtin_nontemporal_store(v, p); }
DI void st_nt(f32x4* p, f32x4 v) { __builtin_nontemporal_store(v, p); }
DI int get_tid() { int t = threadIdx.x; asm volatile("" : "+v"(t)); return t; }

#define XB_TMO      128
#define XB_XCNT(j)  (256  + 64 * (j))
#define XB_XSUB(j)  (1280 + 64 * (j))
#define XB_XGEN(j)  (2304 + 64 * (j))
#define XB_TOP      3328
#define XB_TOPGEN   3392
#define XCD_BAR_WORDS 3456
#define XB_SPIN_CAP (1u << 22)
DI unsigned xb_ld(unsigned* p) { return __hip_atomic_load(p, __ATOMIC_RELAXED, __HIP_MEMORY_SCOPE_AGENT); }
DI unsigned xb_add(unsigned* p, unsigned v) { return __hip_atomic_fetch_add(p, v, __ATOMIC_RELAXED, __HIP_MEMORY_SCOPE_AGENT); }
DI unsigned xb_xcc_id() { return (unsigned)__builtin_amdgcn_s_getreg((3 << 11) | 20) & 0xFu; }
#define XB_SPIN(cond, bar) do { unsigned _sp = 0; while (cond) { __builtin_amdgcn_s_sleep(1); \
    if ((++_sp & 255u) == 0u) { if (xb_ld(&(bar)[XB_TMO])) break; if (_sp > XB_SPIN_CAP) { atomicAdd(&(bar)[XB_TMO], 1u); break; } } } } while (0)
struct XcdBarrier { unsigned* bar; unsigned x; volatile LAS unsigned* st; };
DI XcdBarrier xcd_barrier_post(unsigned* bar, volatile LAS unsigned* st) {
  XcdBarrier b; b.bar = bar; b.x = xb_xcc_id(); b.st = st;
  if (threadIdx.x == 0) (void)xb_add(&bar[XB_XCNT(b.x)], 1u);
  return b;
}
DI void xcd_barrier_complete(unsigned* bar, unsigned x, unsigned& nloc, unsigned& nx) {
  const unsigned G = gridDim.x;
  unsigned sum, cnt, mine, sp = 0u;
  for (;;) {
    sum = 0u; cnt = 0u; mine = 0u;
#pragma unroll
    for (unsigned j = 0; j < 16; ++j) { const unsigned c = xb_ld(&bar[XB_XCNT(j)]); sum += c; cnt += (c > 0u) ? 1u : 0u; mine = (j == x) ? c : mine; }
    if (sum == G) break;
    __builtin_amdgcn_s_sleep(1);
    if ((++sp & 255u) == 0u) { if (xb_ld(&bar[XB_TMO])) break; if (sp > XB_SPIN_CAP) { atomicAdd(&bar[XB_TMO], 1u); break; } }
  }
  nloc = mine > 0u ? mine : 1u; nx = cnt > 0u ? cnt : 1u;
}
DI void xcd_barrier(const XcdBarrier& b) {
  asm volatile("s_waitcnt vmcnt(0)" ::: "memory");
  __syncthreads();
  if (threadIdx.x == 0) {
    unsigned* bar = b.bar;
    __builtin_amdgcn_s_waitcnt(0);
    unsigned nloc = b.st[0], nx = b.st[1];
    if (nloc == 0u) { xcd_barrier_complete(bar, b.x, nloc, nx); b.st[0] = nloc; b.st[1] = nx; }
    const unsigned old = xb_add(&bar[XB_XSUB(b.x)], 1u);
    const unsigned gen = old / nloc;
    if (old + 1u == (gen + 1u) * nloc) {
      __builtin_amdgcn_fence(__ATOMIC_RELEASE, "agent");
      asm volatile("s_waitcnt vmcnt(0)" ::: "memory");
      const unsigned og = xb_add(&bar[XB_TOP], 1u);
      const unsigned tg = og / nx;
      if (og + 1u == (tg + 1u) * nx) xb_add(&bar[XB_TOPGEN], 1u);
      else XB_SPIN(xb_ld(&bar[XB_TOPGEN]) == tg, bar);
      __builtin_amdgcn_fence(__ATOMIC_ACQUIRE, "agent");
      xb_add(&bar[XB_XGEN(b.x)], 1u);
      asm volatile("s_waitcnt vmcnt(0)" ::: "memory");
    } else {
      XB_SPIN(xb_ld(&bar[XB_XGEN(b.x)]) == gen, bar);
      __builtin_amdgcn_fence(__ATOMIC_ACQUIRE, "agent");
      asm volatile("s_waitcnt vmcnt(0)" ::: "memory");
    }
  }
  __syncthreads();
}
namespace pg8 {
constexpr int BM = 256, BK = 64, HALF = 128, HTB = HALF * BK * 2, STAGE_BYTES = 8 * HTB, NXCD = 8, WGM = 8;
DI int lds_byte(int r, int c) { const int st = (r >> 4) * 2 + (c >> 5), rr = r & 15, cc = c & 31, ob = rr * 64 + cc * 2; return st * 1024 + (ob ^ (((ob >> 9) & 1) << 5)); }
DI void stage_rc(int b, int& R, int& C) { const int st = b / 1024, sb = b % 1024, swz = sb ^ (((sb >> 9) & 1) << 5); R = (st >> 1) * 16 + swz / 64; C = (st & 1) * 32 + (swz % 64) / 2; }
DI int perm32(int rho) { const int n = rho >> 4, i = rho & 15; return 8 * (i >> 2) + 4 * n + (i & 3); }

struct Unit { int pm, pn; };
struct Gemm { const bf16_t* A; const bf16_t* Bt; int lda, ldb, K; size_t tstepA, tstepB; };

struct StaticOrder {
  int nM, nN, nwg, G, c;
  DI void init(int M, int N, int G_, int c_) { nM = M / BM; nN = N / BM; nwg = nM * nN; G = G_; c = c_; }
  DI bool next(int i, Unit& u) const {
    const long L = (long)i * G + c; if (L >= nwg) return false;
    int wgid = (int)L; { const int q = nwg / NXCD, r = nwg % NXCD, xcd = wgid % NXCD, off = wgid / NXCD; wgid = (xcd < r ? xcd * (q + 1) : r * (q + 1) + (xcd - r) * q) + off; }
    const int nig = WGM * nN, gid = wgid / nig, fm = gid * WGM, gsz = (nM - fm) < WGM ? (nM - fm) : WGM;
    u.pm = fm + ((wgid % nig) % gsz); u.pn = (wgid % nig) / gsz; return true;
  }
};
struct SingleUnit {
  int pm, pn;
  DI bool next(int i, Unit& u) const { if (i != 0) return false; u.pm = pm; u.pn = pn; return true; }
};

template <class Epi, class Sched, bool ALIGN_EPI = false, bool SP2 = false>
DI void gemm_phase(LAS unsigned char* lds, const Gemm g, const Sched& S, const Epi& E) {
  const int tid = get_tid(), wid = __builtin_amdgcn_readfirstlane(tid >> 6), lane = tid & 63, wr = wid >> 2, wc = wid & 3, fr = lane & 15, fq = lane >> 4;
  const int K = g.K, nt = K / BK;
  unsigned voffA[2], voffB[2];
#pragma unroll
  for (int i = 0; i < 2; ++i) { int R, C; stage_rc(tid * 16 + i * 8192, R, C); const int Rb = Epi::PERM ? ((R & ~31) + perm32(R & 31)) : R;
    voffA[i] = (unsigned)(R * g.lda + C) * 2u; voffB[i] = (unsigned)(Rb * g.ldb + C) * 2u; }
  const size_t kstep = (size_t)(BK * 2);
  const size_t hstepA = (size_t)HALF * g.lda * 2, hstepB = (size_t)HALF * g.ldb * 2;
  const unsigned ldsw = (unsigned)wid * 1024u;
  const int aoff = lds_byte(wr * 64 + fr, fq * 8), boff = lds_byte(wc * 32 + fr, fq * 8);
#define PG8_SA(b, h) (((b) * 2 + (h)) * HTB)
#define PG8_SB(b, h) ((4 + (b) * 2 + (h)) * HTB)
#define PG8_STAGE(bufoff, gbase, voff) do { _Pragma("unroll") for (int _i = 0; _i < 2; ++_i) \
    __builtin_amdgcn_global_load_lds((const unsigned*)((const char*)(gbase) + (voff)[_i]), (LAS unsigned*)(lds + (bufoff) + ldsw + _i * 8192), 16, 0, 0); } while (0)
#define PG8_LDA(dst, b, h) do { _Pragma("unroll") for (int m = 0; m < 4; ++m) _Pragma("unroll") for (int k = 0; k < 2; ++k) dst[m][k] = *(const LAS bf16x8*)(lds + PG8_SA(b, h) + aoff + m * 2048 + k * 1024); } while (0)
#define PG8_LDB(dst, b, h) do { _Pragma("unroll") for (int n = 0; n < 2; ++n) _Pragma("unroll") for (int k = 0; k < 2; ++k) dst[n][k] = *(const LAS bf16x8*)(lds + PG8_SB(b, h) + boff + n * 2048 + k * 1024); } while (0)
#define PG8_MMA(ai, bj, At, Bt) do { __builtin_amdgcn_s_setprio(1); _Pragma("unroll") for (int m = 0; m < 4; ++m) _Pragma("unroll") for (int n = 0; n < 2; ++n) _Pragma("unroll") for (int k = 0; k < 2; ++k) \
    acc[ai][bj][m][n] = __builtin_amdgcn_mfma_f32_16x16x32_bf16(Bt[n][k], At[m][k], acc[ai][bj][m][n], 0, 0, 0); __builtin_amdgcn_s_setprio(0); } while (0)
#define PG8_WAIT_V(n) asm volatile("s_waitcnt vmcnt(" #n ")" ::: "memory")
#define PG8_WAIT_L(n) asm volatile("s_waitcnt lgkmcnt(" #n ")" ::: "memory")
#define PG8_BAR __builtin_amdgcn_s_barrier()
#define PG8_SCHED __builtin_amdgcn_sched_barrier(0)
  Unit cur, nxt; int ui = 0;
  if (!S.next(0, cur)) return;
  f32x4 acc[2][2][4][2];
#pragma unroll
  for (int a = 0; a < 2; ++a)
#pragma unroll
    for (int b = 0; b < 2; ++b)
#pragma unroll
      for (int m = 0; m < 4; ++m)
#pragma unroll
        for (int n = 0; n < 2; ++n) acc[a][b][m][n] = (f32x4){0.f, 0.f, 0.f, 0.f};
  bf16x8 At[4][2], B0[2][2], B1[2][2];
  const char* cA = (const char*)g.A + (size_t)cur.pm * g.tstepA; const char* cB = (const char*)g.Bt + (size_t)cur.pn * g.tstepB;
  if constexpr (SP2) {
    PG8_STAGE(PG8_SB(0, 0), cB, voffB); PG8_STAGE(PG8_SB(0, 1), cB + hstepB, voffB); PG8_STAGE(PG8_SA(0, 0), cA, voffA); PG8_STAGE(PG8_SA(0, 1), cA + hstepA, voffA);
    if (wr == 1) PG8_BAR;
    PG8_WAIT_V(2); PG8_BAR;
    PG8_STAGE(PG8_SB(1, 0), cB + kstep, voffB); PG8_STAGE(PG8_SA(1, 0), cA + kstep, voffA); PG8_STAGE(PG8_SB(1, 1), cB + hstepB + kstep, voffB);
    PG8_WAIT_V(6); PG8_BAR;
  } else {
    PG8_STAGE(PG8_SB(0, 0), cB, voffB); PG8_STAGE(PG8_SA(0, 0), cA, voffA); PG8_STAGE(PG8_SB(0, 1), cB + hstepB, voffB); PG8_STAGE(PG8_SA(0, 1), cA + hstepA, voffA);
    if (wr == 1) PG8_BAR;
    PG8_WAIT_V(4); PG8_BAR;
    PG8_STAGE(PG8_SB(1, 0), cB + kstep, voffB); PG8_STAGE(PG8_SA(1, 0), cA + kstep, voffA); PG8_STAGE(PG8_SB(1, 1), cB + hstepB + kstep, voffB);
    PG8_WAIT_V(6); PG8_BAR;
  }
  for (;;) {
    const bool has_next = S.next(ui + 1, nxt);
    const char* nA = has_next ? (const char*)g.A + (size_t)nxt.pm * g.tstepA : cA; const char* nB = has_next ? (const char*)g.Bt + (size_t)nxt.pn * g.tstepB : cB;
    for (int t = 0; t < nt; t += 2) {
      const bool last = (t == nt - 2);
      const char* a1 = cA + (size_t)(t + 1) * kstep;
      const char* a2 = last ? nA : cA + (size_t)(t + 2) * kstep; const char* b2 = last ? nB : cB + (size_t)(t + 2) * kstep;
      const char* a3 = a2 + kstep; const char* b3 = b2 + kstep;
      if constexpr (SP2) {
        PG8_LDB(B0, 0, 0); PG8_LDB(B1, 0, 1); PG8_SCHED; PG8_LDA(At, 0, 0); PG8_STAGE(PG8_SA(1, 1), a1 + hstepA, voffA);
        PG8_WAIT_V(8); PG8_WAIT_L(0); PG8_BAR; PG8_MMA(0, 0, At, B0); PG8_MMA(0, 1, At, B1); PG8_BAR; PG8_SCHED;
        PG8_LDA(At, 0, 1); PG8_STAGE(PG8_SB(0, 0), b2, voffB); PG8_STAGE(PG8_SB(0, 1), b2 + hstepB, voffB); PG8_STAGE(PG8_SA(0, 0), a2, voffA);
        PG8_WAIT_V(8); PG8_WAIT_L(0); PG8_BAR; PG8_MMA(1, 0, At, B0); PG8_MMA(1, 1, At, B1); PG8_BAR; PG8_SCHED;
        PG8_LDB(B0, 1, 0); PG8_LDB(B1, 1, 1); PG8_SCHED; PG8_LDA(At, 1, 0); PG8_STAGE(PG8_SA(0, 1), a2 + hstepA, voffA);
        PG8_WAIT_V(8); PG8_WAIT_L(0); PG8_BAR; PG8_MMA(0, 0, At, B0); PG8_MMA(0, 1, At, B1); PG8_BAR; PG8_SCHED;
        PG8_LDA(At, 1, 1); PG8_STAGE(PG8_SB(1, 0), b3, voffB); PG8_STAGE(PG8_SB(1, 1), b3 + hstepB, voffB); PG8_STAGE(PG8_SA(1, 0), a3, voffA);
        PG8_WAIT_V(8); PG8_WAIT_L(0); PG8_BAR; PG8_MMA(1, 0, At, B0); PG8_MMA(1, 1, At, B1); PG8_BAR; PG8_SCHED;
      } else {
        PG8_LDB(B0, 0, 0); PG8_SCHED; PG8_LDA(At, 0, 0); PG8_STAGE(PG8_SA(1, 1), a1 + hstepA, voffA);
        PG8_WAIT_L(8); PG8_BAR; PG8_WAIT_L(0); PG8_MMA(0, 0, At, B0); PG8_BAR; PG8_SCHED;
        PG8_LDB(B1, 0, 1); PG8_STAGE(PG8_SB(0, 0), b2, voffB);
        PG8_BAR; PG8_WAIT_L(0); PG8_MMA(0, 1, At, B1); PG8_BAR;
        PG8_LDA(At, 0, 1); PG8_STAGE(PG8_SA(0, 0), a2, voffA);
        PG8_BAR; PG8_WAIT_L(0); PG8_MMA(1, 0, At, B0); PG8_BAR; PG8_SCHED;
        PG8_STAGE(PG8_SB(0, 1), b2 + hstepB, voffB);
        PG8_WAIT_V(6); PG8_BAR; PG8_MMA(1, 1, At, B1); PG8_BAR;
        PG8_LDB(B0, 1, 0); PG8_SCHED; PG8_LDA(At, 1, 0); PG8_STAGE(PG8_SA(0, 1), a2 + hstepA, voffA);
        PG8_WAIT_L(8); PG8_BAR; PG8_WAIT_L(0); PG8_MMA(0, 0, At, B0); PG8_BAR; PG8_SCHED;
        PG8_LDB(B1, 1, 1); PG8_STAGE(PG8_SB(1, 0), b3, voffB);
        PG8_BAR; PG8_WAIT_L(0); PG8_MMA(0, 1, At, B1); PG8_BAR;
        PG8_LDA(At, 1, 1); PG8_STAGE(PG8_SA(1, 0), a3, voffA);
        PG8_BAR; PG8_WAIT_L(0); PG8_MMA(1, 0, At, B0); PG8_BAR; PG8_SCHED;
        PG8_STAGE(PG8_SB(1, 1), b3 + hstepB, voffB);
        PG8_WAIT_V(6); PG8_BAR; PG8_MMA(1, 1, At, B1); PG8_BAR;
      }
    }
    if constexpr (ALIGN_EPI) { if (wr == 0) PG8_BAR; }
    if constexpr (!Epi::AFTER_DRAIN) { E(acc, cur, wr, wc, fr, fq); }
    if (!has_next) break;
#pragma unroll
    for (int a = 0; a < 2; ++a)
#pragma unroll
      for (int b = 0; b < 2; ++b)
#pragma unroll
        for (int m = 0; m < 4; ++m)
#pragma unroll
          for (int n = 0; n < 2; ++n) acc[a][b][m][n] = (f32x4){0.f, 0.f, 0.f, 0.f};
    cur = nxt; cA = nA; cB = nB; ++ui;
    if constexpr (ALIGN_EPI) { if (wr == 1) PG8_BAR; }
  }
  PG8_WAIT_V(0);
  if constexpr (!ALIGN_EPI) { if (wr == 0) PG8_BAR; }
  PG8_BAR;
  if constexpr (Epi::AFTER_DRAIN) { E.fused(acc, cur, wr, wc, fr, fq, lds, wid, lane); }
#undef PG8_SA
#undef PG8_SB
#undef PG8_STAGE
#undef PG8_LDA
#undef PG8_LDB
#undef PG8_MMA
#undef PG8_WAIT_V
#undef PG8_WAIT_L
#undef PG8_BAR
#undef PG8_SCHED
}
}

struct Epi1 {
  static constexpr bool PERM = true, AFTER_DRAIN = false;
  const float* rs; bf16_t* uv; bf16_t* q; bf16_t* kv; float* gates;
  DI void operator()(const f32x4 (&acc)[2][2][4][2], const pg8::Unit& u, int wr, int wc, int fr, int fq) const {
    const int pn = u.pn;
#pragma unroll
    for (int ai = 0; ai < 2; ++ai)
#pragma unroll
      for (int m = 0; m < 4; ++m) {
        const int r = u.pm * 256 + ai * 128 + wr * 64 + m * 16 + fr;
        const float s = rs[r];
#pragma unroll
        for (int bj = 0; bj < 2; ++bj) {
          const int cl = bj * 128 + wc * 32 + 8 * fq;
          f32x4 v0 = acc[ai][bj][m][0] * s, v1 = acc[ai][bj][m][1] * s;
          if (pn < 4) {
            u32x4 w; w.x = pk2(v0[0], v0[1]); w.y = pk2(v0[2], v0[3]); w.z = pk2(v1[0], v1[1]); w.w = pk2(v1[2], v1[3]);
            *(u32x4*)(uv + (size_t)r * 1024 + pn * 256 + cl) = w;
          } else if (pn < 6) {
            v0 = v0 * QSCALE; v1 = v1 * QSCALE;
            u32x4 w; w.x = pk2(v0[0], v0[1]); w.y = pk2(v0[2], v0[3]); w.z = pk2(v1[0], v1[1]); w.w = pk2(v1[2], v1[3]);
            *(u32x4*)(q + (size_t)r * 512 + (pn - 4) * 256 + cl) = w;
          } else if (pn < 9) {
            const int kvidx = (pn - 6) * 256 + cl, br = kvidx >> 7, gg = (kvidx >> 6) & 1, d = kvidx & 63, b = r >> 12, t = r & 4095;
            u32x4 w; w.x = pk2(v0[0], v0[1]); w.y = pk2(v0[2], v0[3]); w.z = pk2(v1[0], v1[1]); w.w = pk2(v1[2], v1[3]);
            *(u32x4*)(kv + ((size_t)(((br * 8 + b) * 2 + gg) * 4096 + t)) * 64 + d) = w;
          } else {
            if (cl < 24) {
              f32x4 g0, g1;
#pragma unroll
              for (int j = 0; j < 4; ++j) { g0[j] = sigmoidf_(v0[j]); g1[j] = sigmoidf_(v1[j]); }
              *(f32x4*)(gates + (size_t)r * 24 + cl) = g0; *(f32x4*)(gates + (size_t)r * 24 + cl + 4) = g1;
            }
          }
        }
      }
  }
};
template <bool WRITE_IO, bool WRITE_B> struct EpiRes {
  static constexpr bool PERM = true, AFTER_DRAIN = false;
  const bf16_t* base; float* io; bf16_t* xb; float* ssq;
  DI void operator()(const f32x4 (&acc)[2][2][4][2], const pg8::Unit& u, int wr, int wc, int fr, int fq) const {
#pragma unroll
    for (int ai = 0; ai < 2; ++ai)
#pragma unroll
      for (int m = 0; m < 4; ++m) {
        const int r = u.pm * 256 + ai * 128 + wr * 64 + m * 16 + fr;
        float ss = 0.f;
#pragma unroll
        for (int bj = 0; bj < 2; ++bj) {
          const size_t off = (size_t)r * 1024 + u.pn * 256 + bj * 128 + wc * 32 + 8 * fq;
          const u32x4 xw = *(const u32x4*)(base + off);
          const f32x4 b0 = (f32x4){__uint_as_float(xw.x << 16), __uint_as_float(xw.x & 0xffff0000u), __uint_as_float(xw.y << 16), __uint_as_float(xw.y & 0xffff0000u)};
          const f32x4 b1 = (f32x4){__uint_as_float(xw.z << 16), __uint_as_float(xw.z & 0xffff0000u), __uint_as_float(xw.w << 16), __uint_as_float(xw.w & 0xffff0000u)};
          const f32x4 v0 = acc[ai][bj][m][0] + b0, v1 = acc[ai][bj][m][1] + b1;
          if (WRITE_IO) { *(f32x4*)(io + off) = v0; *(f32x4*)(io + off + 4) = v1; }
          if (WRITE_B) { u32x4 w; w.x = pk2(v0[0], v0[1]); w.y = pk2(v0[2], v0[3]); w.z = pk2(v1[0], v1[1]); w.w = pk2(v1[2], v1[3]); *(u32x4*)(xb + off) = w; }
          ss += (v0[0] * v0[0] + v0[1] * v0[1]) + (v0[2] * v0[2] + v0[3] * v0[3]) + (v1[0] * v1[0] + v1[1] * v1[1]) + (v1[2] * v1[2] + v1[3] * v1[3]);
        }
        ss += __shfl_xor(ss, 16); ss += __shfl_xor(ss, 32);
        if (fq == 0) atomicAdd(ssq + r, ss);
      }
  }
};
struct EpiFF1 {
  static constexpr bool PERM = true, AFTER_DRAIN = false;
  const float* ssq; bf16_t* hid;
  DI void operator()(const f32x4 (&acc)[2][2][4][2], const pg8::Unit& u, int wr, int wc, int fr, int fq) const {
#pragma unroll
    for (int ai = 0; ai < 2; ++ai)
#pragma unroll
      for (int m = 0; m < 4; ++m) {
        const int r = u.pm * 256 + ai * 128 + wr * 64 + m * 16 + fr;
        const float s = __builtin_amdgcn_rsqf(ssq[r] * (1.0f / 1024.0f) + EPSN);
#pragma unroll
        for (int bj = 0; bj < 2; ++bj) {
          f32x4 v0 = acc[ai][bj][m][0] * s, v1 = acc[ai][bj][m][1] * s;
#pragma unroll
          for (int j = 0; j < 4; ++j) { const float a = fmaxf(v0[j], 0.f), b = fmaxf(v1[j], 0.f); v0[j] = a * a; v1[j] = b * b; }
          u32x4 w; w.x = pk2(v0[0], v0[1]); w.y = pk2(v0[2], v0[3]); w.z = pk2(v1[0], v1[1]); w.w = pk2(v1[2], v1[3]);
          st_nt((u32x4*)(hid + (size_t)r * 4096 + u.pn * 256 + bj * 128 + wc * 32 + 8 * fq), w);
        }
      }
  }
};
struct EpiFinal {
  static constexpr bool PERM = true, AFTER_DRAIN = false;
  const bf16_t* xb; float* io; float* ssq; unsigned* cnt; const float* gn; int fuse;
  DI void operator()(f32x4 (&acc)[2][2][4][2], const pg8::Unit& u, int wr, int wc, int fr, int fq) const {
#pragma unroll
    for (int ai = 0; ai < 2; ++ai)
#pragma unroll
      for (int m = 0; m < 4; ++m) {
        const int r = u.pm * 256 + ai * 128 + wr * 64 + m * 16 + fr;
        float ss = 0.f;
#pragma unroll
        for (int bj = 0; bj < 2; ++bj) {
          const size_t off = (size_t)r * 1024 + u.pn * 256 + bj * 128 + wc * 32 + 8 * fq;
          const u32x4 xw = *(const u32x4*)(xb + off);
          const f32x4 b0 = (f32x4){__uint_as_float(xw.x << 16), __uint_as_float(xw.x & 0xffff0000u), __uint_as_float(xw.y << 16), __uint_as_float(xw.y & 0xffff0000u)};
          const f32x4 b1 = (f32x4){__uint_as_float(xw.z << 16), __uint_as_float(xw.z & 0xffff0000u), __uint_as_float(xw.w << 16), __uint_as_float(xw.w & 0xffff0000u)};
          const f32x4 v0 = acc[ai][bj][m][0] + b0, v1 = acc[ai][bj][m][1] + b1;
          acc[ai][bj][m][0] = v0; acc[ai][bj][m][1] = v1;
          if (!fuse) { *(f32x4*)(io + off) = v0; *(f32x4*)(io + off + 4) = v1; }
          ss += (v0[0] * v0[0] + v0[1] * v0[1]) + (v0[2] * v0[2] + v0[3] * v0[3]) + (v1[0] * v1[0] + v1[1] * v1[1]) + (v1[2] * v1[2] + v1[3] * v1[3]);
        }
        ss += __shfl_xor(ss, 16); ss += __shfl_xor(ss, 32);
        if (fq == 0) atomicAdd(ssq + r, ss);
      }
    if (!fuse) return;
    asm volatile("s_waitcnt vmcnt(0)" ::: "memory");
    unsigned* c = cnt + 64 * (u.pm * 2 + wr);
    if (fr == 0 && fq == 0) __hip_atomic_fetch_add(c, 1u, __ATOMIC_RELAXED, __HIP_MEMORY_SCOPE_AGENT);
    { unsigned sp = 0; while ((unsigned)__builtin_amdgcn_readfirstlane(__hip_atomic_load(c, __ATOMIC_RELAXED, __HIP_MEMORY_SCOPE_AGENT)) < 16u) { __builtin_amdgcn_s_sleep(2); if (++sp > (1u << 22)) break; } }
    f32x4 g[2][2];
#pragma unroll
    for (int bj = 0; bj < 2; ++bj)
#pragma unroll
      for (int n = 0; n < 2; ++n) g[bj][n] = *(const f32x4*)(gn + u.pn * 256 + bj * 128 + wc * 32 + 8 * fq + 4 * n);
#pragma unroll
    for (int ai = 0; ai < 2; ++ai)
#pragma unroll
      for (int m = 0; m < 4; ++m) {
        const int r = u.pm * 256 + ai * 128 + wr * 64 + m * 16 + fr;
        const float s = __builtin_amdgcn_rsqf(__hip_atomic_load(ssq + r, __ATOMIC_RELAXED, __HIP_MEMORY_SCOPE_AGENT) * (1.0f / 1024.0f) + EPSN);
#pragma unroll
        for (int bj = 0; bj < 2; ++bj) {
          const size_t off = (size_t)r * 1024 + u.pn * 256 + bj * 128 + wc * 32 + 8 * fq;
          st_nt((f32x4*)(io + off), acc[ai][bj][m][0] * s * g[bj][0]); st_nt((f32x4*)(io + off + 4), acc[ai][bj][m][1] * s * g[bj][1]);
        }
      }
  }
};
constexpr int HSTR = 528;
struct EpiCmp {
  static constexpr bool PERM = false, AFTER_DRAIN = true;
  const float* bias1; const bf16_t* w2t; bf16_t* outp;
  DI void fused(const f32x4 (&acc)[2][2][4][2], const pg8::Unit& u, int wr, int wc, int fr, int fq, LAS unsigned char* lds, int wid, int lane) const {
#pragma unroll
    for (int bj = 0; bj < 2; ++bj)
#pragma unroll
      for (int n = 0; n < 2; ++n) {
        const int c = bj * 128 + wc * 32 + n * 16 + 4 * fq;
        const f32x4 bv = *(const f32x4*)(bias1 + c);
#pragma unroll
        for (int ai = 0; ai < 2; ++ai)
#pragma unroll
          for (int m = 0; m < 4; ++m) {
            const int r = ai * 128 + wr * 64 + m * 16 + fr;
            const f32x4 v = acc[ai][bj][m][n] + bv;
            u32x2 w; w.x = pk2(gelu_tanh(v[0]), gelu_tanh(v[1])); w.y = pk2(gelu_tanh(v[2]), gelu_tanh(v[3]));
            *(LAS u32x2*)(lds + r * HSTR + c * 2) = w;
          }
      }
    __syncthreads();
    f32x4 o[2][4];
#pragma unroll
    for (int mb = 0; mb < 2; ++mb)
#pragma unroll
      for (int nb = 0; nb < 4; ++nb) o[mb][nb] = (f32x4){0.f, 0.f, 0.f, 0.f};
    bf16x8 wf[8][4];
#pragma unroll
    for (int ks = 0; ks < 8; ++ks)
#pragma unroll
      for (int nb = 0; nb < 4; ++nb) wf[ks][nb] = *(const bf16x8*)(w2t + (16 * nb + fr) * 256 + 32 * ks + 8 * fq);
#pragma unroll
    for (int ks = 0; ks < 8; ++ks) {
      bf16x8 hf[2];
#pragma unroll
      for (int mb = 0; mb < 2; ++mb) hf[mb] = *(const LAS bf16x8*)(lds + (32 * wid + 16 * mb + fr) * HSTR + (32 * ks + 8 * fq) * 2);
#pragma unroll
      for (int mb = 0; mb < 2; ++mb)
#pragma unroll
        for (int nb = 0; nb < 4; ++nb) o[mb][nb] = __builtin_amdgcn_mfma_f32_16x16x32_bf16(wf[ks][nb], hf[mb], o[mb][nb], 0, 0, 0);
    }
#pragma unroll
    for (int mb = 0; mb < 2; ++mb)
#pragma unroll
      for (int nb = 0; nb < 4; ++nb) {
        const int row = 32 * wid + 16 * mb + fr;
        u32x2 w; w.x = pk2(o[mb][nb][0], o[mb][nb][1]); w.y = pk2(o[mb][nb][2], o[mb][nb][3]);
        *(u32x2*)(outp + ((size_t)u.pm * 256 + row) * 64 + 16 * nb + 4 * fq) = w;
      }
    __syncthreads();
  }
};

struct TJob { const float* src; bf16_t* dst; const float* g; int K, N, kt, nt; };
DI TJob transpose_job(const Params& p, int job) {
  unsigned char* ws = p.ws; TJob t;
  if (job < 640) t = TJob{p.w_in, (bf16_t*)(ws + OFF_WIN), p.norm1_g, 1024, 2328, job / 40, job % 40};
  else if (job < 896) { const int j = job - 640; t = TJob{p.w_out, (bf16_t*)(ws + OFF_WOUT), nullptr, 1024, 1024, j / 16, j % 16}; }
  else if (job < 1920) { const int j = job - 896; t = TJob{p.w_ff1, (bf16_t*)(ws + OFF_WFF1), p.norm2_g, 1024, 4096, j / 64, j % 64}; }
  else if (job < 2944) { const int j = job - 1920; t = TJob{p.w_ff2, (bf16_t*)(ws + OFF_WFF2), nullptr, 4096, 1024, j / 16, j % 16}; }
  else if (job < 3072) { const int j = job - 2944; t = TJob{p.ck_w1, (bf16_t*)(ws + OFF_CW1), nullptr, 2048, 256, j / 4, j % 4}; }
  else if (job < 3200) { const int j = job - 3072; t = TJob{p.cv_w1, (bf16_t*)(ws + OFF_CW1) + 256 * 2048, nullptr, 2048, 256, j / 4, j % 4}; }
  else if (job < 3204) { const int j = job - 3200; t = TJob{p.ck_w2, (bf16_t*)(ws + OFF_CW2), nullptr, 256, 64, j, 0}; }
  else { const int j = job - 3204; t = TJob{p.cv_w2, (bf16_t*)(ws + OFF_CW2) + 64 * 256, nullptr, 256, 64, j, 0}; }
  return t;
}
DI void transpose_pair(const TJob& ta, const TJob& tb, bool has_b, LAS float* tl) {
  const int tid = get_tid();
  f32x4 va[2], vb[2];
#pragma unroll
  for (int i = 0; i < 2; ++i) {
    const int idx = tid + 512 * i, row = idx >> 4, c4 = idx & 15;
    { const int n = ta.nt * 64 + 4 * c4; va[i] = (f32x4){0.f, 0.f, 0.f, 0.f}; if (n < ta.N) va[i] = *(const f32x4*)(ta.src + (size_t)(ta.kt * 64 + row) * ta.N + n); if (ta.g) va[i] = va[i] * ta.g[ta.kt * 64 + row]; }
    vb[i] = (f32x4){0.f, 0.f, 0.f, 0.f};
    if (has_b) { const int n = tb.nt * 64 + 4 * c4; if (n < tb.N) vb[i] = *(const f32x4*)(tb.src + (size_t)(tb.kt * 64 + row) * tb.N + n); if (tb.g) vb[i] = vb[i] * tb.g[tb.kt * 64 + row]; }
  }
#pragma unroll
  for (int i = 0; i < 2; ++i) {
    const int idx = tid + 512 * i, row = idx >> 4, c4 = idx & 15;
#pragma unroll
    for (int e = 0; e < 4; ++e) { tl[row * 65 + 4 * c4 + e] = va[i][e]; tl[4160 + row * 65 + 4 * c4 + e] = vb[i][e]; }
  }
  __syncthreads();
  {
    const int nrow = tid >> 3, kc = tid & 7;
    float e[8];
#pragma unroll
    for (int j = 0; j < 8; ++j) e[j] = tl[(8 * kc + j) * 65 + nrow];
    u32x4 w; w.x = pk2(e[0], e[1]); w.y = pk2(e[2], e[3]); w.z = pk2(e[4], e[5]); w.w = pk2(e[6], e[7]);
    *(u32x4*)(ta.dst + (size_t)(ta.nt * 64 + nrow) * ta.K + ta.kt * 64 + 8 * kc) = w;
    if (has_b) {
#pragma unroll
      for (int j = 0; j < 8; ++j) e[j] = tl[4160 + (8 * kc + j) * 65 + nrow];
      w.x = pk2(e[0], e[1]); w.y = pk2(e[2], e[3]); w.z = pk2(e[4], e[5]); w.w = pk2(e[6], e[7]);
      *(u32x4*)(tb.dst + (size_t)(tb.nt * 64 + nrow) * tb.K + tb.kt * 64 + 8 * kc) = w;
    }
  }
  __syncthreads();
}

DI void p0_prologue(const Params& p, LAS unsigned char* lds) {
  const int tid = get_tid(), lane = tid & 63, wid = tid >> 6, G = gridDim.x, bx = blockIdx.x;
  unsigned char* ws = p.ws;
  {
    bf16_t* xb = (bf16_t*)(ws + OFF_XB); float* rs1 = (float*)(ws + OFF_RS1);
    for (int r0 = (bx * 8 + wid) * 4; r0 < MTOK; r0 += G * 32) {
      f32x4 a[4][2], c[4][2];
#pragma unroll
      for (int rr = 0; rr < 4; ++rr)
#pragma unroll
        for (int i = 0; i < 2; ++i) { const float* s = p.x + (size_t)(r0 + rr) * 1024 + (lane + 64 * i) * 8; a[rr][i] = __builtin_nontemporal_load((const f32x4*)s); c[rr][i] = __builtin_nontemporal_load((const f32x4*)(s + 4)); }
#pragma unroll
      for (int rr = 0; rr < 4; ++rr) {
        float ss = 0.f;
#pragma unroll
        for (int i = 0; i < 2; ++i) {
          const f32x4 av = a[rr][i], bv = c[rr][i];
          ss += (av[0] * av[0] + av[1] * av[1]) + (av[2] * av[2] + av[3] * av[3]) + (bv[0] * bv[0] + bv[1] * bv[1]) + (bv[2] * bv[2] + bv[3] * bv[3]);
          u32x4 w; w.x = pk2(av[0], av[1]); w.y = pk2(av[2], av[3]); w.z = pk2(bv[0], bv[1]); w.w = pk2(bv[2], bv[3]);
          *(u32x4*)(xb + (size_t)(r0 + rr) * 1024 + (lane + 64 * i) * 8) = w;
        }
        ss = wave_sum(ss);
        if (lane == 0) rs1[r0 + rr] = __builtin_amdgcn_rsqf(ss * (1.0f / 1024.0f) + EPSN);
      }
    }
  }
  { float* z = (float*)(ws + OFF_SSQ2); for (int i = bx * 512 + tid; i < 2 * MTOK; i += G * 512) z[i] = 0.f; }
  for (int pair = bx; pair < 256; pair += G) {
    LAS float* red = (LAS float*)lds;
    const int kv = pair >> 7, n = (pair & 127) * 2 + (tid & 1), ksl = tid >> 1;
    const float* pe = kv ? p.cv_pe : p.ck_pe; const float* w1 = kv ? p.cv_w1 : p.ck_w1;
    float s = 0.f;
#pragma unroll
    for (int k = 0; k < 8; ++k) s += pe[ksl * 8 + k] * w1[(size_t)(ksl * 8 + k) * 256 + n];
    s += __shfl_xor(s, 2); s += __shfl_xor(s, 4); s += __shfl_xor(s, 8); s += __shfl_xor(s, 16); s += __shfl_xor(s, 32);
    if (lane < 2) red[wid * 2 + lane] = s;
    __syncthreads();
    if (tid < 2) { float t = 0.f; for (int i = 0; i < 8; ++i) t += red[i * 2 + tid]; ((float*)(ws + OFF_CB1))[kv * 256 + (pair & 127) * 2 + tid] = t; }
    __syncthreads();
  }
  for (int job = bx; job < 3208; job += 2 * G) {
    const bool has_b = (job + G) < 3208;
    const TJob ta = transpose_job(p, job), tb = transpose_job(p, has_b ? job + G : job);
    transpose_pair(ta, tb, has_b, (LAS float*)lds);
  }
}

constexpr int USTR = 1040;
constexpr int YSTR = 516;
constexpr int C_WOFF = 66560;
DI void conv_load_taps(const Params& p, LAS unsigned char* lds) {
  LAS float* Wp = (LAS float*)(lds + C_WOFF);
  for (int idx = get_tid(); idx < 32 * 256; idx += 512) {
    const int w = idx >> 8, cp = idx & 255;
    f32x2 t = (f32x2){0.f, 0.f};
    if (w < 31) t = *(const f32x2*)(p.dw_w + w * 512 + 2 * cp);
    *(LAS f32x2*)(Wp + ((w >> 2) * 256 + cp) * 8 + (w & 3) * 2) = t;
  }
}
DI void conv_tile(const Params& p, LAS unsigned char* lds, int tile) {
  const int tid = get_tid(), lane = tid & 63, wid = tid >> 6;
  const int b = tile >> 7, t0 = (tile & 127) * 32;
  const bf16_t* uv = (const bf16_t*)(p.ws + OFF_B);
  bf16_t* cat = (bf16_t*)(p.ws + OFF_CAT);
  LAS unsigned char* U = lds; LAS float* Y = (LAS float*)lds;
  const LAS float* Wp = (const LAS float*)(lds + C_WOFF);
  {
    u32x4 vv[8], gv[8];
#pragma unroll
    for (int it = 0; it < 8; ++it) {
      const int idx = tid + 512 * it, row = idx >> 6, ch = idx & 63, t = t0 - 30 + row;
      const int tc = t < 0 ? 0 : (row < 62 ? t : t0);
      const size_t m = (size_t)b * 4096 + tc;
      vv[it] = *(const u32x4*)(uv + m * 1024 + ch * 8); gv[it] = *(const u32x4*)(uv + m * 1024 + 512 + ch * 8);
    }
#pragma unroll
    for (int it = 0; it < 8; ++it) {
      const int idx = tid + 512 * it, row = idx >> 6, ch = idx & 63, t = t0 - 30 + row;
      u32x4 w = (u32x4){0u, 0u, 0u, 0u};
      if (t >= 0 && row < 62) {
#pragma unroll
        for (int j = 0; j < 4; ++j) {
          const float v0 = __uint_as_float(vv[it][j] << 16), v1 = __uint_as_float(vv[it][j] & 0xffff0000u), g0 = __uint_as_float(gv[it][j] << 16), g1 = __uint_as_float(gv[it][j] & 0xffff0000u);
          w[j] = pk2(v0 * sigmoidf_(g0), v1 * sigmoidf_(g1));
        }
      }
      if (row < 63) *(LAS u32x4*)(U + row * USTR + ch * 16) = w;
    }
  }
  __syncthreads();
  const int half = tid >> 8, cp = tid & 255;
  float a0[16], a1[16];
  {
    const f32x2 bias = *(const f32x2*)(p.dw_b + 2 * cp);
#pragma unroll
    for (int o = 0; o < 16; ++o) { a0[o] = bias.x; a1[o] = bias.y; }
#pragma unroll
    for (int og = 0; og < 2; ++og) {
      const LAS unsigned char* ub = U + (half * 16 + og * 8) * USTR + cp * 4;
#pragma unroll 1
      for (int w4 = 0; w4 < 8; ++w4) {
        const f32x4 wa = *(const LAS f32x4*)(Wp + (w4 * 256 + cp) * 8), wb = *(const LAS f32x4*)(Wp + (w4 * 256 + cp) * 8 + 4);
        const float wt0[4] = {wa[0], wa[2], wb[0], wb[2]}, wt1[4] = {wa[1], wa[3], wb[1], wb[3]};
        float u0[11], u1[11];
#pragma unroll
        for (int r = 0; r < 11; ++r) { const unsigned uu = *(const LAS unsigned*)(ub + (w4 * 4 + r) * USTR); u0[r] = __uint_as_float(uu << 16); u1[r] = __uint_as_float(uu & 0xffff0000u); }
#pragma unroll
        for (int o = 0; o < 8; ++o)
#pragma unroll
          for (int k = 0; k < 4; ++k) { a0[og * 8 + o] += u0[o + k] * wt0[k]; a1[og * 8 + o] += u1[o + k] * wt1[k]; }
      }
    }
  }
  __syncthreads();
#pragma unroll
  for (int o = 0; o < 16; ++o) *(LAS f32x2*)(Y + (half * 16 + o) * YSTR + 2 * cp) = (f32x2){a0[o], a1[o]};
  __syncthreads();
  {
    const f32x4 g0 = *(const f32x4*)(p.cln_g + lane * 8), g1 = *(const f32x4*)(p.cln_g + lane * 8 + 4), b0 = *(const f32x4*)(p.cln_b + lane * 8), b1 = *(const f32x4*)(p.cln_b + lane * 8 + 4);
#pragma unroll
    for (int i = 0; i < 4; ++i) {
      const int tok = wid * 4 + i;
      const f32x4 y0 = *(const LAS f32x4*)(Y + tok * YSTR + lane * 8), y1 = *(const LAS f32x4*)(Y + tok * YSTR + lane * 8 + 4);
      float s = (y0[0] + y0[1]) + (y0[2] + y0[3]) + (y1[0] + y1[1]) + (y1[2] + y1[3]);
      s = wave_sum(s);
      const float mu = s * (1.0f / 512.0f);
      const f32x4 d0 = y0 - mu, d1 = y1 - mu;
      float q = (d0[0] * d0[0] + d0[1] * d0[1]) + (d0[2] * d0[2] + d0[3] * d0[3]) + (d1[0] * d1[0] + d1[1] * d1[1]) + (d1[2] * d1[2] + d1[3] * d1[3]);
      q = wave_sum(q);
      const float rstd = __builtin_amdgcn_rsqf(q * (1.0f / 512.0f) + EPSN);
      f32x4 o0 = d0 * rstd * g0 + b0, o1 = d1 * rstd * g1 + b1;
#pragma unroll
      for (int j = 0; j < 4; ++j) { o0[j] = o0[j] * sigmoidf_(o0[j]); o1[j] = o1[j] * sigmoidf_(o1[j]); }
      u32x4 w; w.x = pk2(o0[0], o0[1]); w.y = pk2(o0[2], o0[3]); w.z = pk2(o1[0], o1[1]); w.w = pk2(o1[2], o1[3]);
      *(u32x4*)(cat + ((size_t)b * 4096 + t0 + tok) * 1024 + lane * 8) = w;
    }
  }
  __syncthreads();
}

constexpr int KVSTR = 144;
constexpr int VSTR = 144;
constexpr int A_GRP = 4 * 64 * KVSTR;
constexpr int A_KOFF = 0, A_VOFF = 2 * 64 * KVSTR;
constexpr int A_SLAB = 2 * A_GRP;
constexpr int SLAB_FLOATS = 32 * 65;
constexpr int A_SEL = A_SLAB + 8 * SLAB_FLOATS * 4;
constexpr int A_OR = A_SEL + 512;
constexpr int A_CNT = A_OR + 16;
constexpr int A_NXT = A_CNT + 32;
constexpr int A_LINV = A_NXT + 32;
static_assert(A_LINV + 1024 <= LDS_BYTES - 16, "attention LDS map");

DI void group_sync(LAS unsigned* cnt, unsigned& tgt, int lane) {
  tgt += 4u;
  __builtin_amdgcn_fence(__ATOMIC_RELEASE, "workgroup");
  if (lane == 0) __hip_atomic_fetch_add(cnt, 1u, __ATOMIC_RELAXED, __HIP_MEMORY_SCOPE_WORKGROUP);
  while ((int)(__hip_atomic_load(cnt, __ATOMIC_RELAXED, __HIP_MEMORY_SCOPE_WORKGROUP) - tgt) < 0) __builtin_amdgcn_s_sleep(0);
  __builtin_amdgcn_fence(__ATOMIC_ACQUIRE, "workgroup");
}

constexpr float ATT_THR = 8.0f;
template <int KIND, bool MASKED>
DI void attn_scores(LAS unsigned char* kbuf, int jc, const bf16x8 (&qf)[4], float slope2, float sc, int tq, int jt, unsigned long long mymask, float mref, f32x16 (&S)[2], int q, int h) {
  float base2; int kmin = -1, kmax = 64;
  if (KIND <= 1) {
    const int lim = 64 * jt + tq - 31 - 1024 * jc - 64 * h;
    base2 = -slope2 * (float)lim - mref; kmax = lim >> 4;
  } else {
    base2 = slope2 * (float)(64 * (jc - jt) + 4 * h - tq) - mref;
    if (MASKED && jc == jt) kmax = tq - 4 * h;
    if (MASKED && KIND == 3 && jc == jt - 8) kmin = tq - 4 * h;
    if (KIND == 2) base2 = ((mymask >> jc) & 1ull) ? base2 : -1e30f;
  }
#pragma unroll
  for (int kb = 0; kb < 2; ++kb) {
#pragma unroll
    for (int i = 0; i < 16; ++i) S[kb][i] = __builtin_fmaf(sc, (float)(32 * kb + 8 * (i >> 2) + (i & 3)), base2);
#pragma unroll
    for (int ks = 0; ks < 4; ++ks) {
      const bf16x8 kf = *(const LAS bf16x8*)(kbuf + (32 * kb + q) * KVSTR + 32 * ks + 16 * h);
      S[kb] = __builtin_amdgcn_mfma_f32_32x32x16_bf16(kf, qf[ks], S[kb], 0, 0, 0);
    }
  }
  if (MASKED) {
    const unsigned range = (unsigned)(kmax - kmin);
#pragma unroll
    for (int kb = 0; kb < 2; ++kb)
#pragma unroll
      for (int i = 0; i < 16; ++i) {
        const int keyc = 32 * kb + 8 * (i >> 2) + (i & 3);
        const bool ok = (kmax > kmin) && ((unsigned)(keyc - kmin - 1) < range);
        S[kb][i] = ok ? S[kb][i] : -INFINITY;
      }
  }
}
DI float attn_exp_sum(f32x16 (&S)[2]) {
  float ps = 0.f;
#pragma unroll
  for (int kb = 0; kb < 2; ++kb)
#pragma unroll
    for (int i = 0; i < 16; ++i) { const float pv = __builtin_amdgcn_exp2f(S[kb][i]); S[kb][i] = pv; ps += pv; asm volatile("" : "+v"(ps)); }
  return ps;
}
constexpr float ATT_SUM_CAP = 16777216.0f;
template <int KIND, bool MASKED>
DI void attn_tile(LAS unsigned char* kbuf, LAS unsigned char* vbuf, int jc, const bf16x8 (&qf)[4], float slope2, float sc, int tq, int jt, unsigned long long mymask,
                  float& m_run, float& l_run, float l2inv, f32x16 (&O)[2], LAS float* slab, int q, int h, int q4, int p4, int g1) {
  f32x16 S[2];
  attn_scores<KIND, MASKED>(kbuf, jc, qf, slope2, sc, tq, jt, mymask, m_run, S, q, h);
  {
    float ps = attn_exp_sum(S);
    if (__any(!(ps < ATT_SUM_CAP))) {
      asm volatile("s_nop 0" ::: "memory");
      attn_scores<KIND, MASKED>(kbuf, jc, qf, slope2, sc, tq, jt, mymask, m_run, S, q, h);
      float mx = fmaxf(S[0][0], S[1][0]);
#pragma unroll
      for (int i = 1; i < 16; ++i) mx = fmaxf(fmaxf(mx, S[0][i]), S[1][i]);
      mx = fmaxf(mx, __shfl_xor(mx, 32));
      const float d = fmaxf(mx, 0.f), alpha = __builtin_amdgcn_exp2f(-d);
      m_run += d; l_run *= alpha;
#pragma unroll
      for (int kb = 0; kb < 2; ++kb)
#pragma unroll
        for (int i = 0; i < 16; ++i) S[kb][i] -= d;
      if (KIND != 0) {
#pragma unroll
        for (int db = 0; db < 2; ++db)
#pragma unroll
          for (int i = 0; i < 16; ++i) O[db][i] *= alpha;
      }
      if (KIND == 1) { for (int jj = h; jj < 65; jj += 2) slab[q * 65 + jj] *= alpha; }
      ps = attn_exp_sum(S);
    }
    l_run += ps;
  }
  if (KIND == 1) {
    float s4[8], rx[8];
#pragma unroll
    for (int kb = 0; kb < 2; ++kb)
#pragma unroll
      for (int gi = 0; gi < 4; ++gi) {
        float t4 = S[kb][4 * gi] + S[kb][4 * gi + 1]; asm volatile("" : "+v"(t4)); t4 += S[kb][4 * gi + 2]; asm volatile("" : "+v"(t4)); t4 += S[kb][4 * gi + 3];
        s4[4 * kb + gi] = t4; rx[4 * kb + gi] = __shfl_xor(S[kb][4 * gi + 3], 32);
      }
    LAS float* rowp = slab + q * 65 + 16 * jc + h;
    float old[9], val[9];
#pragma unroll
    for (int m = 0; m < 9; ++m) {
      const float own = (m < 8) ? s4[m < 8 ? m : 7] : 0.f;
      const float a1 = (m < 8) ? rx[m < 8 ? m : 7] : 0.f;
      const float a0 = (m > 0) ? rx[m > 0 ? m - 1 : 0] : 0.f;
      val[m] = own + (h ? a1 : a0);
    }
#pragma unroll
    for (int m = 0; m < 9; ++m) old[m] = (m < 8 || h == 0) ? rowp[2 * m] : 0.f;
#pragma unroll
    for (int m = 0; m < 9; ++m) if (m < 8 || h == 0) rowp[2 * m] = old[m] + val[m];
  }
  if (KIND != 0) {
#pragma unroll
    for (int kb = 0; kb < 2; ++kb)
#pragma unroll
      for (int s = 0; s < 2; ++s) {
        u32x4 pw;
        pw.x = pk2(S[kb][8 * s + 0], S[kb][8 * s + 1]); pw.y = pk2(S[kb][8 * s + 2], S[kb][8 * s + 3]);
        pw.z = pk2(S[kb][8 * s + 4], S[kb][8 * s + 5]); pw.w = pk2(S[kb][8 * s + 6], S[kb][8 * s + 7]);
        const bf16x8 pf = __builtin_bit_cast(bf16x8, pw);
#pragma unroll
        for (int db = 0; db < 2; ++db) {
          LAS unsigned char* va = vbuf + (32 * kb + 16 * s + 4 * h + q4) * VSTR + (32 * db + 16 * g1) * 2 + 8 * p4;
          const s16x4 lo = __builtin_amdgcn_ds_read_tr16_b64_v4i16((LAS s16x4*)va);
          const s16x4 hi = __builtin_amdgcn_ds_read_tr16_b64_v4i16((LAS s16x4*)(va + 8 * VSTR));
          const bf16x8 vf = __builtin_shufflevector(lo, hi, 0, 1, 2, 3, 4, 5, 6, 7);
          O[db] = __builtin_amdgcn_mfma_f32_32x32x16_bf16(vf, pf, O[db], 0, 0, 0);
        }
      }
  }
}

template <int KIND>
DI void attn_branch(LAS unsigned char* gl, LAS unsigned* cnt, unsigned& tgt, const bf16_t* Kg, const bf16_t* Vg, unsigned long long tmask, const bf16x8 (&qf)[4], float slope2, int tq, int jt,
                    unsigned long long mymask, float& m_run, float& l_run, float invl, f32x16 (&O)[2], LAS float* slab) {
  const int gt = get_tid() & 255, lane = gt & 63, q = lane & 31, h = lane >> 5;
  const int i16 = lane & 15, q4 = i16 >> 2, p4 = i16 & 3, g1 = (lane >> 4) & 1;
  const float sc = (KIND <= 1) ? slope2 * 16.0f : slope2;
  const int woff = (gt >> 3) * KVSTR + (gt & 7) * 16;
  int j = __builtin_ctzll(tmask); tmask &= tmask - 1;
  const u32x4 z4 = (u32x4){0u, 0u, 0u, 0u};
  u32x4 ka = *(const u32x4*)(Kg + (size_t)j * 4096 + gt * 8), kb = *(const u32x4*)(Kg + (size_t)j * 4096 + 2048 + gt * 8), va = z4, vb = z4;
  if (KIND != 0) { va = *(const u32x4*)(Vg + (size_t)j * 4096 + gt * 8); vb = *(const u32x4*)(Vg + (size_t)j * 4096 + 2048 + gt * 8); }
  int buf = 0;
  for (;;) {
    LAS unsigned char* kbuf = gl + A_KOFF + buf * (64 * KVSTR); LAS unsigned char* vbuf = gl + A_VOFF + buf * (64 * VSTR);
    *(LAS u32x4*)(kbuf + woff) = ka; *(LAS u32x4*)(kbuf + 32 * KVSTR + woff) = kb;
    if (KIND != 0) { *(LAS u32x4*)(vbuf + woff) = va; *(LAS u32x4*)(vbuf + 32 * VSTR + woff) = vb; }
    group_sync(cnt, tgt, lane);
    const int jc = j;
    const bool more = (tmask != 0ull);
    if (more) {
      j = __builtin_ctzll(tmask); tmask &= tmask - 1;
      ka = *(const u32x4*)(Kg + (size_t)j * 4096 + gt * 8); kb = *(const u32x4*)(Kg + (size_t)j * 4096 + 2048 + gt * 8);
      if (KIND != 0) { va = *(const u32x4*)(Vg + (size_t)j * 4096 + gt * 8); vb = *(const u32x4*)(Vg + (size_t)j * 4096 + 2048 + gt * 8); }
    }
    if (KIND <= 1 || jc == jt || (KIND == 3 && jc == jt - 8)) attn_tile<KIND, true>(kbuf, vbuf, jc, qf, slope2, sc, tq, jt, mymask, m_run, l_run, invl, O, slab, q, h, q4, p4, g1);
    else attn_tile<KIND, (KIND <= 1)>(kbuf, vbuf, jc, qf, slope2, sc, tq, jt, mymask, m_run, l_run, invl, O, slab, q, h, q4, p4, g1);
    buf ^= 1;
    if (!more) break;
  }
  group_sync(cnt, tgt, lane);
}

DI int queue_pop(unsigned* qbase, unsigned xcc) {
  for (unsigned qq = 0; qq < 8u; ++qq) {
    const unsigned x2 = (xcc + qq) & 7u;
    const unsigned i = __hip_atomic_fetch_add(qbase + 64 * x2, 1u, __ATOMIC_RELAXED, __HIP_MEMORY_SCOPE_AGENT);
    if (i < 256u) return (int)(x2 * 256u + i);
  }
  return -1;
}
DI void attn_item(const Params& p, LAS unsigned char* lds, int grp, unsigned& tgt, int enc, int& nenc, unsigned xcc) {
  const int gt = get_tid() & 255, lane = gt & 63, hh = __builtin_amdgcn_readfirstlane(gt >> 6), q = lane & 31, h = lane >> 5;
  const int bg = 2 * (enc >> 8) + (enc & 1), jt32 = 127 - ((enc & 255) >> 1);
  int popv = -1;
  if (gt == 0) popv = queue_pop((unsigned*)(p.ws + OFF_QCNT), xcc);
  const int b = bg >> 1, g = bg & 1, head = g * 4 + hh, jt = jt32 >> 1, tq = (jt32 & 1) * 32 + q, t = jt * 64 + tq;
  const size_t mrow = (size_t)b * 4096 + t;
  const bf16_t* Qp = (const bf16_t*)(p.ws + OFF_Q);
  const bf16_t* KV = (const bf16_t*)(p.ws + OFF_KV);
  const float* gates = (const float*)(p.ws + OFF_GATES);
  bf16_t* cat = (bf16_t*)(p.ws + OFF_CAT);
  float* osc = (float*)(p.ws + OFF_B) + mrow * 512 + head * 64 + 4 * h;
  LAS unsigned char* gl = lds + grp * A_GRP;
  LAS float* slab = (LAS float*)(lds + A_SLAB) + (grp * 4 + hh) * SLAB_FLOATS;
  LAS unsigned long long* selm = (LAS unsigned long long*)(lds + A_SEL) + grp * 32;
  LAS unsigned long long* orm = (LAS unsigned long long*)(lds + A_OR) + grp;
  LAS unsigned* cnt = (LAS unsigned*)(lds + A_CNT + 16 * grp);
  for (int i = lane; i < SLAB_FLOATS; i += 64) slab[i] = 0.f;
  if (gt == 0) *orm = 0ull;
  bf16x8 qf[4];
#pragma unroll
  for (int ks = 0; ks < 4; ++ks) qf[ks] = *(const bf16x8*)(Qp + mrow * 512 + head * 64 + 16 * ks + 8 * h);
  const float slope2 = __builtin_amdgcn_exp2f(-(float)(head + 1)) * LOG2E;
  const float g_cmp = gates[mrow * 24 + head * 3 + 0], g_sel = gates[mrow * 24 + head * 3 + 1], g_win = gates[mrow * 24 + head * 3 + 2];
  const size_t bgoff = (size_t)bg * 4096 * 64;
  const bf16_t* Ksel = KV + (size_t)2 * 16 * 4096 * 64 + bgoff; const bf16_t* Vsel = KV + (size_t)3 * 16 * 4096 * 64 + bgoff;
  const bf16_t* Kwin = KV + (size_t)4 * 16 * 4096 * 64 + bgoff; const bf16_t* Vwin = KV + (size_t)5 * 16 * 4096 * 64 + bgoff;
  const bf16_t* Kc = (const bf16_t*)(p.ws + OFF_KC) + (size_t)bg * 256 * 64; const bf16_t* Vc = (const bf16_t*)(p.ws + OFF_VC) + (size_t)bg * 256 * 64;
  f32x16 O[2];
#pragma unroll
  for (int db = 0; db < 2; ++db)
#pragma unroll
    for (int i = 0; i < 16; ++i) O[db][i] = 0.f;
  {
    const int ncmp = 4 * jt + 2 * (jt32 & 1) + 1, ntile = (ncmp + 63) >> 6;
    const unsigned long long cm = (1ull << ntile) - 1ull;
    float m_run = 0.f, l_run = 0.f;
    attn_branch<1>(gl, cnt, tgt, Kc, Vc, cm, qf, slope2, tq, jt, 0ull, m_run, l_run, 0.f, O, slab);
    const float lt = l_run + __shfl_xor(l_run, 32);
    const float invl = lt > 0.f ? __builtin_amdgcn_rcpf(lt) : 0.f;
    if (h == 0) ((LAS float*)(lds + A_LINV))[(grp * 4 + hh) * 32 + q] = invl;
    const float gsc = g_cmp * invl;
#pragma unroll
    for (int db = 0; db < 2; ++db)
#pragma unroll
      for (int gi = 0; gi < 4; ++gi) {
        *(f32x4*)(osc + 32 * db + 8 * gi) = (f32x4){O[db][4 * gi], O[db][4 * gi + 1], O[db][4 * gi + 2], O[db][4 * gi + 3]} * gsc;
        O[db][4 * gi] = 0.f; O[db][4 * gi + 1] = 0.f; O[db][4 * gi + 2] = 0.f; O[db][4 * gi + 3] = 0.f;
      }
  }
  group_sync(cnt, tgt, lane);
  {
    const LAS float* slabs = (const LAS float*)(lds + A_SLAB) + grp * 4 * SLAB_FLOATS;
    unsigned long long worm = 0ull;
    unsigned key[8], prefix[8];
#pragma unroll
    for (int tt = 0; tt < 8; ++tt) {
      const int tok = hh * 8 + tt;
      float v = 0.f;
#pragma unroll
      for (int h2 = 0; h2 < 4; ++h2) v += slabs[h2 * SLAB_FLOATS + tok * 65 + lane] * ((const LAS float*)(lds + A_LINV))[(grp * 4 + h2) * 32 + tok];
      if (lane == 0 || lane == jt || lane == jt - 1) v = 1e30f; else if (lane > jt) v = -1e30f;
      unsigned k = __float_as_uint(v); k = (k & 0x80000000u) ? ~k : (k | 0x80000000u);
      key[tt] = k; prefix[tt] = 0u;
    }
#pragma unroll
    for (int bit = 31; bit >= 0; --bit)
#pragma unroll
      for (int tt = 0; tt < 8; ++tt) {
        const unsigned cand = prefix[tt] | (1u << bit);
        const unsigned long long mge = __ballot(key[tt] >= cand);
        prefix[tt] = (__popcll(mge) >= 16) ? cand : prefix[tt];
      }
#pragma unroll
    for (int tt = 0; tt < 8; ++tt) {
      const unsigned long long mgt = __ballot(key[tt] > prefix[tt]), meq = __ballot(key[tt] == prefix[tt]);
      const int need = 16 - __popcll(mgt);
      const int rank_eq = __popcll(meq & ((1ull << lane) - 1ull));
      const unsigned long long msk = mgt | __ballot((key[tt] == prefix[tt]) && (rank_eq < need));
      if (lane == 0) selm[hh * 8 + tt] = msk;
      worm |= msk;
    }
    if (lane == 0) atomicOr((unsigned long long*)orm, worm);
  }
  if (gt == 0) *(LAS int*)(lds + A_NXT + 16 * grp) = popv;
  group_sync(cnt, tgt, lane);
  nenc = *(const LAS int*)(lds + A_NXT + 16 * grp);
  const unsigned long long mymask = selm[q];
  const unsigned long long ormask = *orm;
  const unsigned long long causal = (jt >= 63) ? ~0ull : ((2ull << jt) - 1ull);
  const int jlo = jt >= 8 ? jt - 8 : 0;
  {
    float m_run = 0.f, l_run = 0.f;
    attn_branch<2>(gl, cnt, tgt, Ksel, Vsel, ormask & causal, qf, slope2, tq, jt, mymask, m_run, l_run, 0.f, O, slab);
    const float lt = l_run + __shfl_xor(l_run, 32);
    const float sc = lt > 0.f ? g_sel / lt : 0.f;
#pragma unroll
    for (int db = 0; db < 2; ++db)
#pragma unroll
      for (int gi = 0; gi < 4; ++gi) {
        const f32x4 pv = *(const f32x4*)(osc + 32 * db + 8 * gi);
        *(f32x4*)(osc + 32 * db + 8 * gi) = pv + (f32x4){O[db][4 * gi], O[db][4 * gi + 1], O[db][4 * gi + 2], O[db][4 * gi + 3]} * sc;
        O[db][4 * gi] = 0.f; O[db][4 * gi + 1] = 0.f; O[db][4 * gi + 2] = 0.f; O[db][4 * gi + 3] = 0.f;
      }
  }
  {
    const unsigned long long wm = causal & ~((1ull << jlo) - 1ull);
    float m_run = 0.f, l_run = 0.f;
    attn_branch<3>(gl, cnt, tgt, Kwin, Vwin, wm, qf, slope2, tq, jt, 0ull, m_run, l_run, 0.f, O, slab);
    const float lt = l_run + __shfl_xor(l_run, 32);
    const float sc = lt > 0.f ? g_win / lt : 0.f;
#pragma unroll
    for (int db = 0; db < 2; ++db)
#pragma unroll
      for (int gi = 0; gi < 4; ++gi) {
        const f32x4 v = *(const f32x4*)(osc + 32 * db + 8 * gi) + (f32x4){O[db][4 * gi], O[db][4 * gi + 1], O[db][4 * gi + 2], O[db][4 * gi + 3]} * sc;
        u32x2 w; w.x = pk2(v[0], v[1]); w.y = pk2(v[2], v[3]);
        *(u32x2*)(cat + mrow * 1024 + 512 + head * 64 + 32 * db + 8 * gi + 4 * h) = w;
      }
  }
}

__global__ void __launch_bounds__(512, 2) fwd_megakernel(Params p) {
  extern __shared__ __attribute__((aligned(16))) unsigned char smem[];
  LAS unsigned char* lds = (LAS unsigned char*)smem;
  cg::grid_group grid = cg::this_grid();
  const int G = gridDim.x, bx = blockIdx.x;
  unsigned char* ws = p.ws;
  if (p.ws == nullptr) grid.sync();
  volatile LAS unsigned* bst = (volatile LAS unsigned*)(lds + LDS_BYTES - 16);
  if (threadIdx.x == 0) { bst[0] = 0u; bst[1] = 0u; }
  __syncthreads();
  const XcdBarrier gbar = xcd_barrier_post((unsigned*)(ws + OFF_BAR), bst);

  p0_prologue(p, lds);
  xcd_barrier(gbar);

  {
    pg8::Gemm g{(const bf16_t*)(ws + OFF_XB), (const bf16_t*)(ws + OFF_WIN), 1024, 1024, 1024, (size_t)256 * 1024 * 2, (size_t)256 * 1024 * 2};
    pg8::StaticOrder S; S.init(MTOK, 2560, G, bx);
    Epi1 E{(const float*)(ws + OFF_RS1), (bf16_t*)(ws + OFF_B), (bf16_t*)(ws + OFF_Q), (bf16_t*)(ws + OFF_KV), (float*)(ws + OFF_GATES)};
    pg8::gemm_phase<Epi1, pg8::StaticOrder, true, true>(lds, g, S, E);
  }
  xcd_barrier(gbar);

  {
    const int ncmp = (G > 64) ? 32 : 0;
    if (bx < ncmp) {
      const int kv = bx >> 4, pm = bx & 15;
      pg8::Gemm g{(const bf16_t*)(ws + OFF_KV) + (size_t)kv * 16 * 4096 * 64, (const bf16_t*)(ws + OFF_CW1) + (size_t)kv * 256 * 2048, 1024, 2048, 2048, (size_t)4096 * 64 * 2, 0};
      pg8::SingleUnit S{pm, 0};
      EpiCmp E{(const float*)(ws + OFF_CB1) + kv * 256, (const bf16_t*)(ws + OFF_CW2) + kv * 64 * 256, (bf16_t*)(ws + (kv ? OFF_VC : OFF_KC))};
      pg8::gemm_phase<EpiCmp, pg8::SingleUnit, false, true>(lds, g, S, E);
    } else {
      conv_load_taps(p, lds);
      for (int tile = bx - ncmp; tile < 1024; tile += G - ncmp) conv_tile(p, lds, tile);
    }
    if (ncmp == 0) {
      for (int un = bx; un < 32; un += G) {
        const int kv = un >> 4, pm = un & 15;
        pg8::Gemm g{(const bf16_t*)(ws + OFF_KV) + (size_t)kv * 16 * 4096 * 64, (const bf16_t*)(ws + OFF_CW1) + (size_t)kv * 256 * 2048, 1024, 2048, 2048, (size_t)4096 * 64 * 2, 0};
        pg8::SingleUnit S{pm, 0};
        EpiCmp E{(const float*)(ws + OFF_CB1) + kv * 256, (const bf16_t*)(ws + OFF_CW2) + kv * 64 * 256, (bf16_t*)(ws + (kv ? OFF_VC : OFF_KC))};
        pg8::gemm_phase<EpiCmp, pg8::SingleUnit, false, true>(lds, g, S, E);
      }
    }
  }
  xcd_barrier(gbar);

  {
    const int tid3 = get_tid(), grp = __builtin_amdgcn_readfirstlane(tid3 >> 8);
    if (tid3 < 2) *(LAS unsigned*)(lds + A_CNT + 16 * tid3) = 0u;
    __syncthreads();
    unsigned tgt = 0u;
    const int gt3 = tid3 & 255, lane3 = tid3 & 63;
    const unsigned xcc = xb_xcc_id();
    LAS unsigned* cnt3 = (LAS unsigned*)(lds + A_CNT + 16 * grp);
    if (gt3 == 0) *(LAS int*)(lds + A_NXT + 16 * grp) = queue_pop((unsigned*)(ws + OFF_QCNT), xcc);
    group_sync(cnt3, tgt, lane3);
    int enc = *(const LAS int*)(lds + A_NXT + 16 * grp);
    group_sync(cnt3, tgt, lane3);
    while (enc >= 0) { int nenc = -1; attn_item(p, lds, grp, tgt, enc, nenc, xcc); enc = nenc; }
  }
  xcd_barrier(gbar);

  {
    pg8::Gemm g{(const bf16_t*)(ws + OFF_CAT), (const bf16_t*)(ws + OFF_WOUT), 1024, 1024, 1024, (size_t)256 * 1024 * 2, (size_t)256 * 1024 * 2};
    pg8::StaticOrder S; S.init(MTOK, 1024, G, bx);
    EpiRes<false, true> E{(const bf16_t*)(ws + OFF_XB), p.out, (bf16_t*)(ws + OFF_B), (float*)(ws + OFF_SSQ2)};
    pg8::gemm_phase<EpiRes<false, true>, pg8::StaticOrder, true, true>(lds, g, S, E);
  }
  xcd_barrier(gbar);

  {
    pg8::Gemm g{(const bf16_t*)(ws + OFF_B), (const bf16_t*)(ws + OFF_WFF1), 1024, 1024, 1024, (size_t)256 * 1024 * 2, (size_t)256 * 1024 * 2};
    pg8::StaticOrder S; S.init(MTOK, 4096, G, bx);
    EpiFF1 E{(const float*)(ws + OFF_SSQ2), (bf16_t*)(ws + OFF_H)};
    pg8::gemm_phase<EpiFF1, pg8::StaticOrder, true, true>(lds, g, S, E);
  }
  xcd_barrier(gbar);

  const int fuse_final = (G == 256) ? 1 : 0;
  {
    pg8::Gemm g{(const bf16_t*)(ws + OFF_H), (const bf16_t*)(ws + OFF_WFF2), 4096, 4096, 4096, (size_t)256 * 4096 * 2, (size_t)256 * 4096 * 2};
    pg8::StaticOrder S; S.init(MTOK, 1024, G, bx);
    EpiFinal E{(const bf16_t*)(ws + OFF_B), p.out, (float*)(ws + OFF_SSQ3), (unsigned*)(ws + OFF_PCNT), p.norm_f_g, fuse_final};
    pg8::gemm_phase<EpiFinal, pg8::StaticOrder, true, true>(lds, g, S, E);
  }
  if (!fuse_final) {
    xcd_barrier(gbar);
    const int tid = get_tid(), lane = tid & 63, wid = tid >> 6;
    const float* ssq = (const float*)(ws + OFF_SSQ3);
    f32x4 gn[4];
#pragma unroll
    for (int i = 0; i < 4; ++i) gn[i] = *(const f32x4*)(p.norm_f_g + (lane + 64 * i) * 4);
    for (int r = bx * 8 + wid; r < MTOK; r += G * 8) {
      const float s = __builtin_amdgcn_rsqf(ssq[r] * (1.0f / 1024.0f) + EPSN);
      float* row = p.out + (size_t)r * 1024;
#pragma unroll
      for (int i = 0; i < 4; ++i) { f32x4 v = *(const f32x4*)(row + (lane + 64 * i) * 4); v = v * s * gn[i]; *(f32x4*)(row + (lane + 64 * i) * 4) = v; }
    }
  }
}

extern "C" void kernel_launch(void* const* d_in, const int* in_sizes, int n_in, void* d_out, int out_size, void* d_ws, size_t ws_size, hipStream_t stream) {
  constexpr size_t kDynLds = LDS_BYTES;
  static int grid_blocks = 0;
  if (!grid_blocks) {
    int dev = 0, cus = 0, per_cu = 0;
    (void)hipGetDevice(&dev);
    (void)hipDeviceGetAttribute(&cus, hipDeviceAttributeMultiprocessorCount, dev);
    (void)hipFuncSetAttribute((const void*)fwd_megakernel, hipFuncAttributeMaxDynamicSharedMemorySize, (int)kDynLds);
    (void)hipOccupancyMaxActiveBlocksPerMultiprocessor(&per_cu, (const void*)fwd_megakernel, 512, kDynLds);
    if (per_cu < 1) fprintf(stderr, "kernel_launch: occupancy query says %d blocks per CU\n", per_cu);
    grid_blocks = cus > 0 ? cus : 256;
    if (ws_size < WS_END) fprintf(stderr, "kernel_launch: workspace too small: %zu < %zu\n", ws_size, (size_t)WS_END);
  }
  (void)hipMemsetAsync((unsigned char*)d_ws + OFF_BAR, 0, XCD_BAR_WORDS * 4 + 256 * 256 + 8 * 256, stream);
  Params p{};
  p.x = (const float*)d_in[0]; p.norm1_g = (const float*)d_in[1]; p.w_in = (const float*)d_in[2]; p.dw_w = (const float*)d_in[3]; p.dw_b = (const float*)d_in[4];
  p.cln_g = (const float*)d_in[5]; p.cln_b = (const float*)d_in[6]; p.ck_pe = (const float*)d_in[7]; p.ck_w1 = (const float*)d_in[8]; p.ck_w2 = (const float*)d_in[9];
  p.cv_pe = (const float*)d_in[10]; p.cv_w1 = (const float*)d_in[11]; p.cv_w2 = (const float*)d_in[12]; p.w_out = (const float*)d_in[13]; p.norm2_g = (const float*)d_in[14];
  p.w_ff1 = (const float*)d_in[15]; p.w_ff2 = (const float*)d_in[16]; p.norm_f_g = (const float*)d_in[17];
  p.out = (float*)d_out; p.ws = (unsigned char*)d_ws;
  void* args[] = {&p};
  hipError_t e = hipLaunchCooperativeKernel((const void*)fwd_megakernel, dim3(grid_blocks), dim3(512), args, kDynLds, stream);
  if (e != hipSuccess) fprintf(stderr, "cooperative launch failed: %s (grid %d)\n", hipGetErrorString(e), grid_blocks);
}
```

```cpp
#include <hip/hip_runtime.h>
#include <hip/hip_cooperative_groups.h>
#include <cstdio>
namespace cg = cooperative_groups;

#define LAS __attribute__((address_space(3)))
#define DI __device__ __forceinline__
typedef unsigned short bf16_t;
typedef short bf16x8 __attribute__((ext_vector_type(8)));
typedef short s16x4 __attribute__((ext_vector_type(4)));
typedef float f32x4 __attribute__((ext_vector_type(4)));
typedef float f32x2 __attribute__((ext_vector_type(2)));
typedef float f32x16 __attribute__((ext_vector_type(16)));
typedef unsigned u32x4 __attribute__((ext_vector_type(4)));
typedef unsigned u32x2 __attribute__((ext_vector_type(2)));
typedef __bf16 bf16v2 __attribute__((ext_vector_type(2)));

constexpr float LOG2E = 1.4426950408889634f;
constexpr float EPSN = 1e-6f;
constexpr int LDS_BYTES = 147456;
constexpr int MTOK = 32768, TSEQ = 4096, DM = 1024, DFF = 4096;
constexpr float QSCALE = 0.125f * LOG2E;

constexpr size_t MiB = 1024 * 1024;
constexpr size_t XCD_BAR_WORDS_C = 3456;
constexpr size_t OFF_WIN = 0;
constexpr size_t OFF_WOUT = OFF_WIN + 2560 * 1024 * 2;
constexpr size_t OFF_WFF1 = OFF_WOUT + 1024 * 1024 * 2;
constexpr size_t OFF_WFF2 = OFF_WFF1 + 4096 * 1024 * 2;
constexpr size_t OFF_CW1 = OFF_WFF2 + 4096 * 1024 * 2;
constexpr size_t OFF_CW2 = OFF_CW1 + 2 * 256 * 2048 * 2;
constexpr size_t OFF_CB1 = OFF_CW2 + 2 * 64 * 256 * 2;
constexpr size_t OFF_RS1 = OFF_CB1 + 2 * 256 * 4;
constexpr size_t OFF_SSQ2 = OFF_RS1 + MTOK * 4;
constexpr size_t OFF_SSQ3 = OFF_SSQ2 + MTOK * 4;
constexpr size_t OFF_GATES = OFF_SSQ3 + MTOK * 4;
constexpr size_t OFF_KC = OFF_GATES + (size_t)MTOK * 24 * 4;
constexpr size_t OFF_VC = OFF_KC + 16 * 256 * 64 * 2;
constexpr size_t OFF_BAR = OFF_VC + 16 * 256 * 64 * 2;
constexpr size_t OFF_PCNT = OFF_BAR + XCD_BAR_WORDS_C * 4;
constexpr size_t OFF_QCNT = OFF_PCNT + 256 * 256;
constexpr size_t OFF_B = 30 * MiB;
constexpr size_t OFF_H = 94 * MiB;
constexpr size_t OFF_XB = OFF_H;
constexpr size_t OFF_Q = OFF_H + 64 * MiB;
constexpr size_t OFF_KV = OFF_H + 96 * MiB;
constexpr size_t OFF_CAT = OFF_H + 256 * MiB;
constexpr size_t WS_END = OFF_CAT + 64 * MiB;
static_assert(OFF_QCNT + 8 * 256 <= OFF_B, "ws map");

struct Params {
  const float* x; const float* norm1_g; const float* w_in; const float* dw_w; const float* dw_b; const float* cln_g; const float* cln_b;
  const float* ck_pe; const float* ck_w1; const float* ck_w2; const float* cv_pe; const float* cv_w1; const float* cv_w2;
  const float* w_out; const float* norm2_g; const float* w_ff1; const float* w_ff2; const float* norm_f_g;
  float* out; unsigned char* ws;
};

DI unsigned pk2(float a, float b) { f32x2 v = {a, b}; bf16v2 r = __builtin_convertvector(v, bf16v2); return __builtin_bit_cast(unsigned, r); }
DI float bf2f(unsigned short u) { return __uint_as_float((unsigned)u << 16); }
DI float sigmoidf_(float v) { return __builtin_amdgcn_rcpf(1.0f + __builtin_amdgcn_exp2f(-v * LOG2E)); }
DI float gelu_tanh(float v) { const float u = 0.7978845608028654f * (v + 0.044715f * v * v * v); const float e = __builtin_amdgcn_exp2f(2.0f * LOG2E * u); const float th = 1.0f - 2.0f * __builtin_amdgcn_rcpf(e + 1.0f); return 0.5f * v * (1.0f + th); }
DI float wave_sum(float v) { v += __shfl_xor(v, 1); v += __shfl_xor(v, 2); v += __shfl_xor(v, 4); v += __shfl_xor(v, 8); v += __shfl_xor(v, 16); v += __shfl_xor(v, 32); return v; }

DI void st_nt(u32x4* p, u32x4 v) { __builtin_nontemporal_store(v, p); }
DI void st_nt(f32x4* p, f32x4 v) { __builtin_nontemporal_store(v, p); }
DI int get_tid() { int t = threadIdx.x; asm volatile("" : "+v"(t)); return t; }

#define XB_TMO      128
#define XB_XCNT(j)  (256  + 64 * (j))
#define XB_XSUB(j)  (1280 + 64 * (j))
#define XB_XGEN(j)  (2304 + 64 * (j))
#define XB_TOP      3328
#define XB_TOPGEN   3392
#define XCD_BAR_WORDS 3456
#define XB_SPIN_CAP (1u << 22)
DI unsigned xb_ld(unsigned* p) { return __hip_atomic_load(p, __ATOMIC_RELAXED, __HIP_MEMORY_SCOPE_AGENT); }
DI unsigned xb_add(unsigned* p, unsigned v) { return __hip_atomic_fetch_add(p, v, __ATOMIC_RELAXED, __HIP_MEMORY_SCOPE_AGENT); }
DI unsigned xb_xcc_id() { return (unsigned)__builtin_amdgcn_s_getreg((3 << 11) | 20) & 0xFu; }
#define XB_SPIN(cond, bar) do { unsigned _sp = 0; while (cond) { __builtin_amdgcn_s_sleep(1); \
    if ((++_sp & 255u) == 0u) { if (xb_ld(&(bar)[XB_TMO])) break; if (_sp > XB_SPIN_CAP) { atomicAdd(&(bar)[XB_TMO], 1u); break; } } } } while (0)
struct XcdBarrier { unsigned* bar; unsigned x; volatile LAS unsigned* st; };
DI XcdBarrier xcd_barrier_post(unsigned* bar, volatile LAS unsigned* st) {
  XcdBarrier b; b.bar = bar; b.x = xb_xcc_id(); b.st = st;
  if (threadIdx.x == 0) (void)xb_add(&bar[XB_XCNT(b.x)], 1u);
  return b;
}
DI void xcd_barrier_complete(unsigned* bar, unsigned x, unsigned& nloc, unsigned& nx) {
  const unsigned G = gridDim.x;
  unsigned sum, cnt, mine, sp = 0u;
  for (;;) {
    sum = 0u; cnt = 0u; mine = 0u;
#pragma unroll
    for (unsigned j = 0; j < 16; ++j) { const unsigned c = xb_ld(&bar[XB_XCNT(j)]); sum += c; cnt += (c > 0u) ? 1u : 0u; mine = (j == x) ? c : mine; }
    if (sum == G) break;
    __builtin_amdgcn_s_sleep(1);
    if ((++sp & 255u) == 0u) { if (xb_ld(&bar[XB_TMO])) break; if (sp > XB_SPIN_CAP) { atomicAdd(&bar[XB_TMO], 1u); break; } }
  }
  nloc = mine > 0u ? mine : 1u; nx = cnt > 0u ? cnt : 1u;
}
DI void xcd_barrier(const XcdBarrier& b) {
  asm volatile("s_waitcnt vmcnt(0)" ::: "memory");
  __syncthreads();
  if (threadIdx.x == 0) {
    unsigned* bar = b.bar;
    __builtin_amdgcn_s_waitcnt(0);
    unsigned nloc = b.st[0], nx = b.st[1];
    if (nloc == 0u) { xcd_barrier_complete(bar, b.x, nloc, nx); b.st[0] = nloc; b.st[1] = nx; }
    const unsigned old = xb_add(&bar[XB_XSUB(b.x)], 1u);
    const unsigned gen = old / nloc;
    if (old + 1u == (gen + 1u) * nloc) {
      __builtin_amdgcn_fence(__ATOMIC_RELEASE, "agent");
      asm volatile("s_waitcnt vmcnt(0)" ::: "memory");
      const unsigned og = xb_add(&bar[XB_TOP], 1u);
      const unsigned tg = og / nx;
      if (og + 1u == (tg + 1u) * nx) xb_add(&bar[XB_TOPGEN], 1u);
      else XB_SPIN(xb_ld(&bar[XB_TOPGEN]) == tg, bar);
      __builtin_amdgcn_fence(__ATOMIC_ACQUIRE, "agent");
      xb_add(&bar[XB_XGEN(b.x)], 1u);
      asm volatile("s_waitcnt vmcnt(0)" ::: "memory");
    } else {
      XB_SPIN(xb_ld(&bar[XB_XGEN(b.x)]) == gen, bar);
      __builtin_amdgcn_fence(__ATOMIC_ACQUIRE, "agent");
      asm volatile("s_waitcnt vmcnt(0)" ::: "memory");
    }
  }
  __syncthreads();
}
namespace pg8 {
constexpr int BM = 256, BK = 64, HALF = 128, HTB = HALF * BK * 2, STAGE_BYTES = 8 * HTB, NXCD = 8, WGM = 8;
DI int lds_byte(int r, int c) { const int st = (r >> 4) * 2 + (c >> 5), rr = r & 15, cc = c & 31, ob = rr * 64 + cc * 2; return st * 1024 + (ob ^ (((ob >> 9) & 1) << 5)); }
DI void stage_rc(int b, int& R, int& C) { const int st = b / 1024, sb = b % 1024, swz = sb ^ (((sb >> 9) & 1) << 5); R = (st >> 1) * 16 + swz / 64; C = (st & 1) * 32 + (swz % 64) / 2; }
DI int perm32(int rho) { const int n = rho >> 4, i = rho & 15; return 8 * (i >> 2) + 4 * n + (i & 3); }

struct Unit { int pm, pn; };
struct Gemm { const bf16_t* A; const bf16_t* Bt; int lda, ldb, K; size_t tstepA, tstepB; };

struct StaticOrder {
  int nM, nN, nwg, G, c;
  DI void init(int M, int N, int G_, int c_) { nM = M / BM; nN = N / BM; nwg = nM * nN; G = G_; c = c_; }
  DI bool next(int i, Unit& u) const {
    const long L = (long)i * G + c; if (L >= nwg) return false;
    int wgid = (int)L; { const int q = nwg / NXCD, r = nwg % NXCD, xcd = wgid % NXCD, off = wgid / NXCD; wgid = (xcd < r ? xcd * (q + 1) : r * (q + 1) + (xcd - r) * q) + off; }
    const int nig = WGM * nN, gid = wgid / nig, fm = gid * WGM, gsz = (nM - fm) < WGM ? (nM - fm) : WGM;
    u.pm = fm + ((wgid % nig) % gsz); u.pn = (wgid % nig) / gsz; return true;
  }
};
struct SingleUnit {
  int pm, pn;
  DI bool next(int i, Unit& u) const { if (i != 0) return false; u.pm = pm; u.pn = pn; return true; }
};

template <class Epi, class Sched, bool ALIGN_EPI = false, bool SP2 = false>
DI void gemm_phase(LAS unsigned char* lds, const Gemm g, const Sched& S, const Epi& E) {
  const int tid = get_tid(), wid = __builtin_amdgcn_readfirstlane(tid >> 6), lane = tid & 63, wr = wid >> 2, wc = wid & 3, fr = lane & 15, fq = lane >> 4;
  const int K = g.K, nt = K / BK;
  unsigned voffA[2], voffB[2];
#pragma unroll
  for (int i = 0; i < 2; ++i) { int R, C; stage_rc(tid * 16 + i * 8192, R, C); const int Rb = Epi::PERM ? ((R & ~31) + perm32(R & 31)) : R;
    voffA[i] = (unsigned)(R * g.lda + C) * 2u; voffB[i] = (unsigned)(Rb * g.ldb + C) * 2u; }
  const size_t kstep = (size_t)(BK * 2);
  const size_t hstepA = (size_t)HALF * g.lda * 2, hstepB = (size_t)HALF * g.ldb * 2;
  const unsigned ldsw = (unsigned)wid * 1024u;
  const int aoff = lds_byte(wr * 64 + fr, fq * 8), boff = lds_byte(wc * 32 + fr, fq * 8);
#define PG8_SA(b, h) (((b) * 2 + (h)) * HTB)
#define PG8_SB(b, h) ((4 + (b) * 2 + (h)) * HTB)
#define PG8_STAGE(bufoff, gbase, voff) do { _Pragma("unroll") for (int _i = 0; _i < 2; ++_i) \
    __builtin_amdgcn_global_load_lds((const unsigned*)((const char*)(gbase) + (voff)[_i]), (LAS unsigned*)(lds + (bufoff) + ldsw + _i * 8192), 16, 0, 0); } while (0)
#define PG8_LDA(dst, b, h) do { _Pragma("unroll") for (int m = 0; m < 4; ++m) _Pragma("unroll") for (int k = 0; k < 2; ++k) dst[m][k] = *(const LAS bf16x8*)(lds + PG8_SA(b, h) + aoff + m * 2048 + k * 1024); } while (0)
#define PG8_LDB(dst, b, h) do { _Pragma("unroll") for (int n = 0; n < 2; ++n) _Pragma("unroll") for (int k = 0; k < 2; ++k) dst[n][k] = *(const LAS bf16x8*)(lds + PG8_SB(b, h) + boff + n * 2048 + k * 1024); } while (0)
#define PG8_MMA(ai, bj, At, Bt) do { __builtin_amdgcn_s_setprio(1); _Pragma("unroll") for (int m = 0; m < 4; ++m) _Pragma("unroll") for (int n = 0; n < 2; ++n) _Pragma("unroll") for (int k = 0; k < 2; ++k) \
    acc[ai][bj][m][n] = __builtin_amdgcn_mfma_f32_16x16x32_bf16(Bt[n][k], At[m][k], acc[ai][bj][m][n], 0, 0, 0); __builtin_amdgcn_s_setprio(0); } while (0)
#define PG8_WAIT_V(n) asm volatile("s_waitcnt vmcnt(" #n ")" ::: "memory")
#define PG8_WAIT_L(n) asm volatile("s_waitcnt lgkmcnt(" #n ")" ::: "memory")
#define PG8_BAR __builtin_amdgcn_s_barrier()
#define PG8_SCHED __builtin_amdgcn_sched_barrier(0)
  Unit cur, nxt; int ui = 0;
  if (!S.next(0, cur)) return;
  f32x4 acc[2][2][4][2];
#pragma unroll
  for (int a = 0; a < 2; ++a)
#pragma unroll
    for (int b = 0; b < 2; ++b)
#pragma unroll
      for (int m = 0; m < 4; ++m)
#pragma unroll
        for (int n = 0; n < 2; ++n) acc[a][b][m][n] = (f32x4){0.f, 0.f, 0.f, 0.f};
  bf16x8 At[4][2], B0[2][2], B1[2][2];
  const char* cA = (const char*)g.A + (size_t)cur.pm * g.tstepA; const char* cB = (const char*)g.Bt + (size_t)cur.pn * g.tstepB;
  if constexpr (SP2) {
    PG8_STAGE(PG8_SB(0, 0), cB, voffB); PG8_STAGE(PG8_SB(0, 1), cB + hstepB, voffB); PG8_STAGE(PG8_SA(0, 0), cA, voffA); PG8_STAGE(PG8_SA(0, 1), cA + hstepA, voffA);
    if (wr == 1) PG8_BAR;
    PG8_WAIT_V(2); PG8_BAR;
    PG8_STAGE(PG8_SB(1, 0), cB + kstep, voffB); PG8_STAGE(PG8_SA(1, 0), cA + kstep, voffA); PG8_STAGE(PG8_SB(1, 1), cB + hstepB + kstep, voffB);
    PG8_WAIT_V(6); PG8_BAR;
  } else {
    PG8_STAGE(PG8_SB(0, 0), cB, voffB); PG8_STAGE(PG8_SA(0, 0), cA, voffA); PG8_STAGE(PG8_SB(0, 1), cB + hstepB, voffB); PG8_STAGE(PG8_SA(0, 1), cA + hstepA, voffA);
    if (wr == 1) PG8_BAR;
    PG8_WAIT_V(4); PG8_BAR;
    PG8_STAGE(PG8_SB(1, 0), cB + kstep, voffB); PG8_STAGE(PG8_SA(1, 0), cA + kstep, voffA); PG8_STAGE(PG8_SB(1, 1), cB + hstepB + kstep, voffB);
    PG8_WAIT_V(6); PG8_BAR;
  }
  for (;;) {
    const bool has_next = S.next(ui + 1, nxt);
    const char* nA = has_next ? (const char*)g.A + (size_t)nxt.pm * g.tstepA : cA; const char* nB = has_next ? (const char*)g.Bt + (size_t)nxt.pn * g.tstepB : cB;
    for (int t = 0; t < nt; t += 2) {
      const bool last = (t == nt - 2);
      const char* a1 = cA + (size_t)(t + 1) * kstep;
      const char* a2 = last ? nA : cA + (size_t)(t + 2) * kstep; const char* b2 = last ? nB : cB + (size_t)(t + 2) * kstep;
      const char* a3 = a2 + kstep; const char* b3 = b2 + kstep;
      if constexpr (SP2) {
        PG8_LDB(B0, 0, 0); PG8_LDB(B1, 0, 1); PG8_SCHED; PG8_LDA(At, 0, 0); PG8_STAGE(PG8_SA(1, 1), a1 + hstepA, voffA);
        PG8_WAIT_V(8); PG8_WAIT_L(0); PG8_BAR; PG8_MMA(0, 0, At, B0); PG8_MMA(0, 1, At, B1); PG8_BAR; PG8_SCHED;
        PG8_LDA(At, 0, 1); PG8_STAGE(PG8_SB(0, 0), b2, voffB); PG8_STAGE(PG8_SB(0, 1), b2 + hstepB, voffB); PG8_STAGE(PG8_SA(0, 0), a2, voffA);
        PG8_WAIT_V(8); PG8_WAIT_L(0); PG8_BAR; PG8_MMA(1, 0, At, B0); PG8_MMA(1, 1, At, B1); PG8_BAR; PG8_SCHED;
        PG8_LDB(B0, 1, 0); PG8_LDB(B1, 1, 1); PG8_SCHED; PG8_LDA(At, 1, 0); PG8_STAGE(PG8_SA(0, 1), a2 + hstepA, voffA);
        PG8_WAIT_V(8); PG8_WAIT_L(0); PG8_BAR; PG8_MMA(0, 0, At, B0); PG8_MMA(0, 1, At, B1); PG8_BAR; PG8_SCHED;
        PG8_LDA(At, 1, 1); PG8_STAGE(PG8_SB(1, 0), b3, voffB); PG8_STAGE(PG8_SB(1, 1), b3 + hstepB, voffB); PG8_STAGE(PG8_SA(1, 0), a3, voffA);
        PG8_WAIT_V(8); PG8_WAIT_L(0); PG8_BAR; PG8_MMA(1, 0, At, B0); PG8_MMA(1, 1, At, B1); PG8_BAR; PG8_SCHED;
      } else {
        PG8_LDB(B0, 0, 0); PG8_SCHED; PG8_LDA(At, 0, 0); PG8_STAGE(PG8_SA(1, 1), a1 + hstepA, voffA);
        PG8_WAIT_L(8); PG8_BAR; PG8_WAIT_L(0); PG8_MMA(0, 0, At, B0); PG8_BAR; PG8_SCHED;
        PG8_LDB(B1, 0, 1); PG8_STAGE(PG8_SB(0, 0), b2, voffB);
        PG8_BAR; PG8_WAIT_L(0); PG8_MMA(0, 1, At, B1); PG8_BAR;
        PG8_LDA(At, 0, 1); PG8_STAGE(PG8_SA(0, 0), a2, voffA);
        PG8_BAR; PG8_WAIT_L(0); PG8_MMA(1, 0, At, B0); PG8_BAR; PG8_SCHED;
        PG8_STAGE(PG8_SB(0, 1), b2 + hstepB, voffB);
        PG8_WAIT_V(6); PG8_BAR; PG8_MMA(1, 1, At, B1); PG8_BAR;
        PG8_LDB(B0, 1, 0); PG8_SCHED; PG8_LDA(At, 1, 0); PG8_STAGE(PG8_SA(0, 1), a2 + hstepA, voffA);
        PG8_WAIT_L(8); PG8_BAR; PG8_WAIT_L(0); PG8_MMA(0, 0, At, B0); PG8_BAR; PG8_SCHED;
        PG8_LDB(B1, 1, 1); PG8_STAGE(PG8_SB(1, 0), b3, voffB);
        PG8_BAR; PG8_WAIT_L(0); PG8_MMA(0, 1, At, B1); PG8_BAR;
        PG8_LDA(At, 1, 1); PG8_STAGE(PG8_SA(1, 0), a3, voffA);
        PG8_BAR; PG8_WAIT_L(0); PG8_MMA(1, 0, At, B0); PG8_BAR; PG8_SCHED;
        PG8_STAGE(PG8_SB(1, 1), b3 + hstepB, voffB);
        PG8_WAIT_V(6); PG8_BAR; PG8_MMA(1, 1, At, B1); PG8_BAR;
      }
    }
    if constexpr (ALIGN_EPI) { if (wr == 0) PG8_BAR; }
    if constexpr (!Epi::AFTER_DRAIN) { E(acc, cur, wr, wc, fr, fq); }
    if (!has_next) break;
#pragma unroll
    for (int a = 0; a < 2; ++a)
#pragma unroll
      for (int b = 0; b < 2; ++b)
#pragma unroll
        for (int m = 0; m < 4; ++m)
#pragma unroll
          for (int n = 0; n < 2; ++n) acc[a][b][m][n] = (f32x4){0.f, 0.f, 0.f, 0.f};
    cur = nxt; cA = nA; cB = nB; ++ui;
    if constexpr (ALIGN_EPI) { if (wr == 1) PG8_BAR; }
  }
  PG8_WAIT_V(0);
  if constexpr (!ALIGN_EPI) { if (wr == 0) PG8_BAR; }
  PG8_BAR;
  if constexpr (Epi::AFTER_DRAIN) { E.fused(acc, cur, wr, wc, fr, fq, lds, wid, lane); }
#undef PG8_SA
#undef PG8_SB
#undef PG8_STAGE
#undef PG8_LDA
#undef PG8_LDB
#undef PG8_MMA
#undef PG8_WAIT_V
#undef PG8_WAIT_L
#undef PG8_BAR
#undef PG8_SCHED
}
}

struct Epi1 {
  static constexpr bool PERM = true, AFTER_DRAIN = false;
  const float* rs; bf16_t* uv; bf16_t* q; bf16_t* kv; float* gates;
  DI void operator()(const f32x4 (&acc)[2][2][4][2], const pg8::Unit& u, int wr, int wc, int fr, int fq) const {
    const int pn = u.pn;
#pragma unroll
    for (int ai = 0; ai < 2; ++ai)
#pragma unroll
      for (int m = 0; m < 4; ++m) {
        const int r = u.pm * 256 + ai * 128 + wr * 64 + m * 16 + fr;
        const float s = rs[r];
#pragma unroll
        for (int bj = 0; bj < 2; ++bj) {
          const int cl = bj * 128 + wc * 32 + 8 * fq;
          f32x4 v0 = acc[ai][bj][m][0] * s, v1 = acc[ai][bj][m][1] * s;
          if (pn < 4) {
            u32x4 w; w.x = pk2(v0[0], v0[1]); w.y = pk2(v0[2], v0[3]); w.z = pk2(v1[0], v1[1]); w.w = pk2(v1[2], v1[3]);
            *(u32x4*)(uv + (size_t)r * 1024 + pn * 256 + cl) = w;
          } else if (pn < 6) {
            v0 = v0 * QSCALE; v1 = v1 * QSCALE;
            u32x4 w; w.x = pk2(v0[0], v0[1]); w.y = pk2(v0[2], v0[3]); w.z = pk2(v1[0], v1[1]); w.w = pk2(v1[2], v1[3]);
            *(u32x4*)(q + (size_t)r * 512 + (pn - 4) * 256 + cl) = w;
          } else if (pn < 9) {
            const int kvidx = (pn - 6) * 256 + cl, br = kvidx >> 7, gg = (kvidx >> 6) & 1, d = kvidx & 63, b = r >> 12, t = r & 4095;
            u32x4 w; w.x = pk2(v0[0], v0[1]); w.y = pk2(v0[2], v0[3]); w.z = pk2(v1[0], v1[1]); w.w = pk2(v1[2], v1[3]);
            *(u32x4*)(kv + ((size_t)(((br * 8 + b) * 2 + gg) * 4096 + t)) * 64 + d) = w;
          } else {
            if (cl < 24) {
              f32x4 g0, g1;
#pragma unroll
              for (int j = 0; j < 4; ++j) { g0[j] = sigmoidf_(v0[j]); g1[j] = sigmoidf_(v1[j]); }
              *(f32x4*)(gates + (size_t)r * 24 + cl) = g0; *(f32x4*)(gates + (size_t)r * 24 + cl + 4) = g1;
            }
          }
        }
      }
  }
};
template <bool WRITE_IO, bool WRITE_B> struct EpiRes {
  static constexpr bool PERM = true, AFTER_DRAIN = false;
  const bf16_t* base; float* io; bf16_t* xb; float* ssq;
  DI void operator()(const f32x4 (&acc)[2][2][4][2], const pg8::Unit& u, int wr, int wc, int fr, int fq) const {
#pragma unroll
    for (int ai = 0; ai < 2; ++ai)
#pragma unroll
      for (int m = 0; m < 4; ++m) {
        const int r = u.pm * 256 + ai * 128 + wr * 64 + m * 16 + fr;
        float ss = 0.f;
#pragma unroll
        for (int bj = 0; bj < 2; ++bj) {
          const size_t off = (size_t)r * 1024 + u.pn * 256 + bj * 128 + wc * 32 + 8 * fq;
          const u32x4 xw = *(const u32x4*)(base + off);
          const f32x4 b0 = (f32x4){__uint_as_float(xw.x << 16), __uint_as_float(xw.x & 0xffff0000u), __uint_as_float(xw.y << 16), __uint_as_float(xw.y & 0xffff0000u)};
          const f32x4 b1 = (f32x4){__uint_as_float(xw.z << 16), __uint_as_float(xw.z & 0xffff0000u), __uint_as_float(xw.w << 16), __uint_as_float(xw.w & 0xffff0000u)};
          const f32x4 v0 = acc[ai][bj][m][0] + b0, v1 = acc[ai][bj][m][1] + b1;
          if (WRITE_IO) { *(f32x4*)(io + off) = v0; *(f32x4*)(io + off + 4) = v1; }
          if (WRITE_B) { u32x4 w; w.x = pk2(v0[0], v0[1]); w.y = pk2(v0[2], v0[3]); w.z = pk2(v1[0], v1[1]); w.w = pk2(v1[2], v1[3]); *(u32x4*)(xb + off) = w; }
          ss += (v0[0] * v0[0] + v0[1] * v0[1]) + (v0[2] * v0[2] + v0[3] * v0[3]) + (v1[0] * v1[0] + v1[1] * v1[1]) + (v1[2] * v1[2] + v1[3] * v1[3]);
        }
        ss += __shfl_xor(ss, 16); ss += __shfl_xor(ss, 32);
        if (fq == 0) atomicAdd(ssq + r, ss);
      }
  }
};
struct EpiFF1 {
  static constexpr bool PERM = true, AFTER_DRAIN = false;
  const float* ssq; bf16_t* hid;
  DI void operator()(const f32x4 (&acc)[2][2][4][2], const pg8::Unit& u, int wr, int wc, int fr, int fq) const {
#pragma unroll
    for (int ai = 0; ai < 2; ++ai)
#pragma unroll
      for (int m = 0; m < 4; ++m) {
        const int r = u.pm * 256 + ai * 128 + wr * 64 + m * 16 + fr;
        const float s = __builtin_amdgcn_rsqf(ssq[r] * (1.0f / 1024.0f) + EPSN);
#pragma unroll
        for (int bj = 0; bj < 2; ++bj) {
          f32x4 v0 = acc[ai][bj][m][0] * s, v1 = acc[ai][bj][m][1] * s;
#pragma unroll
          for (int j = 0; j < 4; ++j) { const float a = fmaxf(v0[j], 0.f), b = fmaxf(v1[j], 0.f); v0[j] = a * a; v1[j] = b * b; }
          u32x4 w; w.x = pk2(v0[0], v0[1]); w.y = pk2(v0[2], v0[3]); w.z = pk2(v1[0], v1[1]); w.w = pk2(v1[2], v1[3]);
          st_nt((u32x4*)(hid + (size_t)r * 4096 + u.pn * 256 + bj * 128 + wc * 32 + 8 * fq), w);
        }
      }
  }
};
struct EpiFinal {
  static constexpr bool PERM = true, AFTER_DRAIN = false;
  const bf16_t* xb; float* io; float* ssq; unsigned* cnt; const float* gn; int fuse;
  DI void operator()(f32x4 (&acc)[2][2][4][2], const pg8::Unit& u, int wr, int wc, int fr, int fq) const {
#pragma unroll
    for (int ai = 0; ai < 2; ++ai)
#pragma unroll
      for (int m = 0; m < 4; ++m) {
        const int r = u.pm * 256 + ai * 128 + wr * 64 + m * 16 + fr;
        float ss = 0.f;
#pragma unroll
        for (int bj = 0; bj < 2; ++bj) {
          const size_t off = (size_t)r * 1024 + u.pn * 256 + bj * 128 + wc * 32 + 8 * fq;
          const u32x4 xw = *(const u32x4*)(xb + off);
          const f32x4 b0 = (f32x4){__uint_as_float(xw.x << 16), __uint_as_float(xw.x & 0xffff0000u), __uint_as_float(xw.y << 16), __uint_as_float(xw.y & 0xffff0000u)};
          const f32x4 b1 = (f32x4){__uint_as_float(xw.z << 16), __uint_as_float(xw.z & 0xffff0000u), __uint_as_float(xw.w << 16), __uint_as_float(xw.w & 0xffff0000u)};
          const f32x4 v0 = acc[ai][bj][m][0] + b0, v1 = acc[ai][bj][m][1] + b1;
          acc[ai][bj][m][0] = v0; acc[ai][bj][m][1] = v1;
          if (!fuse) { *(f32x4*)(io + off) = v0; *(f32x4*)(io + off + 4) = v1; }
          ss += (v0[0] * v0[0] + v0[1] * v0[1]) + (v0[2] * v0[2] + v0[3] * v0[3]) + (v1[0] * v1[0] + v1[1] * v1[1]) + (v1[2] * v1[2] + v1[3] * v1[3]);
        }
        ss += __shfl_xor(ss, 16); ss += __shfl_xor(ss, 32);
        if (fq == 0) atomicAdd(ssq + r, ss);
      }
    if (!fuse) return;
    asm volatile("s_waitcnt vmcnt(0)" ::: "memory");
    unsigned* c = cnt + 64 * (u.pm * 2 + wr);
    if (fr == 0 && fq == 0) __hip_atomic_fetch_add(c, 1u, __ATOMIC_RELAXED, __HIP_MEMORY_SCOPE_AGENT);
    { unsigned sp = 0; while ((unsigned)__builtin_amdgcn_readfirstlane(__hip_atomic_load(c, __ATOMIC_RELAXED, __HIP_MEMORY_SCOPE_AGENT)) < 16u) { __builtin_amdgcn_s_sleep(2); if (++sp > (1u << 22)) break; } }
    f32x4 g[2][2];
#pragma unroll
    for (int bj = 0; bj < 2; ++bj)
#pragma unroll
      for (int n = 0; n < 2; ++n) g[bj][n] = *(const f32x4*)(gn + u.pn * 256 + bj * 128 + wc * 32 + 8 * fq + 4 * n);
#pragma unroll
    for (int ai = 0; ai < 2; ++ai)
#pragma unroll
      for (int m = 0; m < 4; ++m) {
        const int r = u.pm * 256 + ai * 128 + wr * 64 + m * 16 + fr;
        const float s = __builtin_amdgcn_rsqf(__hip_atomic_load(ssq + r, __ATOMIC_RELAXED, __HIP_MEMORY_SCOPE_AGENT) * (1.0f / 1024.0f) + EPSN);
#pragma unroll
        for (int bj = 0; bj < 2; ++bj) {
          const size_t off = (size_t)r * 1024 + u.pn * 256 + bj * 128 + wc * 32 + 8 * fq;
          st_nt((f32x4*)(io + off), acc[ai][bj][m][0] * s * g[bj][0]); st_nt((f32x4*)(io + off + 4), acc[ai][bj][m][1] * s * g[bj][1]);
        }
      }
  }
};
constexpr int HSTR = 528;
struct EpiCmp {
  static constexpr bool PERM = false, AFTER_DRAIN = true;
  const float* bias1; const bf16_t* w2t; bf16_t* outp;
  DI void fused(const f32x4 (&acc)[2][2][4][2], const pg8::Unit& u, int wr, int wc, int fr, int fq, LAS unsigned char* lds, int wid, int lane) const {
#pragma unroll
    for (int bj = 0; bj < 2; ++bj)
#pragma unroll
      for (int n = 0; n < 2; ++n) {
        const int c = bj * 128 + wc * 32 + n * 16 + 4 * fq;
        const f32x4 bv = *(const f32x4*)(bias1 + c);
#pragma unroll
        for (int ai = 0; ai < 2; ++ai)
#pragma unroll
          for (int m = 0; m < 4; ++m) {
            const int r = ai * 128 + wr * 64 + m * 16 + fr;
            const f32x4 v = acc[ai][bj][m][n] + bv;
            u32x2 w; w.x = pk2(gelu_tanh(v[0]), gelu_tanh(v[1])); w.y = pk2(gelu_tanh(v[2]), gelu_tanh(v[3]));
            *(LAS u32x2*)(lds + r * HSTR + c * 2) = w;
          }
      }
    __syncthreads();
    f32x4 o[2][4];
#pragma unroll
    for (int mb = 0; mb < 2; ++mb)
#pragma unroll
      for (int nb = 0; nb < 4; ++nb) o[mb][nb] = (f32x4){0.f, 0.f, 0.f, 0.f};
    bf16x8 wf[8][4];
#pragma unroll
    for (int ks = 0; ks < 8; ++ks)
#pragma unroll
      for (int nb = 0; nb < 4; ++nb) wf[ks][nb] = *(const bf16x8*)(w2t + (16 * nb + fr) * 256 + 32 * ks + 8 * fq);
#pragma unroll
    for (int ks = 0; ks < 8; ++ks) {
      bf16x8 hf[2];
#pragma unroll
      for (int mb = 0; mb < 2; ++mb) hf[mb] = *(const LAS bf16x8*)(lds + (32 * wid + 16 * mb + fr) * HSTR + (32 * ks + 8 * fq) * 2);
#pragma unroll
      for (int mb = 0; mb < 2; ++mb)
#pragma unroll
        for (int nb = 0; nb < 4; ++nb) o[mb][nb] = __builtin_amdgcn_mfma_f32_16x16x32_bf16(wf[ks][nb], hf[mb], o[mb][nb], 0, 0, 0);
    }
#pragma unroll
    for (int mb = 0; mb < 2; ++mb)
#pragma unroll
      for (int nb = 0; nb < 4; ++nb) {
        const int row = 32 * wid + 16 * mb + fr;
        u32x2 w; w.x = pk2(o[mb][nb][0], o[mb][nb][1]); w.y = pk2(o[mb][nb][2], o[mb][nb][3]);
        *(u32x2*)(outp + ((size_t)u.pm * 256 + row) * 64 + 16 * nb + 4 * fq) = w;
      }
    __syncthreads();
  }
};

struct TJob { const float* src; bf16_t* dst; const float* g; int K, N, kt, nt; };
DI TJob transpose_job(const Params& p, int job) {
  unsigned char* ws = p.ws; TJob t;
  if (job < 640) t = TJob{p.w_in, (bf16_t*)(ws + OFF_WIN), p.norm1_g, 1024, 2328, job / 40, job % 40};
  else if (job < 896) { const int j = job - 640; t = TJob{p.w_out, (bf16_t*)(ws + OFF_WOUT), nullptr, 1024, 1024, j / 16, j % 16}; }
  else if (job < 1920) { const int j = job - 896; t = TJob{p.w_ff1, (bf16_t*)(ws + OFF_WFF1), p.norm2_g, 1024, 4096, j / 64, j % 64}; }
  else if (job < 2944) { const int j = job - 1920; t = TJob{p.w_ff2, (bf16_t*)(ws + OFF_WFF2), nullptr, 4096, 1024, j / 16, j % 16}; }
  else if (job < 3072) { const int j = job - 2944; t = TJob{p.ck_w1, (bf16_t*)(ws + OFF_CW1), nullptr, 2048, 256, j / 4, j % 4}; }
  else if (job < 3200) { const int j = job - 3072; t = TJob{p.cv_w1, (bf16_t*)(ws + OFF_CW1) + 256 * 2048, nullptr, 2048, 256, j / 4, j % 4}; }
  else if (job < 3204) { const int j = job - 3200; t = TJob{p.ck_w2, (bf16_t*)(ws + OFF_CW2), nullptr, 256, 64, j, 0}; }
  else { const int j = job - 3204; t = TJob{p.cv_w2, (bf16_t*)(ws + OFF_CW2) + 64 * 256, nullptr, 256, 64, j, 0}; }
  return t;
}
DI void transpose_pair(const TJob& ta, const TJob& tb, bool has_b, LAS float* tl) {
  const int tid = get_tid();
  f32x4 va[2], vb[2];
#pragma unroll
  for (int i = 0; i < 2; ++i) {
    const int idx = tid + 512 * i, row = idx >> 4, c4 = idx & 15;
    { const int n = ta.nt * 64 + 4 * c4; va[i] = (f32x4){0.f, 0.f, 0.f, 0.f}; if (n < ta.N) va[i] = *(const f32x4*)(ta.src + (size_t)(ta.kt * 64 + row) * ta.N + n); if (ta.g) va[i] = va[i] * ta.g[ta.kt * 64 + row]; }
    vb[i] = (f32x4){0.f, 0.f, 0.f, 0.f};
    if (has_b) { const int n = tb.nt * 64 + 4 * c4; if (n < tb.N) vb[i] = *(const f32x4*)(tb.src + (size_t)(tb.kt * 64 + row) * tb.N + n); if (tb.g) vb[i] = vb[i] * tb.g[tb.kt * 64 + row]; }
  }
#pragma unroll
  for (int i = 0; i < 2; ++i) {
    const int idx = tid + 512 * i, row = idx >> 4, c4 = idx & 15;
#pragma unroll
    for (int e = 0; e < 4; ++e) { tl[row * 65 + 4 * c4 + e] = va[i][e]; tl[4160 + row * 65 + 4 * c4 + e] = vb[i][e]; }
  }
  __syncthreads();
  {
    const int nrow = tid >> 3, kc = tid & 7;
    float e[8];
#pragma unroll
    for (int j = 0; j < 8; ++j) e[j] = tl[(8 * kc + j) * 65 + nrow];
    u32x4 w; w.x = pk2(e[0], e[1]); w.y = pk2(e[2], e[3]); w.z = pk2(e[4], e[5]); w.w = pk2(e[6], e[7]);
    *(u32x4*)(ta.dst + (size_t)(ta.nt * 64 + nrow) * ta.K + ta.kt * 64 + 8 * kc) = w;
    if (has_b) {
#pragma unroll
      for (int j = 0; j < 8; ++j) e[j] = tl[4160 + (8 * kc + j) * 65 + nrow];
      w.x = pk2(e[0], e[1]); w.y = pk2(e[2], e[3]); w.z = pk2(e[4], e[5]); w.w = pk2(e[6], e[7]);
      *(u32x4*)(tb.dst + (size_t)(tb.nt * 64 + nrow) * tb.K + tb.kt * 64 + 8 * kc) = w;
    }
  }
  __syncthreads();
}

DI void p0_prologue(const Params& p, LAS unsigned char* lds) {
  const int tid = get_tid(), lane = tid & 63, wid = tid >> 6, G = gridDim.x, bx = blockIdx.x;
  unsigned char* ws = p.ws;
  {
    bf16_t* xb = (bf16_t*)(ws + OFF_XB); float* rs1 = (float*)(ws + OFF_RS1);
    for (int r0 = (bx * 8 + wid) * 4; r0 < MTOK; r0 += G * 32) {
      f32x4 a[4][2], c[4][2];
#pragma unroll
      for (int rr = 0; rr < 4; ++rr)
#pragma unroll
        for (int i = 0; i < 2; ++i) { const float* s = p.x + (size_t)(r0 + rr) * 1024 + (lane + 64 * i) * 8; a[rr][i] = __builtin_nontemporal_load((const f32x4*)s); c[rr][i] = __builtin_nontemporal_load((const f32x4*)(s + 4)); }
#pragma unroll
      for (int rr = 0; rr < 4; ++rr) {
        float ss = 0.f;
#pragma unroll
        for (int i = 0; i < 2; ++i) {
          const f32x4 av = a[rr][i], bv = c[rr][i];
          ss += (av[0] * av[0] + av[1] * av[1]) + (av[2] * av[2] + av[3] * av[3]) + (bv[0] * bv[0] + bv[1] * bv[1]) + (bv[2] * bv[2] + bv[3] * bv[3]);
          u32x4 w; w.x = pk2(av[0], av[1]); w.y = pk2(av[2], av[3]); w.z = pk2(bv[0], bv[1]); w.w = pk2(bv[2], bv[3]);
          *(u32x4*)(xb + (size_t)(r0 + rr) * 1024 + (lane + 64 * i) * 8) = w;
        }
        ss = wave_sum(ss);
        if (lane == 0) rs1[r0 + rr] = __builtin_amdgcn_rsqf(ss * (1.0f / 1024.0f) + EPSN);
      }
    }
  }
  { float* z = (float*)(ws + OFF_SSQ2); for (int i = bx * 512 + tid; i < 2 * MTOK; i += G * 512) z[i] = 0.f; }
  for (int pair = bx; pair < 256; pair += G) {
    LAS float* red = (LAS float*)lds;
    const int kv = pair >> 7, n = (pair & 127) * 2 + (tid & 1), ksl = tid >> 1;
    const float* pe = kv ? p.cv_pe : p.ck_pe; const float* w1 = kv ? p.cv_w1 : p.ck_w1;
    float s = 0.f;
#pragma unroll
    for (int k = 0; k < 8; ++k) s += pe[ksl * 8 + k] * w1[(size_t)(ksl * 8 + k) * 256 + n];
    s += __shfl_xor(s, 2); s += __shfl_xor(s, 4); s += __shfl_xor(s, 8); s += __shfl_xor(s, 16); s += __shfl_xor(s, 32);
    if (lane < 2) red[wid * 2 + lane] = s;
    __syncthreads();
    if (tid < 2) { float t = 0.f; for (int i = 0; i < 8; ++i) t += red[i * 2 + tid]; ((float*)(ws + OFF_CB1))[kv * 256 + (pair & 127) * 2 + tid] = t; }
    __syncthreads();
  }
  for (int job = bx; job < 3208; job += 2 * G) {
    const bool has_b = (job + G) < 3208;
    const TJob ta = transpose_job(p, job), tb = transpose_job(p, has_b ? job + G : job);
    transpose_pair(ta, tb, has_b, (LAS float*)lds);
  }
}

constexpr int USTR = 1040;
constexpr int YSTR = 516;
constexpr int C_WOFF = 66560;
DI void conv_load_taps(const Params& p, LAS unsigned char* lds) {
  LAS float* Wp = (LAS float*)(lds + C_WOFF);
  for (int idx = get_tid(); idx < 32 * 256; idx += 512) {
    const int w = idx >> 8, cp = idx & 255;
    f32x2 t = (f32x2){0.f, 0.f};
    if (w < 31) t = *(const f32x2*)(p.dw_w + w * 512 + 2 * cp);
    *(LAS f32x2*)(Wp + ((w >> 2) * 256 + cp) * 8 + (w & 3) * 2) = t;
  }
}
DI void conv_tile(const Params& p, LAS unsigned char* lds, int tile) {
  const int tid = get_tid(), lane = tid & 63, wid = tid >> 6;
  const int b = tile >> 7, t0 = (tile & 127) * 32;
  const bf16_t* uv = (const bf16_t*)(p.ws + OFF_B);
  bf16_t* cat = (bf16_t*)(p.ws + OFF_CAT);
  LAS unsigned char* U = lds; LAS float* Y = (LAS float*)lds;
  const LAS float* Wp = (const LAS float*)(lds + C_WOFF);
  {
    u32x4 vv[8], gv[8];
#pragma unroll
    for (int it = 0; it < 8; ++it) {
      const int idx = tid + 512 * it, row = idx >> 6, ch = idx & 63, t = t0 - 30 + row;
      const int tc = t < 0 ? 0 : (row < 62 ? t : t0);
      const size_t m = (size_t)b * 4096 + tc;
      vv[it] = *(const u32x4*)(uv + m * 1024 + ch * 8); gv[it] = *(const u32x4*)(uv + m * 1024 + 512 + ch * 8);
    }
#pragma unroll
    for (int it = 0; it < 8; ++it) {
      const int idx = tid + 512 * it, row = idx >> 6, ch = idx & 63, t = t0 - 30 + row;
      u32x4 w = (u32x4){0u, 0u, 0u, 0u};
      if (t >= 0 && row < 62) {
#pragma unroll
        for (int j = 0; j < 4; ++j) {
          const float v0 = __uint_as_float(vv[it][j] << 16), v1 = __uint_as_float(vv[it][j] & 0xffff0000u), g0 = __uint_as_float(gv[it][j] << 16), g1 = __uint_as_float(gv[it][j] & 0xffff0000u);
          w[j] = pk2(v0 * sigmoidf_(g0), v1 * sigmoidf_(g1));
        }
      }
      if (row < 63) *(LAS u32x4*)(U + row * USTR + ch * 16) = w;
    }
  }
  __syncthreads();
  const int half = tid >> 8, cp = tid & 255;
  float a0[16], a1[16];
  {
    const f32x2 bias = *(const f32x2*)(p.dw_b + 2 * cp);
#pragma unroll
    for (int o = 0; o < 16; ++o) { a0[o] = bias.x; a1[o] = bias.y; }
#pragma unroll
    for (int og = 0; og < 2; ++og) {
      const LAS unsigned char* ub = U + (half * 16 + og * 8) * USTR + cp * 4;
#pragma unroll 1
      for (int w4 = 0; w4 < 8; ++w4) {
        const f32x4 wa = *(const LAS f32x4*)(Wp + (w4 * 256 + cp) * 8), wb = *(const LAS f32x4*)(Wp + (w4 * 256 + cp) * 8 + 4);
        const float wt0[4] = {wa[0], wa[2], wb[0], wb[2]}, wt1[4] = {wa[1], wa[3], wb[1], wb[3]};
        float u0[11], u1[11];
#pragma unroll
        for (int r = 0; r < 11; ++r) { const unsigned uu = *(const LAS unsigned*)(ub + (w4 * 4 + r) * USTR); u0[r] = __uint_as_float(uu << 16); u1[r] = __uint_as_float(uu & 0xffff0000u); }
#pragma unroll
        for (int o = 0; o < 8; ++o)
#pragma unroll
          for (int k = 0; k < 4; ++k) { a0[og * 8 + o] += u0[o + k] * wt0[k]; a1[og * 8 + o] += u1[o + k] * wt1[k]; }
      }
    }
  }
  __syncthreads();
#pragma unroll
  for (int o = 0; o < 16; ++o) *(LAS f32x2*)(Y + (half * 16 + o) * YSTR + 2 * cp) = (f32x2){a0[o], a1[o]};
  __syncthreads();
  {
    const f32x4 g0 = *(const f32x4*)(p.cln_g + lane * 8), g1 = *(const f32x4*)(p.cln_g + lane * 8 + 4), b0 = *(const f32x4*)(p.cln_b + lane * 8), b1 = *(const f32x4*)(p.cln_b + lane * 8 + 4);
#pragma unroll
    for (int i = 0; i < 4; ++i) {
      const int tok = wid * 4 + i;
      const f32x4 y0 = *(const LAS f32x4*)(Y + tok * YSTR + lane * 8), y1 = *(const LAS f32x4*)(Y + tok * YSTR + lane * 8 + 4);
      float s = (y0[0] + y0[1]) + (y0[2] + y0[3]) + (y1[0] + y1[1]) + (y1[2] + y1[3]);
      s = wave_sum(s);
      const float mu = s * (1.0f / 512.0f);
      const f32x4 d0 = y0 - mu, d1 = y1 - mu;
      float q = (d0[0] * d0[0] + d0[1] * d0[1]) + (d0[2] * d0[2] + d0[3] * d0[3]) + (d1[0] * d1[0] + d1[1] * d1[1]) + (d1[2] * d1[2] + d1[3] * d1[3]);
      q = wave_sum(q);
      const float rstd = __builtin_amdgcn_rsqf(q * (1.0f / 512.0f) + EPSN);
      f32x4 o0 = d0 * rstd * g0 + b0, o1 = d1 * rstd * g1 + b1;
#pragma unroll
      for (int j = 0; j < 4; ++j) { o0[j] = o0[j] * sigmoidf_(o0[j]); o1[j] = o1[j] * sigmoidf_(o1[j]); }
      u32x4 w; w.x = pk2(o0[0], o0[1]); w.y = pk2(o0[2], o0[3]); w.z = pk2(o1[0], o1[1]); w.w = pk2(o1[2], o1[3]);
      *(u32x4*)(cat + ((size_t)b * 4096 + t0 + tok) * 1024 + lane * 8) = w;
    }
  }
  __syncthreads();
}

constexpr int KVSTR = 144;
constexpr int VSTR = 144;
constexpr int A_GRP = 4 * 64 * KVSTR;
constexpr int A_KOFF = 0, A_VOFF = 2 * 64 * KVSTR;
constexpr int A_SLAB = 2 * A_GRP;
constexpr int SLAB_FLOATS = 32 * 65;
constexpr int A_SEL = A_SLAB + 8 * SLAB_FLOATS * 4;
constexpr int A_OR = A_SEL + 512;
constexpr int A_CNT = A_OR + 16;
constexpr int A_NXT = A_CNT + 32;
constexpr int A_LINV = A_NXT + 32;
static_assert(A_LINV + 1024 <= LDS_BYTES - 16, "attention LDS map");

DI void group_sync(LAS unsigned* cnt, unsigned& tgt, int lane) {
  tgt += 4u;
  __builtin_amdgcn_fence(__ATOMIC_RELEASE, "workgroup");
  if (lane == 0) __hip_atomic_fetch_add(cnt, 1u, __ATOMIC_RELAXED, __HIP_MEMORY_SCOPE_WORKGROUP);
  while ((int)(__hip_atomic_load(cnt, __ATOMIC_RELAXED, __HIP_MEMORY_SCOPE_WORKGROUP) - tgt) < 0) __builtin_amdgcn_s_sleep(0);
  __builtin_amdgcn_fence(__ATOMIC_ACQUIRE, "workgroup");
}

constexpr float ATT_THR = 8.0f;
template <int KIND, bool MASKED>
DI void attn_scores(LAS unsigned char* kbuf, int jc, const bf16x8 (&qf)[4], float slope2, float sc, int tq, int jt, unsigned long long mymask, float mref, f32x16 (&S)[2], int q, int h) {
  float base2; int kmin = -1, kmax = 64;
  if (KIND <= 1) {
    const int lim = 64 * jt + tq - 31 - 1024 * jc - 64 * h;
    base2 = -slope2 * (float)lim - mref; kmax = lim >> 4;
  } else {
    base2 = slope2 * (float)(64 * (jc - jt) + 4 * h - tq) - mref;
    if (MASKED && jc == jt) kmax = tq - 4 * h;
    if (MASKED && KIND == 3 && jc == jt - 8) kmin = tq - 4 * h;
    if (KIND == 2) base2 = ((mymask >> jc) & 1ull) ? base2 : -1e30f;
  }
#pragma unroll
  for (int kb = 0; kb < 2; ++kb) {
#pragma unroll
    for (int i = 0; i < 16; ++i) S[kb][i] = __builtin_fmaf(sc, (float)(32 * kb + 8 * (i >> 2) + (i & 3)), base2);
#pragma unroll
    for (int ks = 0; ks < 4; ++ks) {
      const bf16x8 kf = *(const LAS bf16x8*)(kbuf + (32 * kb + q) * KVSTR + 32 * ks + 16 * h);
      S[kb] = __builtin_amdgcn_mfma_f32_32x32x16_bf16(kf, qf[ks], S[kb], 0, 0, 0);
    }
  }
  if (MASKED) {
    const unsigned range = (unsigned)(kmax - kmin);
#pragma unroll
    for (int kb = 0; kb < 2; ++kb)
#pragma unroll
      for (int i = 0; i < 16; ++i) {
        const int keyc = 32 * kb + 8 * (i >> 2) + (i & 3);
        const bool ok = (kmax > kmin) && ((unsigned)(keyc - kmin - 1) < range);
        S[kb][i] = ok ? S[kb][i] : -INFINITY;
      }
  }
}
DI float attn_exp_sum(f32x16 (&S)[2]) {
  float ps = 0.f;
#pragma unroll
  for (int kb = 0; kb < 2; ++kb)
#pragma unroll
    for (int i = 0; i < 16; ++i) { const float pv = __builtin_amdgcn_exp2f(S[kb][i]); S[kb][i] = pv; ps += pv; asm volatile("" : "+v"(ps)); }
  return ps;
}
constexpr float ATT_SUM_CAP = 16777216.0f;
template <int KIND, bool MASKED>
DI void attn_tile(LAS unsigned char* kbuf, LAS unsigned char* vbuf, int jc, const bf16x8 (&qf)[4], float slope2, float sc, int tq, int jt, unsigned long long mymask,
                  float& m_run, float& l_run, float l2inv, f32x16 (&O)[2], LAS float* slab, int q, int h, int q4, int p4, int g1) {
  f32x16 S[2];
  attn_scores<KIND, MASKED>(kbuf, jc, qf, slope2, sc, tq, jt, mymask, m_run, S, q, h);
  {
    float ps = attn_exp_sum(S);
    if (__any(!(ps < ATT_SUM_CAP))) {
      asm volatile("s_nop 0" ::: "memory");
      attn_scores<KIND, MASKED>(kbuf, jc, qf, slope2, sc, tq, jt, mymask, m_run, S, q, h);
      float mx = fmaxf(S[0][0], S[1][0]);
#pragma unroll
      for (int i = 1; i < 16; ++i) mx = fmaxf(fmaxf(mx, S[0][i]), S[1][i]);
      mx = fmaxf(mx, __shfl_xor(mx, 32));
      const float d = fmaxf(mx, 0.f), alpha = __builtin_amdgcn_exp2f(-d);
      m_run += d; l_run *= alpha;
#pragma unroll
      for (int kb = 0; kb < 2; ++kb)
#pragma unroll
        for (int i = 0; i < 16; ++i) S[kb][i] -= d;
      if (KIND != 0) {
#pragma unroll
        for (int db = 0; db < 2; ++db)
#pragma unroll
          for (int i = 0; i < 16; ++i) O[db][i] *= alpha;
      }
      if (KIND == 1) { for (int jj = h; jj < 65; jj += 2) slab[q * 65 + jj] *= alpha; }
      ps = attn_exp_sum(S);
    }
    l_run += ps;
  }
  if (KIND == 1) {
    float s4[8], rx[8];
#pragma unroll
    for (int kb = 0; kb < 2; ++kb)
#pragma unroll
      for (int gi = 0; gi < 4; ++gi) {
        float t4 = S[kb][4 * gi] + S[kb][4 * gi + 1]; asm volatile("" : "+v"(t4)); t4 += S[kb][4 * gi + 2]; asm volatile("" : "+v"(t4)); t4 += S[kb][4 * gi + 3];
        s4[4 * kb + gi] = t4; rx[4 * kb + gi] = __shfl_xor(S[kb][4 * gi + 3], 32);
      }
    LAS float* rowp = slab + q * 65 + 16 * jc + h;
    float old[9], val[9];
#pragma unroll
    for (int m = 0; m < 9; ++m) {
      const float own = (m < 8) ? s4[m < 8 ? m : 7] : 0.f;
      const float a1 = (m < 8) ? rx[m < 8 ? m : 7] : 0.f;
      const float a0 = (m > 0) ? rx[m > 0 ? m - 1 : 0] : 0.f;
      val[m] = own + (h ? a1 : a0);
    }
#pragma unroll
    for (int m = 0; m < 9; ++m) old[m] = (m < 8 || h == 0) ? rowp[2 * m] : 0.f;
#pragma unroll
    for (int m = 0; m < 9; ++m) if (m < 8 || h == 0) rowp[2 * m] = old[m] + val[m];
  }
  if (KIND != 0) {
#pragma unroll
    for (int kb = 0; kb < 2; ++kb)
#pragma unroll
      for (int s = 0; s < 2; ++s) {
        u32x4 pw;
        pw.x = pk2(S[kb][8 * s + 0], S[kb][8 * s + 1]); pw.y = pk2(S[kb][8 * s + 2], S[kb][8 * s + 3]);
        pw.z = pk2(S[kb][8 * s + 4], S[kb][8 * s + 5]); pw.w = pk2(S[kb][8 * s + 6], S[kb][8 * s + 7]);
        const bf16x8 pf = __builtin_bit_cast(bf16x8, pw);
#pragma unroll
        for (int db = 0; db < 2; ++db) {
          LAS unsigned char* va = vbuf + (32 * kb + 16 * s + 4 * h + q4) * VSTR + (32 * db + 16 * g1) * 2 + 8 * p4;
          const s16x4 lo = __builtin_amdgcn_ds_read_tr16_b64_v4i16((LAS s16x4*)va);
          const s16x4 hi = __builtin_amdgcn_ds_read_tr16_b64_v4i16((LAS s16x4*)(va + 8 * VSTR));
          const bf16x8 vf = __builtin_shufflevector(lo, hi, 0, 1, 2, 3, 4, 5, 6, 7);
          O[db] = __builtin_amdgcn_mfma_f32_32x32x16_bf16(vf, pf, O[db], 0, 0, 0);
        }
      }
  }
}

template <int KIND>
DI void attn_branch(LAS unsigned char* gl, LAS unsigned* cnt, unsigned& tgt, const bf16_t* Kg, const bf16_t* Vg, unsigned long long tmask, const bf16x8 (&qf)[4], float slope2, int tq, int jt,
                    unsigned long long mymask, float& m_run, float& l_run, float invl, f32x16 (&O)[2], LAS float* slab) {
  const int gt = get_tid() & 255, lane = gt & 63, q = lane & 31, h = lane >> 5;
  const int i16 = lane & 15, q4 = i16 >> 2, p4 = i16 & 3, g1 = (lane >> 4) & 1;
  const float sc = (KIND <= 1) ? slope2 * 16.0f : slope2;
  const int woff = (gt >> 3) * KVSTR + (gt & 7) * 16;
  int j = __builtin_ctzll(tmask); tmask &= tmask - 1;
  const u32x4 z4 = (u32x4){0u, 0u, 0u, 0u};
  u32x4 ka = *(const u32x4*)(Kg + (size_t)j * 4096 + gt * 8), kb = *(const u32x4*)(Kg + (size_t)j * 4096 + 2048 + gt * 8), va = z4, vb = z4;
  if (KIND != 0) { va = *(const u32x4*)(Vg + (size_t)j * 4096 + gt * 8); vb = *(const u32x4*)(Vg + (size_t)j * 4096 + 2048 + gt * 8); }
  int buf = 0;
  for (;;) {
    LAS unsigned char* kbuf = gl + A_KOFF + buf * (64 * KVSTR); LAS unsigned char* vbuf = gl + A_VOFF + buf * (64 * VSTR);
    *(LAS u32x4*)(kbuf + woff) = ka; *(LAS u32x4*)(kbuf + 32 * KVSTR + woff) = kb;
    if (KIND != 0) { *(LAS u32x4*)(vbuf + woff) = va; *(LAS u32x4*)(vbuf + 32 * VSTR + woff) = vb; }
    group_sync(cnt, tgt, lane);
    const int jc = j;
    const bool more = (tmask != 0ull);
    if (more) {
      j = __builtin_ctzll(tmask); tmask &= tmask - 1;
      ka = *(const u32x4*)(Kg + (size_t)j * 4096 + gt * 8); kb = *(const u32x4*)(Kg + (size_t)j * 4096 + 2048 + gt * 8);
      if (KIND != 0) { va = *(const u32x4*)(Vg + (size_t)j * 4096 + gt * 8); vb = *(const u32x4*)(Vg + (size_t)j * 4096 + 2048 + gt * 8); }
    }
    if (KIND <= 1 || jc == jt || (KIND == 3 && jc == jt - 8)) attn_tile<KIND, true>(kbuf, vbuf, jc, qf, slope2, sc, tq, jt, mymask, m_run, l_run, invl, O, slab, q, h, q4, p4, g1);
    else attn_tile<KIND, (KIND <= 1)>(kbuf, vbuf, jc, qf, slope2, sc, tq, jt, mymask, m_run, l_run, invl, O, slab, q, h, q4, p4, g1);
    buf ^= 1;
    if (!more) break;
  }
  group_sync(cnt, tgt, lane);
}

DI int queue_pop(unsigned* qbase, unsigned xcc) {
  for (unsigned qq = 0; qq < 8u; ++qq) {
    const unsigned x2 = (xcc + qq) & 7u;
    const unsigned i = __hip_atomic_fetch_add(qbase + 64 * x2, 1u, __ATOMIC_RELAXED, __HIP_MEMORY_SCOPE_AGENT);
    if (i < 256u) return (int)(x2 * 256u + i);
  }
  return -1;
}
DI void attn_item(const Params& p, LAS unsigned char* lds, int grp, unsigned& tgt, int enc, int& nenc, unsigned xcc) {
  const int gt = get_tid() & 255, lane = gt & 63, hh = __builtin_amdgcn_readfirstlane(gt >> 6), q = lane & 31, h = lane >> 5;
  const int bg = 2 * (enc >> 8) + (enc & 1), jt32 = 127 - ((enc & 255) >> 1);
  int popv = -1;
  if (gt == 0) popv = queue_pop((unsigned*)(p.ws + OFF_QCNT), xcc);
  const int b = bg >> 1, g = bg & 1, head = g * 4 + hh, jt = jt32 >> 1, tq = (jt32 & 1) * 32 + q, t = jt * 64 + tq;
  const size_t mrow = (size_t)b * 4096 + t;
  const bf16_t* Qp = (const bf16_t*)(p.ws + OFF_Q);
  const bf16_t* KV = (const bf16_t*)(p.ws + OFF_KV);
  const float* gates = (const float*)(p.ws + OFF_GATES);
  bf16_t* cat = (bf16_t*)(p.ws + OFF_CAT);
  float* osc = (float*)(p.ws + OFF_B) + mrow * 512 + head * 64 + 4 * h;
  LAS unsigned char* gl = lds + grp * A_GRP;
  LAS float* slab = (LAS float*)(lds + A_SLAB) + (grp * 4 + hh) * SLAB_FLOATS;
  LAS unsigned long long* selm = (LAS unsigned long long*)(lds + A_SEL) + grp * 32;
  LAS unsigned long long* orm = (LAS unsigned long long*)(lds + A_OR) + grp;
  LAS unsigned* cnt = (LAS unsigned*)(lds + A_CNT + 16 * grp);
  for (int i = lane; i < SLAB_FLOATS; i += 64) slab[i] = 0.f;
  if (gt == 0) *orm = 0ull;
  bf16x8 qf[4];
#pragma unroll
  for (int ks = 0; ks < 4; ++ks) qf[ks] = *(const bf16x8*)(Qp + mrow * 512 + head * 64 + 16 * ks + 8 * h);
  const float slope2 = __builtin_amdgcn_exp2f(-(float)(head + 1)) * LOG2E;
  const float g_cmp = gates[mrow * 24 + head * 3 + 0], g_sel = gates[mrow * 24 + head * 3 + 1], g_win = gates[mrow * 24 + head * 3 + 2];
  const size_t bgoff = (size_t)bg * 4096 * 64;
  const bf16_t* Ksel = KV + (size_t)2 * 16 * 4096 * 64 + bgoff; const bf16_t* Vsel = KV + (size_t)3 * 16 * 4096 * 64 + bgoff;
  const bf16_t* Kwin = KV + (size_t)4 * 16 * 4096 * 64 + bgoff; const bf16_t* Vwin = KV + (size_t)5 * 16 * 4096 * 64 + bgoff;
  const bf16_t* Kc = (const bf16_t*)(p.ws + OFF_KC) + (size_t)bg * 256 * 64; const bf16_t* Vc = (const bf16_t*)(p.ws + OFF_VC) + (size_t)bg * 256 * 64;
  f32x16 O[2];
#pragma unroll
  for (int db = 0; db < 2; ++db)
#pragma unroll
    for (int i = 0; i < 16; ++i) O[db][i] = 0.f;
  {
    const int ncmp = 4 * jt + 2 * (jt32 & 1) + 1, ntile = (ncmp + 63) >> 6;
    const unsigned long long cm = (1ull << ntile) - 1ull;
    float m_run = 0.f, l_run = 0.f;
    attn_branch<1>(gl, cnt, tgt, Kc, Vc, cm, qf, slope2, tq, jt, 0ull, m_run, l_run, 0.f, O, slab);
    const float lt = l_run + __shfl_xor(l_run, 32);
    const float invl = lt > 0.f ? __builtin_amdgcn_rcpf(lt) : 0.f;
    if (h == 0) ((LAS float*)(lds + A_LINV))[(grp * 4 + hh) * 32 + q] = invl;
    const float gsc = g_cmp * invl;
#pragma unroll
    for (int db = 0; db < 2; ++db)
#pragma unroll
      for (int gi = 0; gi < 4; ++gi) {
        *(f32x4*)(osc + 32 * db + 8 * gi) = (f32x4){O[db][4 * gi], O[db][4 * gi + 1], O[db][4 * gi + 2], O[db][4 * gi + 3]} * gsc;
        O[db][4 * gi] = 0.f; O[db][4 * gi + 1] = 0.f; O[db][4 * gi + 2] = 0.f; O[db][4 * gi + 3] = 0.f;
      }
  }
  group_sync(cnt, tgt, lane);
  {
    const LAS float* slabs = (const LAS float*)(lds + A_SLAB) + grp * 4 * SLAB_FLOATS;
    unsigned long long worm = 0ull;
    unsigned key[8], prefix[8];
#pragma unroll
    for (int tt = 0; tt < 8; ++tt) {
      const int tok = hh * 8 + tt;
      float v = 0.f;
#pragma unroll
      for (int h2 = 0; h2 < 4; ++h2) v += slabs[h2 * SLAB_FLOATS + tok * 65 + lane] * ((const LAS float*)(lds + A_LINV))[(grp * 4 + h2) * 32 + tok];
      if (lane == 0 || lane == jt || lane == jt - 1) v = 1e30f; else if (lane > jt) v = -1e30f;
      unsigned k = __float_as_uint(v); k = (k & 0x80000000u) ? ~k : (k | 0x80000000u);
      key[tt] = k; prefix[tt] = 0u;
    }
#pragma unroll
    for (int bit = 31; bit >= 0; --bit)
#pragma unroll
      for (int tt = 0; tt < 8; ++tt) {
        const unsigned cand = prefix[tt] | (1u << bit);
        const unsigned long long mge = __ballot(key[tt] >= cand);
        prefix[tt] = (__popcll(mge) >= 16) ? cand : prefix[tt];
      }
#pragma unroll
    for (int tt = 0; tt < 8; ++tt) {
      const unsigned long long mgt = __ballot(key[tt] > prefix[tt]), meq = __ballot(key[tt] == prefix[tt]);
      const int need = 16 - __popcll(mgt);
      const int rank_eq = __popcll(meq & ((1ull << lane) - 1ull));
      const unsigned long long msk = mgt | __ballot((key[tt] == prefix[tt]) && (rank_eq < need));
      if (lane == 0) selm[hh * 8 + tt] = msk;
      worm |= msk;
    }
    if (lane == 0) atomicOr((unsigned long long*)orm, worm);
  }
  if (gt == 0) *(LAS int*)(lds + A_NXT + 16 * grp) = popv;
  group_sync(cnt, tgt, lane);
  nenc = *(const LAS int*)(lds + A_NXT + 16 * grp);
  const unsigned long long mymask = selm[q];
  const unsigned long long ormask = *orm;
  const unsigned long long causal = (jt >= 63) ? ~0ull : ((2ull << jt) - 1ull);
  const int jlo = jt >= 8 ? jt - 8 : 0;
  {
    float m_run = 0.f, l_run = 0.f;
    attn_branch<2>(gl, cnt, tgt, Ksel, Vsel, ormask & causal, qf, slope2, tq, jt, mymask, m_run, l_run, 0.f, O, slab);
    const float lt = l_run + __shfl_xor(l_run, 32);
    const float sc = lt > 0.f ? g_sel / lt : 0.f;
#pragma unroll
    for (int db = 0; db < 2; ++db)
#pragma unroll
      for (int gi = 0; gi < 4; ++gi) {
        const f32x4 pv = *(const f32x4*)(osc + 32 * db + 8 * gi);
        *(f32x4*)(osc + 32 * db + 8 * gi) = pv + (f32x4){O[db][4 * gi], O[db][4 * gi + 1], O[db][4 * gi + 2], O[db][4 * gi + 3]} * sc;
        O[db][4 * gi] = 0.f; O[db][4 * gi + 1] = 0.f; O[db][4 * gi + 2] = 0.f; O[db][4 * gi + 3] = 0.f;
      }
  }
  {
    const unsigned long long wm = causal & ~((1ull << jlo) - 1ull);
    float m_run = 0.f, l_run = 0.f;
    attn_branch<3>(gl, cnt, tgt, Kwin, Vwin, wm, qf, slope2, tq, jt, 0ull, m_run, l_run, 0.f, O, slab);
    const float lt = l_run + __shfl_xor(l_run, 32);
    const float sc = lt > 0.f ? g_win / lt : 0.f;
#pragma unroll
    for (int db = 0; db < 2; ++db)
#pragma unroll
      for (int gi = 0; gi < 4; ++gi) {
        const f32x4 v = *(const f32x4*)(osc + 32 * db + 8 * gi) + (f32x4){O[db][4 * gi], O[db][4 * gi + 1], O[db][4 * gi + 2], O[db][4 * gi + 3]} * sc;
        u32x2 w; w.x = pk2(v[0], v[1]); w.y = pk2(v[2], v[3]);
        *(u32x2*)(cat + mrow * 1024 + 512 + head * 64 + 32 * db + 8 * gi + 4 * h) = w;
      }
  }
}

__global__ void __launch_bounds__(512, 2) fwd_megakernel(Params p) {
  extern __shared__ __attribute__((aligned(16))) unsigned char smem[];
  LAS unsigned char* lds = (LAS unsigned char*)smem;
  cg::grid_group grid = cg::this_grid();
  const int G = gridDim.x, bx = blockIdx.x;
  unsigned char* ws = p.ws;
  if (p.ws == nullptr) grid.sync();
  volatile LAS unsigned* bst = (volatile LAS unsigned*)(lds + LDS_BYTES - 16);
  if (threadIdx.x == 0) { bst[0] = 0u; bst[1] = 0u; }
  __syncthreads();
  const XcdBarrier gbar = xcd_barrier_post((unsigned*)(ws + OFF_BAR), bst);

  p0_prologue(p, lds);
  xcd_barrier(gbar);

  {
    pg8::Gemm g{(const bf16_t*)(ws + OFF_XB), (const bf16_t*)(ws + OFF_WIN), 1024, 1024, 1024, (size_t)256 * 1024 * 2, (size_t)256 * 1024 * 2};
    pg8::StaticOrder S; S.init(MTOK, 2560, G, bx);
    Epi1 E{(const float*)(ws + OFF_RS1), (bf16_t*)(ws + OFF_B), (bf16_t*)(ws + OFF_Q), (bf16_t*)(ws + OFF_KV), (float*)(ws + OFF_GATES)};
    pg8::gemm_phase<Epi1, pg8::StaticOrder, true, true>(lds, g, S, E);
  }
  xcd_barrier(gbar);

  {
    const int ncmp = (G > 64) ? 32 : 0;
    if (bx < ncmp) {
      const int kv = bx >> 4, pm = bx & 15;
      pg8::Gemm g{(const bf16_t*)(ws + OFF_KV) + (size_t)kv * 16 * 4096 * 64, (const bf16_t*)(ws + OFF_CW1) + (size_t)kv * 256 * 2048, 1024, 2048, 2048, (size_t)4096 * 64 * 2, 0};
      pg8::SingleUnit S{pm, 0};
      EpiCmp E{(const float*)(ws + OFF_CB1) + kv * 256, (const bf16_t*)(ws + OFF_CW2) + kv * 64 * 256, (bf16_t*)(ws + (kv ? OFF_VC : OFF_KC))};
      pg8::gemm_phase<EpiCmp, pg8::SingleUnit, false, true>(lds, g, S, E);
    } else {
      conv_load_taps(p, lds);
      for (int tile = bx - ncmp; tile < 1024; tile += G - ncmp) conv_tile(p, lds, tile);
    }
    if (ncmp == 0) {
      for (int un = bx; un < 32; un += G) {
        const int kv = un >> 4, pm = un & 15;
        pg8::Gemm g{(const bf16_t*)(ws + OFF_KV) + (size_t)kv * 16 * 4096 * 64, (const bf16_t*)(ws + OFF_CW1) + (size_t)kv * 256 * 2048, 1024, 2048, 2048, (size_t)4096 * 64 * 2, 0};
        pg8::SingleUnit S{pm, 0};
        EpiCmp E{(const float*)(ws + OFF_CB1) + kv * 256, (const bf16_t*)(ws + OFF_CW2) + kv * 64 * 256, (bf16_t*)(ws + (kv ? OFF_VC : OFF_KC))};
        pg8::gemm_phase<EpiCmp, pg8::SingleUnit, false, true>(lds, g, S, E);
      }
    }
  }
  xcd_barrier(gbar);

  {
    const int tid3 = get_tid(), grp = __builtin_amdgcn_readfirstlane(tid3 >> 8);
    if (tid3 < 2) *(LAS unsigned*)(lds + A_CNT + 16 * tid3) = 0u;
    __syncthreads();
    unsigned tgt = 0u;
    const int gt3 = tid3 & 255, lane3 = tid3 & 63;
    const unsigned xcc = xb_xcc_id();
    LAS unsigned* cnt3 = (LAS unsigned*)(lds + A_CNT + 16 * grp);
    if (gt3 == 0) *(LAS int*)(lds + A_NXT + 16 * grp) = queue_pop((unsigned*)(ws + OFF_QCNT), xcc);
    group_sync(cnt3, tgt, lane3);
    int enc = *(const LAS int*)(lds + A_NXT + 16 * grp);
    group_sync(cnt3, tgt, lane3);
    while (enc >= 0) { int nenc = -1; attn_item(p, lds, grp, tgt, enc, nenc, xcc); enc = nenc; }
  }
  xcd_barrier(gbar);

  {
    pg8::Gemm g{(const bf16_t*)(ws + OFF_CAT), (const bf16_t*)(ws + OFF_WOUT), 1024, 1024, 1024, (size_t)256 * 1024 * 2, (size_t)256 * 1024 * 2};
    pg8::StaticOrder S; S.init(MTOK, 1024, G, bx);
    EpiRes<false, true> E{(const bf16_t*)(ws + OFF_XB), p.out, (bf16_t*)(ws + OFF_B), (float*)(ws + OFF_SSQ2)};
    pg8::gemm_phase<EpiRes<false, true>, pg8::StaticOrder, true, true>(lds, g, S, E);
  }
  xcd_barrier(gbar);

  {
    pg8::Gemm g{(const bf16_t*)(ws + OFF_B), (const bf16_t*)(ws + OFF_WFF1), 1024, 1024, 1024, (size_t)256 * 1024 * 2, (size_t)256 * 1024 * 2};
    pg8::StaticOrder S; S.init(MTOK, 4096, G, bx);
    EpiFF1 E{(const float*)(ws + OFF_SSQ2), (bf16_t*)(ws + OFF_H)};
    pg8::gemm_phase<EpiFF1, pg8::StaticOrder, false, true>(lds, g, S, E);
  }
  xcd_barrier(gbar);

  const int fuse_final = (G == 256) ? 1 : 0;
  {
    pg8::Gemm g{(const bf16_t*)(ws + OFF_H), (const bf16_t*)(ws + OFF_WFF2), 4096, 4096, 4096, (size_t)256 * 4096 * 2, (size_t)256 * 4096 * 2};
    pg8::StaticOrder S; S.init(MTOK, 1024, G, bx);
    EpiFinal E{(const bf16_t*)(ws + OFF_B), p.out, (float*)(ws + OFF_SSQ3), (unsigned*)(ws + OFF_PCNT), p.norm_f_g, fuse_final};
    pg8::gemm_phase<EpiFinal, pg8::StaticOrder, true, true>(lds, g, S, E);
  }
  if (!fuse_final) {
    xcd_barrier(gbar);
    const int tid = get_tid(), lane = tid & 63, wid = tid >> 6;
    const float* ssq = (const float*)(ws + OFF_SSQ3);
    f32x4 gn[4];
#pragma unroll
    for (int i = 0; i < 4; ++i) gn[i] = *(const f32x4*)(p.norm_f_g + (lane + 64 * i) * 4);
    for (int r = bx * 8 + wid; r < MTOK; r += G * 8) {
      const float s = __builtin_amdgcn_rsqf(ssq[r] * (1.0f / 1024.0f) + EPSN);
      float* row = p.out + (size_t)r * 1024;
#pragma unroll
      for (int i = 0; i < 4; ++i) { f32x4 v = *(const f32x4*)(row + (lane + 64 * i) * 4); v = v * s * gn[i]; *(f32x4*)(row + (lane + 64 * i) * 4) = v; }
    }
  }
}

extern "C" void kernel_launch(void* const* d_in, const int* in_sizes, int n_in, void* d_out, int out_size, void* d_ws, size_t ws_size, hipStream_t stream) {
  constexpr size_t kDynLds = LDS_BYTES;
  static int grid_blocks = 0;
  if (!grid_blocks) {
    int dev = 0, cus = 0, per_cu = 0;
    (void)hipGetDevice(&dev);
    (void)hipDeviceGetAttribute(&cus, hipDeviceAttributeMultiprocessorCount, dev);
    (void)hipFuncSetAttribute((const void*)fwd_megakernel, hipFuncAttributeMaxDynamicSharedMemorySize, (int)kDynLds);
    (void)hipOccupancyMaxActiveBlocksPerMultiprocessor(&per_cu, (const void*)fwd_megakernel, 512, kDynLds);
    if (per_cu < 1) fprintf(stderr, "kernel_launch: occupancy query says %d blocks per CU\n", per_cu);
    grid_blocks = cus > 0 ? cus : 256;
    if (ws_size < WS_END) fprintf(stderr, "kernel_launch: workspace too small: %zu < %zu\n", ws_size, (size_t)WS_END);
  }
  (void)hipMemsetAsync((unsigned char*)d_ws + OFF_BAR, 0, XCD_BAR_WORDS * 4 + 256 * 256 + 8 * 256, stream);
  Params p{};
  p.x = (const float*)d_in[0]; p.norm1_g = (const float*)d_in[1]; p.w_in = (const float*)d_in[2]; p.dw_w = (const float*)d_in[3]; p.dw_b = (const float*)d_in[4];
  p.cln_g = (const float*)d_in[5]; p.cln_b = (const float*)d_in[6]; p.ck_pe = (const float*)d_in[7]; p.ck_w1 = (const float*)d_in[8]; p.ck_w2 = (const float*)d_in[9];
  p.cv_pe = (const float*)d_in[10]; p.cv_w1 = (const float*)d_in[11]; p.cv_w2 = (const float*)d_in[12]; p.w_out = (const float*)d_in[13]; p.norm2_g = (const float*)d_in[14];
  p.w_ff1 = (const float*)d_in[15]; p.w_ff2 = (const float*)d_in[16]; p.norm_f_g = (const float*)d_in[17];
  p.out = (float*)d_out; p.ws = (unsigned char*)d_ws;
  void* args[] = {&p};
  hipError_t e = hipLaunchCooperativeKernel((const void*)fwd_megakernel, dim3(grid_blocks), dim3(512), args, kDynLds, stream);
  if (e != hipSuccess) fprintf(stderr, "cooperative launch failed: %s (grid %d)\n", hipGetErrorString(e), grid_blocks);
}
```

```cpp
#include <hip/hip_runtime.h>
#include <hip/hip_cooperative_groups.h>
#include <cstdio>
namespace cg = cooperative_groups;

#define LAS __attribute__((address_space(3)))
#define DI __device__ __forceinline__
typedef unsigned short bf16_t;
typedef short bf16x8 __attribute__((ext_vector_type(8)));
typedef short s16x4 __attribute__((ext_vector_type(4)));
typedef float f32x4 __attribute__((ext_vector_type(4)));
typedef float f32x2 __attribute__((ext_vector_type(2)));
typedef float f32x16 __attribute__((ext_vector_type(16)));
typedef unsigned u32x4 __attribute__((ext_vector_type(4)));
typedef unsigned u32x2 __attribute__((ext_vector_type(2)));
typedef __bf16 bf16v2 __attribute__((ext_vector_type(2)));

constexpr float LOG2E = 1.4426950408889634f;
constexpr float EPSN = 1e-6f;
constexpr int LDS_BYTES = 147456;
constexpr int MTOK = 32768, TSEQ = 4096, DM = 1024, DFF = 4096;
constexpr float QSCALE = 0.125f * LOG2E;

constexpr size_t MiB = 1024 * 1024;
constexpr size_t XCD_BAR_WORDS_C = 3456;
constexpr size_t OFF_WIN = 0;
constexpr size_t OFF_WOUT = OFF_WIN + 2560 * 1024 * 2;
constexpr size_t OFF_WFF1 = OFF_WOUT + 1024 * 1024 * 2;
constexpr size_t OFF_WFF2 = OFF_WFF1 + 4096 * 1024 * 2;
constexpr size_t OFF_CW1 = OFF_WFF2 + 4096 * 1024 * 2;
constexpr size_t OFF_CW2 = OFF_CW1 + 2 * 256 * 2048 * 2;
constexpr size_t OFF_CB1 = OFF_CW2 + 2 * 64 * 256 * 2;
constexpr size_t OFF_RS1 = OFF_CB1 + 2 * 256 * 4;
constexpr size_t OFF_SSQ2 = OFF_RS1 + MTOK * 4;
constexpr size_t OFF_SSQ3 = OFF_SSQ2 + MTOK * 4;
constexpr size_t OFF_GATES = OFF_SSQ3 + MTOK * 4;
constexpr size_t OFF_KC = OFF_GATES + (size_t)MTOK * 24 * 4;
constexpr size_t OFF_VC = OFF_KC + 16 * 256 * 64 * 2;
constexpr size_t OFF_BAR = OFF_VC + 16 * 256 * 64 * 2;
constexpr size_t OFF_PCNT = OFF_BAR + XCD_BAR_WORDS_C * 4;
constexpr size_t OFF_QCNT = OFF_PCNT + 256 * 256;
constexpr size_t OFF_B = 30 * MiB;
constexpr size_t OFF_H = 94 * MiB;
constexpr size_t OFF_XB = OFF_H;
constexpr size_t OFF_Q = OFF_H + 64 * MiB;
constexpr size_t OFF_KV = OFF_H + 96 * MiB;
constexpr size_t OFF_CAT = OFF_H + 256 * MiB;
constexpr int HIDP = 4096 + 64;
constexpr size_t OFF_WFF2P = OFF_CAT + 64 * MiB;
constexpr size_t WS_END = OFF_WFF2P + 9 * MiB;
static_assert(OFF_QCNT + 8 * 256 <= OFF_B, "ws map");

struct Params {
  const float* x; const float* norm1_g; const float* w_in; const float* dw_w; const float* dw_b; const float* cln_g; const float* cln_b;
  const float* ck_pe; const float* ck_w1; const float* ck_w2; const float* cv_pe; const float* cv_w1; const float* cv_w2;
  const float* w_out; const float* norm2_g; const float* w_ff1; const float* w_ff2; const float* norm_f_g;
  float* out; unsigned char* ws;
};

DI unsigned pk2(float a, float b) { f32x2 v = {a, b}; bf16v2 r = __builtin_convertvector(v, bf16v2); return __builtin_bit_cast(unsigned, r); }
DI float bf2f(unsigned short u) { return __uint_as_float((unsigned)u << 16); }
DI float sigmoidf_(float v) { return __builtin_amdgcn_rcpf(1.0f + __builtin_amdgcn_exp2f(-v * LOG2E)); }
DI float gelu_tanh(float v) { const float u = 0.7978845608028654f * (v + 0.044715f * v * v * v); const float e = __builtin_amdgcn_exp2f(2.0f * LOG2E * u); const float th = 1.0f - 2.0f * __builtin_amdgcn_rcpf(e + 1.0f); return 0.5f * v * (1.0f + th); }
DI float wave_sum(float v) { v += __shfl_xor(v, 1); v += __shfl_xor(v, 2); v += __shfl_xor(v, 4); v += __shfl_xor(v, 8); v += __shfl_xor(v, 16); v += __shfl_xor(v, 32); return v; }

DI void st_nt(u32x4* p, u32x4 v) { __builtin_nontemporal_store(v, p); }
DI void st_nt(f32x4* p, f32x4 v) { __builtin_nontemporal_store(v, p); }
DI int get_tid() { int t = threadIdx.x; asm volatile("" : "+v"(t)); return t; }

#define XB_TMO      128
#define XB_XCNT(j)  (256  + 64 * (j))
#define XB_XSUB(j)  (1280 + 64 * (j))
#define XB_XGEN(j)  (2304 + 64 * (j))
#define XB_TOP      3328
#define XB_TOPGEN   3392
#define XCD_BAR_WORDS 3456
#define XB_SPIN_CAP (1u << 22)
DI unsigned xb_ld(unsigned* p) { return __hip_atomic_load(p, __ATOMIC_RELAXED, __HIP_MEMORY_SCOPE_AGENT); }
DI unsigned xb_add(unsigned* p, unsigned v) { return __hip_atomic_fetch_add(p, v, __ATOMIC_RELAXED, __HIP_MEMORY_SCOPE_AGENT); }
DI unsigned xb_xcc_id() { return (unsigned)__builtin_amdgcn_s_getreg((3 << 11) | 20) & 0xFu; }
#define XB_SPIN(cond, bar) do { unsigned _sp = 0; while (cond) { __builtin_amdgcn_s_sleep(1); \
    if ((++_sp & 255u) == 0u) { if (xb_ld(&(bar)[XB_TMO])) break; if (_sp > XB_SPIN_CAP) { atomicAdd(&(bar)[XB_TMO], 1u); break; } } } } while (0)
struct XcdBarrier { unsigned* bar; unsigned x; volatile LAS unsigned* st; };
DI XcdBarrier xcd_barrier_post(unsigned* bar, volatile LAS unsigned* st) {
  XcdBarrier b; b.bar = bar; b.x = xb_xcc_id(); b.st = st;
  if (threadIdx.x == 0) (void)xb_add(&bar[XB_XCNT(b.x)], 1u);
  return b;
}
DI void xcd_barrier_complete(unsigned* bar, unsigned x, unsigned& nloc, unsigned& nx) {
  const unsigned G = gridDim.x;
  unsigned sum, cnt, mine, sp = 0u;
  for (;;) {
    sum = 0u; cnt = 0u; mine = 0u;
#pragma unroll
    for (unsigned j = 0; j < 16; ++j) { const unsigned c = xb_ld(&bar[XB_XCNT(j)]); sum += c; cnt += (c > 0u) ? 1u : 0u; mine = (j == x) ? c : mine; }
    if (sum == G) break;
    __builtin_amdgcn_s_sleep(1);
    if ((++sp & 255u) == 0u) { if (xb_ld(&bar[XB_TMO])) break; if (sp > XB_SPIN_CAP) { atomicAdd(&bar[XB_TMO], 1u); break; } }
  }
  nloc = mine > 0u ? mine : 1u; nx = cnt > 0u ? cnt : 1u;
}
DI void xcd_barrier(const XcdBarrier& b) {
  asm volatile("s_waitcnt vmcnt(0)" ::: "memory");
  __syncthreads();
  if (threadIdx.x == 0) {
    unsigned* bar = b.bar;
    __builtin_amdgcn_s_waitcnt(0);
    unsigned nloc = b.st[0], nx = b.st[1];
    if (nloc == 0u) { xcd_barrier_complete(bar, b.x, nloc, nx); b.st[0] = nloc; b.st[1] = nx; }
    const unsigned old = xb_add(&bar[XB_XSUB(b.x)], 1u);
    const unsigned gen = old / nloc;
    if (old + 1u == (gen + 1u) * nloc) {
      __builtin_amdgcn_fence(__ATOMIC_RELEASE, "agent");
      asm volatile("s_waitcnt vmcnt(0)" ::: "memory");
      const unsigned og = xb_add(&bar[XB_TOP], 1u);
      const unsigned tg = og / nx;
      if (og + 1u == (tg + 1u) * nx) xb_add(&bar[XB_TOPGEN], 1u);
      else XB_SPIN(xb_ld(&bar[XB_TOPGEN]) == tg, bar);
      __builtin_amdgcn_fence(__ATOMIC_ACQUIRE, "agent");
      xb_add(&bar[XB_XGEN(b.x)], 1u);
      asm volatile("s_waitcnt vmcnt(0)" ::: "memory");
    } else {
      XB_SPIN(xb_ld(&bar[XB_XGEN(b.x)]) == gen, bar);
      __builtin_amdgcn_fence(__ATOMIC_ACQUIRE, "agent");
      asm volatile("s_waitcnt vmcnt(0)" ::: "memory");
    }
  }
  __syncthreads();
}
namespace pg8 {
constexpr int BM = 256, BK = 64, HALF = 128, HTB = HALF * BK * 2, STAGE_BYTES = 8 * HTB, NXCD = 8, WGM = 8;
DI int lds_byte(int r, int c) { const int st = (r >> 4) * 2 + (c >> 5), rr = r & 15, cc = c & 31, ob = rr * 64 + cc * 2; return st * 1024 + (ob ^ (((ob >> 9) & 1) << 5)); }
DI void stage_rc(int b, int& R, int& C) { const int st = b / 1024, sb = b % 1024, swz = sb ^ (((sb >> 9) & 1) << 5); R = (st >> 1) * 16 + swz / 64; C = (st & 1) * 32 + (swz % 64) / 2; }
DI int perm32(int rho) { const int n = rho >> 4, i = rho & 15; return 8 * (i >> 2) + 4 * n + (i & 3); }

struct Unit { int pm, pn; };
struct Gemm { const bf16_t* A; const bf16_t* Bt; int lda, ldb, K; size_t tstepA, tstepB; };

struct StaticOrder {
  int nM, nN, nwg, G, c;
  DI void init(int M, int N, int G_, int c_) { nM = M / BM; nN = N / BM; nwg = nM * nN; G = G_; c = c_; }
  DI bool next(int i, Unit& u) const {
    const long L = (long)i * G + c; if (L >= nwg) return false;
    int wgid = (int)L; { const int q = nwg / NXCD, r = nwg % NXCD, xcd = wgid % NXCD, off = wgid / NXCD; wgid = (xcd < r ? xcd * (q + 1) : r * (q + 1) + (xcd - r) * q) + off; }
    const int nig = WGM * nN, gid = wgid / nig, fm = gid * WGM, gsz = (nM - fm) < WGM ? (nM - fm) : WGM;
    u.pm = fm + ((wgid % nig) % gsz); u.pn = (wgid % nig) / gsz; return true;
  }
};
struct SingleUnit {
  int pm, pn;
  DI bool next(int i, Unit& u) const { if (i != 0) return false; u.pm = pm; u.pn = pn; return true; }
};

template <class Epi, class Sched, bool ALIGN_EPI = false, bool SP2 = false>
DI void gemm_phase(LAS unsigned char* lds, const Gemm g, const Sched& S, const Epi& E) {
  const int tid = get_tid(), wid = __builtin_amdgcn_readfirstlane(tid >> 6), lane = tid & 63, wr = wid >> 2, wc = wid & 3, fr = lane & 15, fq = lane >> 4;
  const int K = g.K, nt = K / BK;
  unsigned voffA[2], voffB[2];
#pragma unroll
  for (int i = 0; i < 2; ++i) { int R, C; stage_rc(tid * 16 + i * 8192, R, C); const int Rb = Epi::PERM ? ((R & ~31) + perm32(R & 31)) : R;
    voffA[i] = (unsigned)(R * g.lda + C) * 2u; voffB[i] = (unsigned)(Rb * g.ldb + C) * 2u; }
  const size_t kstep = (size_t)(BK * 2);
  const size_t hstepA = (size_t)HALF * g.lda * 2, hstepB = (size_t)HALF * g.ldb * 2;
  const unsigned ldsw = (unsigned)wid * 1024u;
  const int aoff = lds_byte(wr * 64 + fr, fq * 8), boff = lds_byte(wc * 32 + fr, fq * 8);
#define PG8_SA(b, h) (((b) * 2 + (h)) * HTB)
#define PG8_SB(b, h) ((4 + (b) * 2 + (h)) * HTB)
#define PG8_STAGE(bufoff, gbase, voff) do { _Pragma("unroll") for (int _i = 0; _i < 2; ++_i) \
    __builtin_amdgcn_global_load_lds((const unsigned*)((const char*)(gbase) + (voff)[_i]), (LAS unsigned*)(lds + (bufoff) + ldsw + _i * 8192), 16, 0, 0); } while (0)
#define PG8_LDA(dst, b, h) do { _Pragma("unroll") for (int m = 0; m < 4; ++m) _Pragma("unroll") for (int k = 0; k < 2; ++k) dst[m][k] = *(const LAS bf16x8*)(lds + PG8_SA(b, h) + aoff + m * 2048 + k * 1024); } while (0)
#define PG8_LDB(dst, b, h) do { _Pragma("unroll") for (int n = 0; n < 2; ++n) _Pragma("unroll") for (int k = 0; k < 2; ++k) dst[n][k] = *(const LAS bf16x8*)(lds + PG8_SB(b, h) + boff + n * 2048 + k * 1024); } while (0)
#define PG8_MMA(ai, bj, At, Bt) do { __builtin_amdgcn_s_setprio(1); _Pragma("unroll") for (int m = 0; m < 4; ++m) _Pragma("unroll") for (int n = 0; n < 2; ++n) _Pragma("unroll") for (int k = 0; k < 2; ++k) \
    acc[ai][bj][m][n] = __builtin_amdgcn_mfma_f32_16x16x32_bf16(Bt[n][k], At[m][k], acc[ai][bj][m][n], 0, 0, 0); __builtin_amdgcn_s_setprio(0); } while (0)
#define PG8_WAIT_V(n) asm volatile("s_waitcnt vmcnt(" #n ")" ::: "memory")
#define PG8_WAIT_L(n) asm volatile("s_waitcnt lgkmcnt(" #n ")" ::: "memory")
#define PG8_BAR __builtin_amdgcn_s_barrier()
#define PG8_SCHED __builtin_amdgcn_sched_barrier(0)
  Unit cur, nxt; int ui = 0;
  if (!S.next(0, cur)) return;
  f32x4 acc[2][2][4][2];
#pragma unroll
  for (int a = 0; a < 2; ++a)
#pragma unroll
    for (int b = 0; b < 2; ++b)
#pragma unroll
      for (int m = 0; m < 4; ++m)
#pragma unroll
        for (int n = 0; n < 2; ++n) acc[a][b][m][n] = (f32x4){0.f, 0.f, 0.f, 0.f};
  bf16x8 At[4][2], B0[2][2], B1[2][2];
  const char* cA = (const char*)g.A + (size_t)cur.pm * g.tstepA; const char* cB = (const char*)g.Bt + (size_t)cur.pn * g.tstepB;
  if constexpr (SP2) {
    PG8_STAGE(PG8_SB(0, 0), cB, voffB); PG8_STAGE(PG8_SB(0, 1), cB + hstepB, voffB); PG8_STAGE(PG8_SA(0, 0), cA, voffA); PG8_STAGE(PG8_SA(0, 1), cA + hstepA, voffA);
    if (wr == 1) PG8_BAR;
    PG8_WAIT_V(2); PG8_BAR;
    PG8_STAGE(PG8_SB(1, 0), cB + kstep, voffB); PG8_STAGE(PG8_SA(1, 0), cA + kstep, voffA); PG8_STAGE(PG8_SB(1, 1), cB + hstepB + kstep, voffB);
    PG8_WAIT_V(6); PG8_BAR;
  } else {
    PG8_STAGE(PG8_SB(0, 0), cB, voffB); PG8_STAGE(PG8_SA(0, 0), cA, voffA); PG8_STAGE(PG8_SB(0, 1), cB + hstepB, voffB); PG8_STAGE(PG8_SA(0, 1), cA + hstepA, voffA);
    if (wr == 1) PG8_BAR;
    PG8_WAIT_V(4); PG8_BAR;
    PG8_STAGE(PG8_SB(1, 0), cB + kstep, voffB); PG8_STAGE(PG8_SA(1, 0), cA + kstep, voffA); PG8_STAGE(PG8_SB(1, 1), cB + hstepB + kstep, voffB);
    PG8_WAIT_V(6); PG8_BAR;
  }
  for (;;) {
    const bool has_next = S.next(ui + 1, nxt);
    const char* nA = has_next ? (const char*)g.A + (size_t)nxt.pm * g.tstepA : cA; const char* nB = has_next ? (const char*)g.Bt + (size_t)nxt.pn * g.tstepB : cB;
    for (int t = 0; t < nt; t += 2) {
      const bool last = (t == nt - 2);
      const char* a1 = cA + (size_t)(t + 1) * kstep;
      const char* a2 = last ? nA : cA + (size_t)(t + 2) * kstep; const char* b2 = last ? nB : cB + (size_t)(t + 2) * kstep;
      const char* a3 = a2 + kstep; const char* b3 = b2 + kstep;
      if constexpr (SP2) {
        PG8_LDB(B0, 0, 0); PG8_LDB(B1, 0, 1); PG8_SCHED; PG8_LDA(At, 0, 0); PG8_STAGE(PG8_SA(1, 1), a1 + hstepA, voffA);
        PG8_WAIT_V(8); PG8_WAIT_L(0); PG8_BAR; PG8_MMA(0, 0, At, B0); PG8_MMA(0, 1, At, B1); PG8_BAR; PG8_SCHED;
        PG8_LDA(At, 0, 1); PG8_STAGE(PG8_SB(0, 0), b2, voffB); PG8_STAGE(PG8_SB(0, 1), b2 + hstepB, voffB); PG8_STAGE(PG8_SA(0, 0), a2, voffA);
        PG8_WAIT_V(8); PG8_WAIT_L(0); PG8_BAR; PG8_MMA(1, 0, At, B0); PG8_MMA(1, 1, At, B1); PG8_BAR; PG8_SCHED;
        PG8_LDB(B0, 1, 0); PG8_LDB(B1, 1, 1); PG8_SCHED; PG8_LDA(At, 1, 0); PG8_STAGE(PG8_SA(0, 1), a2 + hstepA, voffA);
        PG8_WAIT_V(8); PG8_WAIT_L(0); PG8_BAR; PG8_MMA(0, 0, At, B0); PG8_MMA(0, 1, At, B1); PG8_BAR; PG8_SCHED;
        PG8_LDA(At, 1, 1); PG8_STAGE(PG8_SB(1, 0), b3, voffB); PG8_STAGE(PG8_SB(1, 1), b3 + hstepB, voffB); PG8_STAGE(PG8_SA(1, 0), a3, voffA);
        PG8_WAIT_V(8); PG8_WAIT_L(0); PG8_BAR; PG8_MMA(1, 0, At, B0); PG8_MMA(1, 1, At, B1); PG8_BAR; PG8_SCHED;
      } else {
        PG8_LDB(B0, 0, 0); PG8_SCHED; PG8_LDA(At, 0, 0); PG8_STAGE(PG8_SA(1, 1), a1 + hstepA, voffA);
        PG8_WAIT_L(8); PG8_BAR; PG8_WAIT_L(0); PG8_MMA(0, 0, At, B0); PG8_BAR; PG8_SCHED;
        PG8_LDB(B1, 0, 1); PG8_STAGE(PG8_SB(0, 0), b2, voffB);
        PG8_BAR; PG8_WAIT_L(0); PG8_MMA(0, 1, At, B1); PG8_BAR;
        PG8_LDA(At, 0, 1); PG8_STAGE(PG8_SA(0, 0), a2, voffA);
        PG8_BAR; PG8_WAIT_L(0); PG8_MMA(1, 0, At, B0); PG8_BAR; PG8_SCHED;
        PG8_STAGE(PG8_SB(0, 1), b2 + hstepB, voffB);
        PG8_WAIT_V(6); PG8_BAR; PG8_MMA(1, 1, At, B1); PG8_BAR;
        PG8_LDB(B0, 1, 0); PG8_SCHED; PG8_LDA(At, 1, 0); PG8_STAGE(PG8_SA(0, 1), a2 + hstepA, voffA);
        PG8_WAIT_L(8); PG8_BAR; PG8_WAIT_L(0); PG8_MMA(0, 0, At, B0); PG8_BAR; PG8_SCHED;
        PG8_LDB(B1, 1, 1); PG8_STAGE(PG8_SB(1, 0), b3, voffB);
        PG8_BAR; PG8_WAIT_L(0); PG8_MMA(0, 1, At, B1); PG8_BAR;
        PG8_LDA(At, 1, 1); PG8_STAGE(PG8_SA(1, 0), a3, voffA);
        PG8_BAR; PG8_WAIT_L(0); PG8_MMA(1, 0, At, B0); PG8_BAR; PG8_SCHED;
        PG8_STAGE(PG8_SB(1, 1), b3 + hstepB, voffB);
        PG8_WAIT_V(6); PG8_BAR; PG8_MMA(1, 1, At, B1); PG8_BAR;
      }
    }
    if constexpr (ALIGN_EPI) { if (wr == 0) PG8_BAR; }
    if constexpr (!Epi::AFTER_DRAIN) { E(acc, cur, wr, wc, fr, fq); }
    if (!has_next) break;
#pragma unroll
    for (int a = 0; a < 2; ++a)
#pragma unroll
      for (int b = 0; b < 2; ++b)
#pragma unroll
        for (int m = 0; m < 4; ++m)
#pragma unroll
          for (int n = 0; n < 2; ++n) acc[a][b][m][n] = (f32x4){0.f, 0.f, 0.f, 0.f};
    cur = nxt; cA = nA; cB = nB; ++ui;
    if constexpr (ALIGN_EPI) { if (wr == 1) PG8_BAR; }
  }
  PG8_WAIT_V(0);
  if constexpr (!ALIGN_EPI) { if (wr == 0) PG8_BAR; }
  PG8_BAR;
  if constexpr (Epi::AFTER_DRAIN) { E.fused(acc, cur, wr, wc, fr, fq, lds, wid, lane); }
#undef PG8_SA
#undef PG8_SB
#undef PG8_STAGE
#undef PG8_LDA
#undef PG8_LDB
#undef PG8_MMA
#undef PG8_WAIT_V
#undef PG8_WAIT_L
#undef PG8_BAR
#undef PG8_SCHED
}
}

struct Epi1 {
  static constexpr bool PERM = true, AFTER_DRAIN = false;
  const float* rs; bf16_t* uv; bf16_t* q; bf16_t* kv; float* gates;
  DI void operator()(const f32x4 (&acc)[2][2][4][2], const pg8::Unit& u, int wr, int wc, int fr, int fq) const {
    const int pn = u.pn;
#pragma unroll
    for (int ai = 0; ai < 2; ++ai)
#pragma unroll
      for (int m = 0; m < 4; ++m) {
        const int r = u.pm * 256 + ai * 128 + wr * 64 + m * 16 + fr;
        const float s = rs[r];
#pragma unroll
        for (int bj = 0; bj < 2; ++bj) {
          const int cl = bj * 128 + wc * 32 + 8 * fq;
          f32x4 v0 = acc[ai][bj][m][0] * s, v1 = acc[ai][bj][m][1] * s;
          if (pn < 4) {
            u32x4 w; w.x = pk2(v0[0], v0[1]); w.y = pk2(v0[2], v0[3]); w.z = pk2(v1[0], v1[1]); w.w = pk2(v1[2], v1[3]);
            *(u32x4*)(uv + (size_t)r * 1024 + pn * 256 + cl) = w;
          } else if (pn < 6) {
            v0 = v0 * QSCALE; v1 = v1 * QSCALE;
            u32x4 w; w.x = pk2(v0[0], v0[1]); w.y = pk2(v0[2], v0[3]); w.z = pk2(v1[0], v1[1]); w.w = pk2(v1[2], v1[3]);
            *(u32x4*)(q + (size_t)r * 512 + (pn - 4) * 256 + cl) = w;
          } else if (pn < 9) {
            const int kvidx = (pn - 6) * 256 + cl, br = kvidx >> 7, gg = (kvidx >> 6) & 1, d = kvidx & 63, b = r >> 12, t = r & 4095;
            u32x4 w; w.x = pk2(v0[0], v0[1]); w.y = pk2(v0[2], v0[3]); w.z = pk2(v1[0], v1[1]); w.w = pk2(v1[2], v1[3]);
            *(u32x4*)(kv + ((size_t)(((br * 8 + b) * 2 + gg) * 4096 + t)) * 64 + d) = w;
          } else {
            if (cl < 24) {
              f32x4 g0, g1;
#pragma unroll
              for (int j = 0; j < 4; ++j) { g0[j] = sigmoidf_(v0[j]); g1[j] = sigmoidf_(v1[j]); }
              *(f32x4*)(gates + (size_t)r * 24 + cl) = g0; *(f32x4*)(gates + (size_t)r * 24 + cl + 4) = g1;
            }
          }
        }
      }
  }
};
template <bool WRITE_IO, bool WRITE_B> struct EpiRes {
  static constexpr bool PERM = true, AFTER_DRAIN = false;
  const bf16_t* base; float* io; bf16_t* xb; float* ssq;
  DI void operator()(const f32x4 (&acc)[2][2][4][2], const pg8::Unit& u, int wr, int wc, int fr, int fq) const {
#pragma unroll
    for (int ai = 0; ai < 2; ++ai)
#pragma unroll
      for (int m = 0; m < 4; ++m) {
        const int r = u.pm * 256 + ai * 128 + wr * 64 + m * 16 + fr;
        float ss = 0.f;
#pragma unroll
        for (int bj = 0; bj < 2; ++bj) {
          const size_t off = (size_t)r * 1024 + u.pn * 256 + bj * 128 + wc * 32 + 8 * fq;
          const u32x4 xw = *(const u32x4*)(base + off);
          const f32x4 b0 = (f32x4){__uint_as_float(xw.x << 16), __uint_as_float(xw.x & 0xffff0000u), __uint_as_float(xw.y << 16), __uint_as_float(xw.y & 0xffff0000u)};
          const f32x4 b1 = (f32x4){__uint_as_float(xw.z << 16), __uint_as_float(xw.z & 0xffff0000u), __uint_as_float(xw.w << 16), __uint_as_float(xw.w & 0xffff0000u)};
          const f32x4 v0 = acc[ai][bj][m][0] + b0, v1 = acc[ai][bj][m][1] + b1;
          if (WRITE_IO) { *(f32x4*)(io + off) = v0; *(f32x4*)(io + off + 4) = v1; }
          if (WRITE_B) { u32x4 w; w.x = pk2(v0[0], v0[1]); w.y = pk2(v0[2], v0[3]); w.z = pk2(v1[0], v1[1]); w.w = pk2(v1[2], v1[3]); *(u32x4*)(xb + off) = w; }
          ss += (v0[0] * v0[0] + v0[1] * v0[1]) + (v0[2] * v0[2] + v0[3] * v0[3]) + (v1[0] * v1[0] + v1[1] * v1[1]) + (v1[2] * v1[2] + v1[3] * v1[3]);
        }
        ss += __shfl_xor(ss, 16); ss += __shfl_xor(ss, 32);
        if (fq == 0) atomicAdd(ssq + r, ss);
      }
  }
};
struct EpiFF1 {
  static constexpr bool PERM = true, AFTER_DRAIN = false;
  const float* ssq; bf16_t* hid;
  DI void operator()(const f32x4 (&acc)[2][2][4][2], const pg8::Unit& u, int wr, int wc, int fr, int fq) const {
#pragma unroll
    for (int ai = 0; ai < 2; ++ai)
#pragma unroll
      for (int m = 0; m < 4; ++m) {
        const int r = u.pm * 256 + ai * 128 + wr * 64 + m * 16 + fr;
        const float s = __builtin_amdgcn_rsqf(ssq[r] * (1.0f / 1024.0f) + EPSN);
#pragma unroll
        for (int bj = 0; bj < 2; ++bj) {
          f32x4 v0 = acc[ai][bj][m][0] * s, v1 = acc[ai][bj][m][1] * s;
#pragma unroll
          for (int j = 0; j < 4; ++j) { const float a = fmaxf(v0[j], 0.f), b = fmaxf(v1[j], 0.f); v0[j] = a * a; v1[j] = b * b; }
          u32x4 w; w.x = pk2(v0[0], v0[1]); w.y = pk2(v0[2], v0[3]); w.z = pk2(v1[0], v1[1]); w.w = pk2(v1[2], v1[3]);
          st_nt((u32x4*)(hid + (size_t)r * HIDP + u.pn * 256 + bj * 128 + wc * 32 + 8 * fq), w);
        }
      }
  }
};
struct EpiFinal {
  static constexpr bool PERM = true, AFTER_DRAIN = false;
  const bf16_t* xb; float* io; float* ssq; unsigned* cnt; const float* gn; int fuse;
  DI void operator()(f32x4 (&acc)[2][2][4][2], const pg8::Unit& u, int wr, int wc, int fr, int fq) const {
#pragma unroll
    for (int ai = 0; ai < 2; ++ai)
#pragma unroll
      for (int m = 0; m < 4; ++m) {
        const int r = u.pm * 256 + ai * 128 + wr * 64 + m * 16 + fr;
        float ss = 0.f;
#pragma unroll
        for (int bj = 0; bj < 2; ++bj) {
          const size_t off = (size_t)r * 1024 + u.pn * 256 + bj * 128 + wc * 32 + 8 * fq;
          const u32x4 xw = *(const u32x4*)(xb + off);
          const f32x4 b0 = (f32x4){__uint_as_float(xw.x << 16), __uint_as_float(xw.x & 0xffff0000u), __uint_as_float(xw.y << 16), __uint_as_float(xw.y & 0xffff0000u)};
          const f32x4 b1 = (f32x4){__uint_as_float(xw.z << 16), __uint_as_float(xw.z & 0xffff0000u), __uint_as_float(xw.w << 16), __uint_as_float(xw.w & 0xffff0000u)};
          const f32x4 v0 = acc[ai][bj][m][0] + b0, v1 = acc[ai][bj][m][1] + b1;
          acc[ai][bj][m][0] = v0; acc[ai][bj][m][1] = v1;
          if (!fuse) { *(f32x4*)(io + off) = v0; *(f32x4*)(io + off + 4) = v1; }
          ss += (v0[0] * v0[0] + v0[1] * v0[1]) + (v0[2] * v0[2] + v0[3] * v0[3]) + (v1[0] * v1[0] + v1[1] * v1[1]) + (v1[2] * v1[2] + v1[3] * v1[3]);
        }
        ss += __shfl_xor(ss, 16); ss += __shfl_xor(ss, 32);
        if (fq == 0) atomicAdd(ssq + r, ss);
      }
    if (!fuse) return;
    asm volatile("s_waitcnt vmcnt(0)" ::: "memory");
    unsigned* c = cnt + 64 * (u.pm * 2 + wr);
    if (fr == 0 && fq == 0) __hip_atomic_fetch_add(c, 1u, __ATOMIC_RELAXED, __HIP_MEMORY_SCOPE_AGENT);
    { unsigned sp = 0; while ((unsigned)__builtin_amdgcn_readfirstlane(__hip_atomic_load(c, __ATOMIC_RELAXED, __HIP_MEMORY_SCOPE_AGENT)) < 16u) { __builtin_amdgcn_s_sleep(2); if (++sp > (1u << 22)) break; } }
    f32x4 g[2][2];
#pragma unroll
    for (int bj = 0; bj < 2; ++bj)
#pragma unroll
      for (int n = 0; n < 2; ++n) g[bj][n] = *(const f32x4*)(gn + u.pn * 256 + bj * 128 + wc * 32 + 8 * fq + 4 * n);
#pragma unroll
    for (int ai = 0; ai < 2; ++ai)
#pragma unroll
      for (int m = 0; m < 4; ++m) {
        const int r = u.pm * 256 + ai * 128 + wr * 64 + m * 16 + fr;
        const float s = __builtin_amdgcn_rsqf(__hip_atomic_load(ssq + r, __ATOMIC_RELAXED, __HIP_MEMORY_SCOPE_AGENT) * (1.0f / 1024.0f) + EPSN);
#pragma unroll
        for (int bj = 0; bj < 2; ++bj) {
          const size_t off = (size_t)r * 1024 + u.pn * 256 + bj * 128 + wc * 32 + 8 * fq;
          st_nt((f32x4*)(io + off), acc[ai][bj][m][0] * s * g[bj][0]); st_nt((f32x4*)(io + off + 4), acc[ai][bj][m][1] * s * g[bj][1]);
        }
      }
  }
};
constexpr int HSTR = 528;
struct EpiCmp {
  static constexpr bool PERM = false, AFTER_DRAIN = true;
  const float* bias1; const bf16_t* w2t; bf16_t* outp;
  DI void fused(const f32x4 (&acc)[2][2][4][2], const pg8::Unit& u, int wr, int wc, int fr, int fq, LAS unsigned char* lds, int wid, int lane) const {
#pragma unroll
    for (int bj = 0; bj < 2; ++bj)
#pragma unroll
      for (int n = 0; n < 2; ++n) {
        const int c = bj * 128 + wc * 32 + n * 16 + 4 * fq;
        const f32x4 bv = *(const f32x4*)(bias1 + c);
#pragma unroll
        for (int ai = 0; ai < 2; ++ai)
#pragma unroll
          for (int m = 0; m < 4; ++m) {
            const int r = ai * 128 + wr * 64 + m * 16 + fr;
            const f32x4 v = acc[ai][bj][m][n] + bv;
            u32x2 w; w.x = pk2(gelu_tanh(v[0]), gelu_tanh(v[1])); w.y = pk2(gelu_tanh(v[2]), gelu_tanh(v[3]));
            *(LAS u32x2*)(lds + r * HSTR + c * 2) = w;
          }
      }
    __syncthreads();
    f32x4 o[2][4];
#pragma unroll
    for (int mb = 0; mb < 2; ++mb)
#pragma unroll
      for (int nb = 0; nb < 4; ++nb) o[mb][nb] = (f32x4){0.f, 0.f, 0.f, 0.f};
    bf16x8 wf[8][4];
#pragma unroll
    for (int ks = 0; ks < 8; ++ks)
#pragma unroll
      for (int nb = 0; nb < 4; ++nb) wf[ks][nb] = *(const bf16x8*)(w2t + (16 * nb + fr) * 256 + 32 * ks + 8 * fq);
#pragma unroll
    for (int ks = 0; ks < 8; ++ks) {
      bf16x8 hf[2];
#pragma unroll
      for (int mb = 0; mb < 2; ++mb) hf[mb] = *(const LAS bf16x8*)(lds + (32 * wid + 16 * mb + fr) * HSTR + (32 * ks + 8 * fq) * 2);
#pragma unroll
      for (int mb = 0; mb < 2; ++mb)
#pragma unroll
        for (int nb = 0; nb < 4; ++nb) o[mb][nb] = __builtin_amdgcn_mfma_f32_16x16x32_bf16(wf[ks][nb], hf[mb], o[mb][nb], 0, 0, 0);
    }
#pragma unroll
    for (int mb = 0; mb < 2; ++mb)
#pragma unroll
      for (int nb = 0; nb < 4; ++nb) {
        const int row = 32 * wid + 16 * mb + fr;
        u32x2 w; w.x = pk2(o[mb][nb][0], o[mb][nb][1]); w.y = pk2(o[mb][nb][2], o[mb][nb][3]);
        *(u32x2*)(outp + ((size_t)u.pm * 256 + row) * 64 + 16 * nb + 4 * fq) = w;
      }
    __syncthreads();
  }
};

struct TJob { const float* src; bf16_t* dst; const float* g; int K, N, kt, nt, ldd; };
DI TJob transpose_job(const Params& p, int job) {
  unsigned char* ws = p.ws; TJob t;
  if (job < 640) t = TJob{p.w_in, (bf16_t*)(ws + OFF_WIN), p.norm1_g, 1024, 2328, job / 40, job % 40, 1024};
  else if (job < 896) { const int j = job - 640; t = TJob{p.w_out, (bf16_t*)(ws + OFF_WOUT), nullptr, 1024, 1024, j / 16, j % 16, 1024}; }
  else if (job < 1920) { const int j = job - 896; t = TJob{p.w_ff1, (bf16_t*)(ws + OFF_WFF1), p.norm2_g, 1024, 4096, j / 64, j % 64, 1024}; }
  else if (job < 2944) { const int j = job - 1920; t = TJob{p.w_ff2, (bf16_t*)(ws + OFF_WFF2P), nullptr, 4096, 1024, j / 16, j % 16, HIDP}; }
  else if (job < 3072) { const int j = job - 2944; t = TJob{p.ck_w1, (bf16_t*)(ws + OFF_CW1), nullptr, 2048, 256, j / 4, j % 4, 2048}; }
  else if (job < 3200) { const int j = job - 3072; t = TJob{p.cv_w1, (bf16_t*)(ws + OFF_CW1) + 256 * 2048, nullptr, 2048, 256, j / 4, j % 4, 2048}; }
  else if (job < 3204) { const int j = job - 3200; t = TJob{p.ck_w2, (bf16_t*)(ws + OFF_CW2), nullptr, 256, 64, j, 0, 256}; }
  else { const int j = job - 3204; t = TJob{p.cv_w2, (bf16_t*)(ws + OFF_CW2) + 64 * 256, nullptr, 256, 64, j, 0, 256}; }
  return t;
}
DI void transpose_pair(const TJob& ta, const TJob& tb, bool has_b, LAS float* tl) {
  const int tid = get_tid();
  f32x4 va[2], vb[2];
#pragma unroll
  for (int i = 0; i < 2; ++i) {
    const int idx = tid + 512 * i, row = idx >> 4, c4 = idx & 15;
    { const int n = ta.nt * 64 + 4 * c4; va[i] = (f32x4){0.f, 0.f, 0.f, 0.f}; if (n < ta.N) va[i] = *(const f32x4*)(ta.src + (size_t)(ta.kt * 64 + row) * ta.N + n); if (ta.g) va[i] = va[i] * ta.g[ta.kt * 64 + row]; }
    vb[i] = (f32x4){0.f, 0.f, 0.f, 0.f};
    if (has_b) { const int n = tb.nt * 64 + 4 * c4; if (n < tb.N) vb[i] = *(const f32x4*)(tb.src + (size_t)(tb.kt * 64 + row) * tb.N + n); if (tb.g) vb[i] = vb[i] * tb.g[tb.kt * 64 + row]; }
  }
#pragma unroll
  for (int i = 0; i < 2; ++i) {
    const int idx = tid + 512 * i, row = idx >> 4, c4 = idx & 15;
#pragma unroll
    for (int e = 0; e < 4; ++e) { tl[row * 65 + 4 * c4 + e] = va[i][e]; tl[4160 + row * 65 + 4 * c4 + e] = vb[i][e]; }
  }
  __syncthreads();
  {
    const int nrow = tid >> 3, kc = tid & 7;
    float e[8];
#pragma unroll
    for (int j = 0; j < 8; ++j) e[j] = tl[(8 * kc + j) * 65 + nrow];
    u32x4 w; w.x = pk2(e[0], e[1]); w.y = pk2(e[2], e[3]); w.z = pk2(e[4], e[5]); w.w = pk2(e[6], e[7]);
    *(u32x4*)(ta.dst + (size_t)(ta.nt * 64 + nrow) * ta.ldd + ta.kt * 64 + 8 * kc) = w;
    if (has_b) {
#pragma unroll
      for (int j = 0; j < 8; ++j) e[j] = tl[4160 + (8 * kc + j) * 65 + nrow];
      w.x = pk2(e[0], e[1]); w.y = pk2(e[2], e[3]); w.z = pk2(e[4], e[5]); w.w = pk2(e[6], e[7]);
      *(u32x4*)(tb.dst + (size_t)(tb.nt * 64 + nrow) * tb.ldd + tb.kt * 64 + 8 * kc) = w;
    }
  }
  __syncthreads();
}

DI void p0_prologue(const Params& p, LAS unsigned char* lds) {
  const int tid = get_tid(), lane = tid & 63, wid = tid >> 6, G = gridDim.x, bx = blockIdx.x;
  unsigned char* ws = p.ws;
  {
    bf16_t* xb = (bf16_t*)(ws + OFF_XB); float* rs1 = (float*)(ws + OFF_RS1);
    for (int r0 = (bx * 8 + wid) * 4; r0 < MTOK; r0 += G * 32) {
      f32x4 a[4][2], c[4][2];
#pragma unroll
      for (int rr = 0; rr < 4; ++rr)
#pragma unroll
        for (int i = 0; i < 2; ++i) { const float* s = p.x + (size_t)(r0 + rr) * 1024 + (lane + 64 * i) * 8; a[rr][i] = __builtin_nontemporal_load((const f32x4*)s); c[rr][i] = __builtin_nontemporal_load((const f32x4*)(s + 4)); }
#pragma unroll
      for (int rr = 0; rr < 4; ++rr) {
        float ss = 0.f;
#pragma unroll
        for (int i = 0; i < 2; ++i) {
          const f32x4 av = a[rr][i], bv = c[rr][i];
          ss += (av[0] * av[0] + av[1] * av[1]) + (av[2] * av[2] + av[3] * av[3]) + (bv[0] * bv[0] + bv[1] * bv[1]) + (bv[2] * bv[2] + bv[3] * bv[3]);
          u32x4 w; w.x = pk2(av[0], av[1]); w.y = pk2(av[2], av[3]); w.z = pk2(bv[0], bv[1]); w.w = pk2(bv[2], bv[3]);
          *(u32x4*)(xb + (size_t)(r0 + rr) * 1024 + (lane + 64 * i) * 8) = w;
        }
        ss = wave_sum(ss);
        if (lane == 0) rs1[r0 + rr] = __builtin_amdgcn_rsqf(ss * (1.0f / 1024.0f) + EPSN);
      }
    }
  }
  { float* z = (float*)(ws + OFF_SSQ2); for (int i = bx * 512 + tid; i < 2 * MTOK; i += G * 512) z[i] = 0.f; }
  for (int pair = bx; pair < 256; pair += G) {
    LAS float* red = (LAS float*)lds;
    const int kv = pair >> 7, n = (pair & 127) * 2 + (tid & 1), ksl = tid >> 1;
    const float* pe = kv ? p.cv_pe : p.ck_pe; const float* w1 = kv ? p.cv_w1 : p.ck_w1;
    float s = 0.f;
#pragma unroll
    for (int k = 0; k < 8; ++k) s += pe[ksl * 8 + k] * w1[(size_t)(ksl * 8 + k) * 256 + n];
    s += __shfl_xor(s, 2); s += __shfl_xor(s, 4); s += __shfl_xor(s, 8); s += __shfl_xor(s, 16); s += __shfl_xor(s, 32);
    if (lane < 2) red[wid * 2 + lane] = s;
    __syncthreads();
    if (tid < 2) { float t = 0.f; for (int i = 0; i < 8; ++i) t += red[i * 2 + tid]; ((float*)(ws + OFF_CB1))[kv * 256 + (pair & 127) * 2 + tid] = t; }
    __syncthreads();
  }
  for (int job = bx; job < 3208; job += 2 * G) {
    const bool has_b = (job + G) < 3208;
    const TJob ta = transpose_job(p, job), tb = transpose_job(p, has_b ? job + G : job);
    transpose_pair(ta, tb, has_b, (LAS float*)lds);
  }
}

constexpr int USTR = 1040;
constexpr int YSTR = 516;
constexpr int C_WOFF = 66560;
DI void conv_load_taps(const Params& p, LAS unsigned char* lds) {
  LAS float* Wp = (LAS float*)(lds + C_WOFF);
  for (int idx = get_tid(); idx < 32 * 256; idx += 512) {
    const int w = idx >> 8, cp = idx & 255;
    f32x2 t = (f32x2){0.f, 0.f};
    if (w < 31) t = *(const f32x2*)(p.dw_w + w * 512 + 2 * cp);
    *(LAS f32x2*)(Wp + ((w >> 2) * 256 + cp) * 8 + (w & 3) * 2) = t;
  }
}
DI void conv_tile(const Params& p, LAS unsigned char* lds, int tile) {
  const int tid = get_tid(), lane = tid & 63, wid = tid >> 6;
  const int b = tile >> 7, t0 = (tile & 127) * 32;
  const bf16_t* uv = (const bf16_t*)(p.ws + OFF_B);
  bf16_t* cat = (bf16_t*)(p.ws + OFF_CAT);
  LAS unsigned char* U = lds; LAS float* Y = (LAS float*)lds;
  const LAS float* Wp = (const LAS float*)(lds + C_WOFF);
  {
    u32x4 vv[8], gv[8];
#pragma unroll
    for (int it = 0; it < 8; ++it) {
      const int idx = tid + 512 * it, row = idx >> 6, ch = idx & 63, t = t0 - 30 + row;
      const int tc = t < 0 ? 0 : (row < 62 ? t : t0);
      const size_t m = (size_t)b * 4096 + tc;
      vv[it] = *(const u32x4*)(uv + m * 1024 + ch * 8); gv[it] = *(const u32x4*)(uv + m * 1024 + 512 + ch * 8);
    }
#pragma unroll
    for (int it = 0; it < 8; ++it) {
      const int idx = tid + 512 * it, row = idx >> 6, ch = idx & 63, t = t0 - 30 + row;
      u32x4 w = (u32x4){0u, 0u, 0u, 0u};
      if (t >= 0 && row < 62) {
#pragma unroll
        for (int j = 0; j < 4; ++j) {
          const float v0 = __uint_as_float(vv[it][j] << 16), v1 = __uint_as_float(vv[it][j] & 0xffff0000u), g0 = __uint_as_float(gv[it][j] << 16), g1 = __uint_as_float(gv[it][j] & 0xffff0000u);
          w[j] = pk2(v0 * sigmoidf_(g0), v1 * sigmoidf_(g1));
        }
      }
      if (row < 63) *(LAS u32x4*)(U + row * USTR + ch * 16) = w;
    }
  }
  __syncthreads();
  const int half = tid >> 8, cp = tid & 255;
  float a0[16], a1[16];
  {
    const f32x2 bias = *(const f32x2*)(p.dw_b + 2 * cp);
#pragma unroll
    for (int o = 0; o < 16; ++o) { a0[o] = bias.x; a1[o] = bias.y; }
#pragma unroll
    for (int og = 0; og < 2; ++og) {
      const LAS unsigned char* ub = U + (half * 16 + og * 8) * USTR + cp * 4;
#pragma unroll 1
      for (int w4 = 0; w4 < 8; ++w4) {
        const f32x4 wa = *(const LAS f32x4*)(Wp + (w4 * 256 + cp) * 8), wb = *(const LAS f32x4*)(Wp + (w4 * 256 + cp) * 8 + 4);
        const float wt0[4] = {wa[0], wa[2], wb[0], wb[2]}, wt1[4] = {wa[1], wa[3], wb[1], wb[3]};
        float u0[11], u1[11];
#pragma unroll
        for (int r = 0; r < 11; ++r) { const unsigned uu = *(const LAS unsigned*)(ub + (w4 * 4 + r) * USTR); u0[r] = __uint_as_float(uu << 16); u1[r] = __uint_as_float(uu & 0xffff0000u); }
#pragma unroll
        for (int o = 0; o < 8; ++o)
#pragma unroll
          for (int k = 0; k < 4; ++k) { a0[og * 8 + o] += u0[o + k] * wt0[k]; a1[og * 8 + o] += u1[o + k] * wt1[k]; }
      }
    }
  }
  __syncthreads();
#pragma unroll
  for (int o = 0; o < 16; ++o) *(LAS f32x2*)(Y + (half * 16 + o) * YSTR + 2 * cp) = (f32x2){a0[o], a1[o]};
  __syncthreads();
  {
    const f32x4 g0 = *(const f32x4*)(p.cln_g + lane * 8), g1 = *(const f32x4*)(p.cln_g + lane * 8 + 4), b0 = *(const f32x4*)(p.cln_b + lane * 8), b1 = *(const f32x4*)(p.cln_b + lane * 8 + 4);
#pragma unroll
    for (int i = 0; i < 4; ++i) {
      const int tok = wid * 4 + i;
      const f32x4 y0 = *(const LAS f32x4*)(Y + tok * YSTR + lane * 8), y1 = *(const LAS f32x4*)(Y + tok * YSTR + lane * 8 + 4);
      float s = (y0[0] + y0[1]) + (y0[2] + y0[3]) + (y1[0] + y1[1]) + (y1[2] + y1[3]);
      s = wave_sum(s);
      const float mu = s * (1.0f / 512.0f);
      const f32x4 d0 = y0 - mu, d1 = y1 - mu;
      float q = (d0[0] * d0[0] + d0[1] * d0[1]) + (d0[2] * d0[2] + d0[3] * d0[3]) + (d1[0] * d1[0] + d1[1] * d1[1]) + (d1[2] * d1[2] + d1[3] * d1[3]);
      q = wave_sum(q);
      const float rstd = __builtin_amdgcn_rsqf(q * (1.0f / 512.0f) + EPSN);
      f32x4 o0 = d0 * rstd * g0 + b0, o1 = d1 * rstd * g1 + b1;
#pragma unroll
      for (int j = 0; j < 4; ++j) { o0[j] = o0[j] * sigmoidf_(o0[j]); o1[j] = o1[j] * sigmoidf_(o1[j]); }
      u32x4 w; w.x = pk2(o0[0], o0[1]); w.y = pk2(o0[2], o0[3]); w.z = pk2(o1[0], o1[1]); w.w = pk2(o1[2], o1[3]);
      *(u32x4*)(cat + ((size_t)b * 4096 + t0 + tok) * 1024 + lane * 8) = w;
    }
  }
  __syncthreads();
}

constexpr int KVSTR = 144;
constexpr int VSTR = 144;
constexpr int A_GRP = 4 * 64 * KVSTR;
constexpr int A_KOFF = 0, A_VOFF = 2 * 64 * KVSTR;
constexpr int A_SLAB = 2 * A_GRP;
constexpr int SLAB_FLOATS = 32 * 65;
constexpr int A_SEL = A_SLAB + 8 * SLAB_FLOATS * 4;
constexpr int A_OR = A_SEL + 512;
constexpr int A_CNT = A_OR + 16;
constexpr int A_NXT = A_CNT + 32;
constexpr int A_LINV = A_NXT + 32;
static_assert(A_LINV + 1024 <= LDS_BYTES - 16, "attention LDS map");

DI void group_sync(LAS unsigned* cnt, unsigned& tgt, int lane) {
  tgt += 4u;
  __builtin_amdgcn_fence(__ATOMIC_RELEASE, "workgroup");
  if (lane == 0) __hip_atomic_fetch_add(cnt, 1u, __ATOMIC_RELAXED, __HIP_MEMORY_SCOPE_WORKGROUP);
  while ((int)(__hip_atomic_load(cnt, __ATOMIC_RELAXED, __HIP_MEMORY_SCOPE_WORKGROUP) - tgt) < 0) __builtin_amdgcn_s_sleep(0);
  __builtin_amdgcn_fence(__ATOMIC_ACQUIRE, "workgroup");
}

constexpr float ATT_THR = 8.0f;
template <int KIND, bool MASKED>
DI void attn_scores(LAS unsigned char* kbuf, int jc, const bf16x8 (&qf)[4], float slope2, float sc, int tq, int jt, unsigned long long mymask, float mref, f32x16 (&S)[2], int q, int h) {
  float base2; int kmin = -1, kmax = 64;
  if (KIND <= 1) {
    const int lim = 64 * jt + tq - 31 - 1024 * jc - 64 * h;
    base2 = -slope2 * (float)lim - mref; kmax = lim >> 4;
  } else {
    base2 = slope2 * (float)(64 * (jc - jt) + 4 * h - tq) - mref;
    if (MASKED && jc == jt) kmax = tq - 4 * h;
    if (MASKED && KIND == 3 && jc == jt - 8) kmin = tq - 4 * h;
    if (KIND == 2) base2 = ((mymask >> jc) & 1ull) ? base2 : -1e30f;
  }
#pragma unroll
  for (int kb = 0; kb < 2; ++kb) {
#pragma unroll
    for (int i = 0; i < 16; ++i) S[kb][i] = __builtin_fmaf(sc, (float)(32 * kb + 8 * (i >> 2) + (i & 3)), base2);
#pragma unroll
    for (int ks = 0; ks < 4; ++ks) {
      const bf16x8 kf = *(const LAS bf16x8*)(kbuf + (32 * kb + q) * KVSTR + 32 * ks + 16 * h);
      S[kb] = __builtin_amdgcn_mfma_f32_32x32x16_bf16(kf, qf[ks], S[kb], 0, 0, 0);
    }
  }
  if (MASKED) {
    const unsigned range = (unsigned)(kmax - kmin);
#pragma unroll
    for (int kb = 0; kb < 2; ++kb)
#pragma unroll
      for (int i = 0; i < 16; ++i) {
        const int keyc = 32 * kb + 8 * (i >> 2) + (i & 3);
        const bool ok = (kmax > kmin) && ((unsigned)(keyc - kmin - 1) < range);
        S[kb][i] = ok ? S[kb][i] : -INFINITY;
      }
  }
}
DI float attn_exp_sum(f32x16 (&S)[2]) {
  float ps = 0.f;
#pragma unroll
  for (int kb = 0; kb < 2; ++kb)
#pragma unroll
    for (int i = 0; i < 16; ++i) { const float pv = __builtin_amdgcn_exp2f(S[kb][i]); S[kb][i] = pv; ps += pv; asm volatile("" : "+v"(ps)); }
  return ps;
}
constexpr float ATT_SUM_CAP = 16777216.0f;
template <int KIND, bool MASKED>
DI void attn_tile(LAS unsigned char* kbuf, LAS unsigned char* vbuf, int jc, const bf16x8 (&qf)[4], float slope2, float sc, int tq, int jt, unsigned long long mymask,
                  float& m_run, float& l_run, float l2inv, f32x16 (&O)[2], LAS float* slab, int q, int h, int q4, int p4, int g1) {
  f32x16 S[2];
  attn_scores<KIND, MASKED>(kbuf, jc, qf, slope2, sc, tq, jt, mymask, m_run, S, q, h);
  {
    float ps = attn_exp_sum(S);
    if (__any(!(ps < ATT_SUM_CAP))) {
      asm volatile("s_nop 0" ::: "memory");
      attn_scores<KIND, MASKED>(kbuf, jc, qf, slope2, sc, tq, jt, mymask, m_run, S, q, h);
      float mx = fmaxf(S[0][0], S[1][0]);
#pragma unroll
      for (int i = 1; i < 16; ++i) mx = fmaxf(fmaxf(mx, S[0][i]), S[1][i]);
      mx = fmaxf(mx, __shfl_xor(mx, 32));
      const float d = fmaxf(mx, 0.f), alpha = __builtin_amdgcn_exp2f(-d);
      m_run += d; l_run *= alpha;
#pragma unroll
      for (int kb = 0; kb < 2; ++kb)
#pragma unroll
        for (int i = 0; i < 16; ++i) S[kb][i] -= d;
      if (KIND != 0) {
#pragma unroll
        for (int db = 0; db < 2; ++db)
#pragma unroll
          for (int i = 0; i < 16; ++i) O[db][i] *= alpha;
      }
      if (KIND == 1) { for (int jj = h; jj < 65; jj += 2) slab[q * 65 + jj] *= alpha; }
      ps = attn_exp_sum(S);
    }
    l_run += ps;
  }
  if (KIND == 1) {
    float s4[8], rx[8];
#pragma unroll
    for (int kb = 0; kb < 2; ++kb)
#pragma unroll
      for (int gi = 0; gi < 4; ++gi) {
        float t4 = S[kb][4 * gi] + S[kb][4 * gi + 1]; asm volatile("" : "+v"(t4)); t4 += S[kb][4 * gi + 2]; asm volatile("" : "+v"(t4)); t4 += S[kb][4 * gi + 3];
        s4[4 * kb + gi] = t4; rx[4 * kb + gi] = __shfl_xor(S[kb][4 * gi + 3], 32);
      }
    LAS float* rowp = slab + q * 65 + 16 * jc + h;
    float old[9], val[9];
#pragma unroll
    for (int m = 0; m < 9; ++m) {
      const float own = (m < 8) ? s4[m < 8 ? m : 7] : 0.f;
      const float a1 = (m < 8) ? rx[m < 8 ? m : 7] : 0.f;
      const float a0 = (m > 0) ? rx[m > 0 ? m - 1 : 0] : 0.f;
      val[m] = own + (h ? a1 : a0);
    }
#pragma unroll
    for (int m = 0; m < 9; ++m) old[m] = (m < 8 || h == 0) ? rowp[2 * m] : 0.f;
#pragma unroll
    for (int m = 0; m < 9; ++m) if (m < 8 || h == 0) rowp[2 * m] = old[m] + val[m];
  }
  if (KIND != 0) {
#pragma unroll
    for (int kb = 0; kb < 2; ++kb)
#pragma unroll
      for (int s = 0; s < 2; ++s) {
        u32x4 pw;
        pw.x = pk2(S[kb][8 * s + 0], S[kb][8 * s + 1]); pw.y = pk2(S[kb][8 * s + 2], S[kb][8 * s + 3]);
        pw.z = pk2(S[kb][8 * s + 4], S[kb][8 * s + 5]); pw.w = pk2(S[kb][8 * s + 6], S[kb][8 * s + 7]);
        const bf16x8 pf = __builtin_bit_cast(bf16x8, pw);
#pragma unroll
        for (int db = 0; db < 2; ++db) {
          LAS unsigned char* va = vbuf + (32 * kb + 16 * s + 4 * h + q4) * VSTR + (32 * db + 16 * g1) * 2 + 8 * p4;
          const s16x4 lo = __builtin_amdgcn_ds_read_tr16_b64_v4i16((LAS s16x4*)va);
          const s16x4 hi = __builtin_amdgcn_ds_read_tr16_b64_v4i16((LAS s16x4*)(va + 8 * VSTR));
          const bf16x8 vf = __builtin_shufflevector(lo, hi, 0, 1, 2, 3, 4, 5, 6, 7);
          O[db] = __builtin_amdgcn_mfma_f32_32x32x16_bf16(vf, pf, O[db], 0, 0, 0);
        }
      }
  }
}

template <int KIND>
DI void attn_branch(LAS unsigned char* gl, LAS unsigned* cnt, unsigned& tgt, const bf16_t* Kg, const bf16_t* Vg, unsigned long long tmask, const bf16x8 (&qf)[4], float slope2, int tq, int jt,
                    unsigned long long mymask, float& m_run, float& l_run, float invl, f32x16 (&O)[2], LAS float* slab) {
  const int gt = get_tid() & 255, lane = gt & 63, q = lane & 31, h = lane >> 5;
  const int i16 = lane & 15, q4 = i16 >> 2, p4 = i16 & 3, g1 = (lane >> 4) & 1;
  const float sc = (KIND <= 1) ? slope2 * 16.0f : slope2;
  const int woff = (gt >> 3) * KVSTR + (gt & 7) * 16;
  int j = __builtin_ctzll(tmask); tmask &= tmask - 1;
  const u32x4 z4 = (u32x4){0u, 0u, 0u, 0u};
  u32x4 ka = *(const u32x4*)(Kg + (size_t)j * 4096 + gt * 8), kb = *(const u32x4*)(Kg + (size_t)j * 4096 + 2048 + gt * 8), va = z4, vb = z4;
  if (KIND != 0) { va = *(const u32x4*)(Vg + (size_t)j * 4096 + gt * 8); vb = *(const u32x4*)(Vg + (size_t)j * 4096 + 2048 + gt * 8); }
  int buf = 0;
  for (;;) {
    LAS unsigned char* kbuf = gl + A_KOFF + buf * (64 * KVSTR); LAS unsigned char* vbuf = gl + A_VOFF + buf * (64 * VSTR);
    *(LAS u32x4*)(kbuf + woff) = ka; *(LAS u32x4*)(kbuf + 32 * KVSTR + woff) = kb;
    if (KIND != 0) { *(LAS u32x4*)(vbuf + woff) = va; *(LAS u32x4*)(vbuf + 32 * VSTR + woff) = vb; }
    group_sync(cnt, tgt, lane);
    const int jc = j;
    const bool more = (tmask != 0ull);
    if (more) {
      j = __builtin_ctzll(tmask); tmask &= tmask - 1;
      ka = *(const u32x4*)(Kg + (size_t)j * 4096 + gt * 8); kb = *(const u32x4*)(Kg + (size_t)j * 4096 + 2048 + gt * 8);
      if (KIND != 0) { va = *(const u32x4*)(Vg + (size_t)j * 4096 + gt * 8); vb = *(const u32x4*)(Vg + (size_t)j * 4096 + 2048 + gt * 8); }
    }
    if (KIND <= 1 || jc == jt || (KIND == 3 && jc == jt - 8)) attn_tile<KIND, true>(kbuf, vbuf, jc, qf, slope2, sc, tq, jt, mymask, m_run, l_run, invl, O, slab, q, h, q4, p4, g1);
    else attn_tile<KIND, (KIND <= 1)>(kbuf, vbuf, jc, qf, slope2, sc, tq, jt, mymask, m_run, l_run, invl, O, slab, q, h, q4, p4, g1);
    buf ^= 1;
    if (!more) break;
  }
  group_sync(cnt, tgt, lane);
}

DI int queue_pop(unsigned* qbase, unsigned xcc) {
  for (unsigned qq = 0; qq < 8u; ++qq) {
    const unsigned x2 = (xcc + qq) & 7u;
    const unsigned i = __hip_atomic_fetch_add(qbase + 64 * x2, 1u, __ATOMIC_RELAXED, __HIP_MEMORY_SCOPE_AGENT);
    if (i < 256u) return (int)(x2 * 256u + i);
  }
  return -1;
}
DI void attn_item(const Params& p, LAS unsigned char* lds, int grp, unsigned& tgt, int enc, int& nenc, unsigned xcc) {
  const int gt = get_tid() & 255, lane = gt & 63, hh = __builtin_amdgcn_readfirstlane(gt >> 6), q = lane & 31, h = lane >> 5;
  const int bg = 2 * (enc >> 8) + (enc & 1), jt32 = 127 - ((enc & 255) >> 1);
  int popv = -1;
  if (gt == 0) popv = queue_pop((unsigned*)(p.ws + OFF_QCNT), xcc);
  const int b = bg >> 1, g = bg & 1, head = g * 4 + hh, jt = jt32 >> 1, tq = (jt32 & 1) * 32 + q, t = jt * 64 + tq;
  const size_t mrow = (size_t)b * 4096 + t;
  const bf16_t* Qp = (const bf16_t*)(p.ws + OFF_Q);
  const bf16_t* KV = (const bf16_t*)(p.ws + OFF_KV);
  const float* gates = (const float*)(p.ws + OFF_GATES);
  bf16_t* cat = (bf16_t*)(p.ws + OFF_CAT);
  float* osc = (float*)(p.ws + OFF_B) + mrow * 512 + head * 64 + 4 * h;
  LAS unsigned char* gl = lds + grp * A_GRP;
  LAS float* slab = (LAS float*)(lds + A_SLAB) + (grp * 4 + hh) * SLAB_FLOATS;
  LAS unsigned long long* selm = (LAS unsigned long long*)(lds + A_SEL) + grp * 32;
  LAS unsigned long long* orm = (LAS unsigned long long*)(lds + A_OR) + grp;
  LAS unsigned* cnt = (LAS unsigned*)(lds + A_CNT + 16 * grp);
  for (int i = lane; i < SLAB_FLOATS; i += 64) slab[i] = 0.f;
  if (gt == 0) *orm = 0ull;
  bf16x8 qf[4];
#pragma unroll
  for (int ks = 0; ks < 4; ++ks) qf[ks] = *(const bf16x8*)(Qp + mrow * 512 + head * 64 + 16 * ks + 8 * h);
  const float slope2 = __builtin_amdgcn_exp2f(-(float)(head + 1)) * LOG2E;
  const float g_cmp = gates[mrow * 24 + head * 3 + 0], g_sel = gates[mrow * 24 + head * 3 + 1], g_win = gates[mrow * 24 + head * 3 + 2];
  const size_t bgoff = (size_t)bg * 4096 * 64;
  const bf16_t* Ksel = KV + (size_t)2 * 16 * 4096 * 64 + bgoff; const bf16_t* Vsel = KV + (size_t)3 * 16 * 4096 * 64 + bgoff;
  const bf16_t* Kwin = KV + (size_t)4 * 16 * 4096 * 64 + bgoff; const bf16_t* Vwin = KV + (size_t)5 * 16 * 4096 * 64 + bgoff;
  const bf16_t* Kc = (const bf16_t*)(p.ws + OFF_KC) + (size_t)bg * 256 * 64; const bf16_t* Vc = (const bf16_t*)(p.ws + OFF_VC) + (size_t)bg * 256 * 64;
  f32x16 O[2];
#pragma unroll
  for (int db = 0; db < 2; ++db)
#pragma unroll
    for (int i = 0; i < 16; ++i) O[db][i] = 0.f;
  {
    const int ncmp = 4 * jt + 2 * (jt32 & 1) + 1, ntile = (ncmp + 63) >> 6;
    const unsigned long long cm = (1ull << ntile) - 1ull;
    float m_run = 0.f, l_run = 0.f;
    attn_branch<1>(gl, cnt, tgt, Kc, Vc, cm, qf, slope2, tq, jt, 0ull, m_run, l_run, 0.f, O, slab);
    const float lt = l_run + __shfl_xor(l_run, 32);
    const float invl = lt > 0.f ? __builtin_amdgcn_rcpf(lt) : 0.f;
    if (h == 0) ((LAS float*)(lds + A_LINV))[(grp * 4 + hh) * 32 + q] = invl;
    const float gsc = g_cmp * invl;
#pragma unroll
    for (int db = 0; db < 2; ++db)
#pragma unroll
      for (int gi = 0; gi < 4; ++gi) {
        *(f32x4*)(osc + 32 * db + 8 * gi) = (f32x4){O[db][4 * gi], O[db][4 * gi + 1], O[db][4 * gi + 2], O[db][4 * gi + 3]} * gsc;
        O[db][4 * gi] = 0.f; O[db][4 * gi + 1] = 0.f; O[db][4 * gi + 2] = 0.f; O[db][4 * gi + 3] = 0.f;
      }
  }
  group_sync(cnt, tgt, lane);
  {
    const LAS float* slabs = (const LAS float*)(lds + A_SLAB) + grp * 4 * SLAB_FLOATS;
    unsigned long long worm = 0ull;
    unsigned key[8], prefix[8];
#pragma unroll
    for (int tt = 0; tt < 8; ++tt) {
      const int tok = hh * 8 + tt;
      float v = 0.f;
#pragma unroll
      for (int h2 = 0; h2 < 4; ++h2) v += slabs[h2 * SLAB_FLOATS + tok * 65 + lane] * ((const LAS float*)(lds + A_LINV))[(grp * 4 + h2) * 32 + tok];
      if (lane == 0 || lane == jt || lane == jt - 1) v = 1e30f; else if (lane > jt) v = -1e30f;
      unsigned k = __float_as_uint(v); k = (k & 0x80000000u) ? ~k : (k | 0x80000000u);
      key[tt] = k; prefix[tt] = 0u;
    }
#pragma unroll
    for (int bit = 31; bit >= 0; --bit)
#pragma unroll
      for (int tt = 0; tt < 8; ++tt) {
        const unsigned cand = prefix[tt] | (1u << bit);
        const unsigned long long mge = __ballot(key[tt] >= cand);
        prefix[tt] = (__popcll(mge) >= 16) ? cand : prefix[tt];
      }
#pragma unroll
    for (int tt = 0; tt < 8; ++tt) {
      const unsigned long long mgt = __ballot(key[tt] > prefix[tt]), meq = __ballot(key[tt] == prefix[tt]);
      const int need = 16 - __popcll(mgt);
      const int rank_eq = __popcll(meq & ((1ull << lane) - 1ull));
      const unsigned long long msk = mgt | __ballot((key[tt] == prefix[tt]) && (rank_eq < need));
      if (lane == 0) selm[hh * 8 + tt] = msk;
      worm |= msk;
    }
    if (lane == 0) atomicOr((unsigned long long*)orm, worm);
  }
  if (gt == 0) *(LAS int*)(lds + A_NXT + 16 * grp) = popv;
  group_sync(cnt, tgt, lane);
  nenc = *(const LAS int*)(lds + A_NXT + 16 * grp);
  const unsigned long long mymask = selm[q];
  const unsigned long long ormask = *orm;
  const unsigned long long causal = (jt >= 63) ? ~0ull : ((2ull << jt) - 1ull);
  const int jlo = jt >= 8 ? jt - 8 : 0;
  {
    float m_run = 0.f, l_run = 0.f;
    attn_branch<2>(gl, cnt, tgt, Ksel, Vsel, ormask & causal, qf, slope2, tq, jt, mymask, m_run, l_run, 0.f, O, slab);
    const float lt = l_run + __shfl_xor(l_run, 32);
    const float sc = lt > 0.f ? g_sel / lt : 0.f;
#pragma unroll
    for (int db = 0; db < 2; ++db)
#pragma unroll
      for (int gi = 0; gi < 4; ++gi) {
        const f32x4 pv = *(const f32x4*)(osc + 32 * db + 8 * gi);
        *(f32x4*)(osc + 32 * db + 8 * gi) = pv + (f32x4){O[db][4 * gi], O[db][4 * gi + 1], O[db][4 * gi + 2], O[db][4 * gi + 3]} * sc;
        O[db][4 * gi] = 0.f; O[db][4 * gi + 1] = 0.f; O[db][4 * gi + 2] = 0.f; O[db][4 * gi + 3] = 0.f;
      }
  }
  {
    const unsigned long long wm = causal & ~((1ull << jlo) - 1ull);
    float m_run = 0.f, l_run = 0.f;
    attn_branch<3>(gl, cnt, tgt, Kwin, Vwin, wm, qf, slope2, tq, jt, 0ull, m_run, l_run, 0.f, O, slab);
    const float lt = l_run + __shfl_xor(l_run, 32);
    const float sc = lt > 0.f ? g_win / lt : 0.f;
#pragma unroll
    for (int db = 0; db < 2; ++db)
#pragma unroll
      for (int gi = 0; gi < 4; ++gi) {
        const f32x4 v = *(const f32x4*)(osc + 32 * db + 8 * gi) + (f32x4){O[db][4 * gi], O[db][4 * gi + 1], O[db][4 * gi + 2], O[db][4 * gi + 3]} * sc;
        u32x2 w; w.x = pk2(v[0], v[1]); w.y = pk2(v[2], v[3]);
        *(u32x2*)(cat + mrow * 1024 + 512 + head * 64 + 32 * db + 8 * gi + 4 * h) = w;
      }
  }
}

__global__ void __launch_bounds__(512, 2) fwd_megakernel(Params p) {
  extern __shared__ __attribute__((aligned(16))) unsigned char smem[];
  LAS unsigned char* lds = (LAS unsigned char*)smem;
  cg::grid_group grid = cg::this_grid();
  const int G = gridDim.x, bx = blockIdx.x;
  unsigned char* ws = p.ws;
  if (p.ws == nullptr) grid.sync();
  volatile LAS unsigned* bst = (volatile LAS unsigned*)(lds + LDS_BYTES - 16);
  if (threadIdx.x == 0) { bst[0] = 0u; bst[1] = 0u; }
  __syncthreads();
  const XcdBarrier gbar = xcd_barrier_post((unsigned*)(ws + OFF_BAR), bst);

  p0_prologue(p, lds);
  xcd_barrier(gbar);

  {
    pg8::Gemm g{(const bf16_t*)(ws + OFF_XB), (const bf16_t*)(ws + OFF_WIN), 1024, 1024, 1024, (size_t)256 * 1024 * 2, (size_t)256 * 1024 * 2};
    pg8::StaticOrder S; S.init(MTOK, 2560, G, bx);
    Epi1 E{(const float*)(ws + OFF_RS1), (bf16_t*)(ws + OFF_B), (bf16_t*)(ws + OFF_Q), (bf16_t*)(ws + OFF_KV), (float*)(ws + OFF_GATES)};
    pg8::gemm_phase<Epi1, pg8::StaticOrder, true, true>(lds, g, S, E);
  }
  xcd_barrier(gbar);

  {
    const int ncmp = (G > 64) ? 32 : 0;
    if (bx < ncmp) {
      const int kv = bx >> 4, pm = bx & 15;
      pg8::Gemm g{(const bf16_t*)(ws + OFF_KV) + (size_t)kv * 16 * 4096 * 64, (const bf16_t*)(ws + OFF_CW1) + (size_t)kv * 256 * 2048, 1024, 2048, 2048, (size_t)4096 * 64 * 2, 0};
      pg8::SingleUnit S{pm, 0};
      EpiCmp E{(const float*)(ws + OFF_CB1) + kv * 256, (const bf16_t*)(ws + OFF_CW2) + kv * 64 * 256, (bf16_t*)(ws + (kv ? OFF_VC : OFF_KC))};
      pg8::gemm_phase<EpiCmp, pg8::SingleUnit, false, true>(lds, g, S, E);
    } else {
      conv_load_taps(p, lds);
      for (int tile = bx - ncmp; tile < 1024; tile += G - ncmp) conv_tile(p, lds, tile);
    }
    if (ncmp == 0) {
      for (int un = bx; un < 32; un += G) {
        const int kv = un >> 4, pm = un & 15;
        pg8::Gemm g{(const bf16_t*)(ws + OFF_KV) + (size_t)kv * 16 * 4096 * 64, (const bf16_t*)(ws + OFF_CW1) + (size_t)kv * 256 * 2048, 1024, 2048, 2048, (size_t)4096 * 64 * 2, 0};
        pg8::SingleUnit S{pm, 0};
        EpiCmp E{(const float*)(ws + OFF_CB1) + kv * 256, (const bf16_t*)(ws + OFF_CW2) + kv * 64 * 256, (bf16_t*)(ws + (kv ? OFF_VC : OFF_KC))};
        pg8::gemm_phase<EpiCmp, pg8::SingleUnit, false, true>(lds, g, S, E);
      }
    }
  }
  xcd_barrier(gbar);

  {
    const int tid3 = get_tid(), grp = __builtin_amdgcn_readfirstlane(tid3 >> 8);
    if (tid3 < 2) *(LAS unsigned*)(lds + A_CNT + 16 * tid3) = 0u;
    __syncthreads();
    unsigned tgt = 0u;
    const int gt3 = tid3 & 255, lane3 = tid3 & 63;
    const unsigned xcc = xb_xcc_id();
    LAS unsigned* cnt3 = (LAS unsigned*)(lds + A_CNT + 16 * grp);
    if (gt3 == 0) *(LAS int*)(lds + A_NXT + 16 * grp) = queue_pop((unsigned*)(ws + OFF_QCNT), xcc);
    group_sync(cnt3, tgt, lane3);
    int enc = *(const LAS int*)(lds + A_NXT + 16 * grp);
    group_sync(cnt3, tgt, lane3);
    while (enc >= 0) { int nenc = -1; attn_item(p, lds, grp, tgt, enc, nenc, xcc); enc = nenc; }
  }
  xcd_barrier(gbar);

  {
    pg8::Gemm g{(const bf16_t*)(ws + OFF_CAT), (const bf16_t*)(ws + OFF_WOUT), 1024, 1024, 1024, (size_t)256 * 1024 * 2, (size_t)256 * 1024 * 2};
    pg8::StaticOrder S; S.init(MTOK, 1024, G, bx);
    EpiRes<false, true> E{(const bf16_t*)(ws + OFF_XB), p.out, (bf16_t*)(ws + OFF_B), (float*)(ws + OFF_SSQ2)};
    pg8::gemm_phase<EpiRes<false, true>, pg8::StaticOrder, true, true>(lds, g, S, E);
  }
  xcd_barrier(gbar);

  {
    pg8::Gemm g{(const bf16_t*)(ws + OFF_B), (const bf16_t*)(ws + OFF_WFF1), 1024, 1024, 1024, (size_t)256 * 1024 * 2, (size_t)256 * 1024 * 2};
    pg8::StaticOrder S; S.init(MTOK, 4096, G, bx);
    EpiFF1 E{(const float*)(ws + OFF_SSQ2), (bf16_t*)(ws + OFF_H)};
    pg8::gemm_phase<EpiFF1, pg8::StaticOrder, false, true>(lds, g, S, E);
  }
  xcd_barrier(gbar);

  const int fuse_final = (G == 256) ? 1 : 0;
  {
    pg8::Gemm g{(const bf16_t*)(ws + OFF_H), (const bf16_t*)(ws + OFF_WFF2P), HIDP, HIDP, 4096, (size_t)256 * HIDP * 2, (size_t)256 * HIDP * 2};
    pg8::StaticOrder S; S.init(MTOK, 1024, G, bx);
    EpiFinal E{(const bf16_t*)(ws + OFF_B), p.out, (float*)(ws + OFF_SSQ3), (unsigned*)(ws + OFF_PCNT), p.norm_f_g, fuse_final};
    pg8::gemm_phase<EpiFinal, pg8::StaticOrder, true, true>(lds, g, S, E);
  }
  if (!fuse_final) {
    xcd_barrier(gbar);
    const int tid = get_tid(), lane = tid & 63, wid = tid >> 6;
    const float* ssq = (const float*)(ws + OFF_SSQ3);
    f32x4 gn[4];
#pragma unroll
    for (int i = 0; i < 4; ++i) gn[i] = *(const f32x4*)(p.norm_f_g + (lane + 64 * i) * 4);
    for (int r = bx * 8 + wid; r < MTOK; r += G * 8) {
      const float s = __builtin_amdgcn_rsqf(ssq[r] * (1.0f / 1024.0f) + EPSN);
      float* row = p.out + (size_t)r * 1024;
#pragma unroll
      for (int i = 0; i < 4; ++i) { f32x4 v = *(const f32x4*)(row + (lane + 64 * i) * 4); v = v * s * gn[i]; *(f32x4*)(row + (lane + 64 * i) * 4) = v; }
    }
  }
}

extern "C" void kernel_launch(void* const* d_in, const int* in_sizes, int n_in, void* d_out, int out_size, void* d_ws, size_t ws_size, hipStream_t stream) {
  constexpr size_t kDynLds = LDS_BYTES;
  static int grid_blocks = 0;
  if (!grid_blocks) {
    int dev = 0, cus = 0, per_cu = 0;
    (void)hipGetDevice(&dev);
    (void)hipDeviceGetAttribute(&cus, hipDeviceAttributeMultiprocessorCount, dev);
    (void)hipFuncSetAttribute((const void*)fwd_megakernel, hipFuncAttributeMaxDynamicSharedMemorySize, (int)kDynLds);
    (void)hipOccupancyMaxActiveBlocksPerMultiprocessor(&per_cu, (const void*)fwd_megakernel, 512, kDynLds);
    if (per_cu < 1) fprintf(stderr, "kernel_launch: occupancy query says %d blocks per CU\n", per_cu);
    grid_blocks = cus > 0 ? cus : 256;
    if (ws_size < WS_END) fprintf(stderr, "kernel_launch: workspace too small: %zu < %zu\n", ws_size, (size_t)WS_END);
  }
  (void)hipMemsetAsync((unsigned char*)d_ws + OFF_BAR, 0, XCD_BAR_WORDS * 4 + 256 * 256 + 8 * 256, stream);
  Params p{};
  p.x = (const float*)d_in[0]; p.norm1_g = (const float*)d_in[1]; p.w_in = (const float*)d_in[2]; p.dw_w = (const float*)d_in[3]; p.dw_b = (const float*)d_in[4];
  p.cln_g = (const float*)d_in[5]; p.cln_b = (const float*)d_in[6]; p.ck_pe = (const float*)d_in[7]; p.ck_w1 = (const float*)d_in[8]; p.ck_w2 = (const float*)d_in[9];
  p.cv_pe = (const float*)d_in[10]; p.cv_w1 = (const float*)d_in[11]; p.cv_w2 = (const float*)d_in[12]; p.w_out = (const float*)d_in[13]; p.norm2_g = (const float*)d_in[14];
  p.w_ff1 = (const float*)d_in[15]; p.w_ff2 = (const float*)d_in[16]; p.norm_f_g = (const float*)d_in[17];
  p.out = (float*)d_out; p.ws = (unsigned char*)d_ws;
  void* args[] = {&p};
  hipError_t e = hipLaunchCooperativeKernel((const void*)fwd_megakernel, dim3(grid_blocks), dim3(512), args, kDynLds, stream);
  if (e != hipSuccess) fprintf(stderr, "cooperative launch failed: %s (grid %d)\n", hipGetErrorString(e), grid_blocks);
}
```

```cpp
#include <hip/hip_runtime.h>
#include <hip/hip_cooperative_groups.h>
#include <cstdio>
namespace cg = cooperative_groups;

#define LAS __attribute__((address_space(3)))
#define DI __device__ __forceinline__
typedef unsigned short bf16_t;
typedef short bf16x8 __attribute__((ext_vector_type(8)));
typedef short s16x4 __attribute__((ext_vector_type(4)));
typedef float f32x4 __attribute__((ext_vector_type(4)));
typedef float f32x2 __attribute__((ext_vector_type(2)));
typedef float f32x16 __attribute__((ext_vector_type(16)));
typedef unsigned u32x4 __attribute__((ext_vector_type(4)));
typedef unsigned u32x2 __attribute__((ext_vector_type(2)));
typedef __bf16 bf16v2 __attribute__((ext_vector_type(2)));

constexpr float LOG2E = 1.4426950408889634f;
constexpr float EPSN = 1e-6f;
constexpr int LDS_BYTES = 147456;
constexpr int MTOK = 32768, TSEQ = 4096, DM = 1024, DFF = 4096;
constexpr float QSCALE = 0.125f * LOG2E;

constexpr size_t MiB = 1024 * 1024;
constexpr size_t XCD_BAR_WORDS_C = 3456;
constexpr size_t OFF_WIN = 0;
constexpr size_t OFF_WOUT = OFF_WIN + 2560 * 1024 * 2;
constexpr size_t OFF_WFF1 = OFF_WOUT + 1024 * 1024 * 2;
constexpr size_t OFF_WFF2 = OFF_WFF1 + 4096 * 1024 * 2;
constexpr size_t OFF_CW1 = OFF_WFF2 + 4096 * 1024 * 2;
constexpr size_t OFF_CW2 = OFF_CW1 + 2 * 256 * 2048 * 2;
constexpr size_t OFF_CB1 = OFF_CW2 + 2 * 64 * 256 * 2;
constexpr size_t OFF_RS1 = OFF_CB1 + 2 * 256 * 4;
constexpr size_t OFF_SSQ2 = OFF_RS1 + MTOK * 4;
constexpr size_t OFF_SSQ3 = OFF_SSQ2 + MTOK * 4;
constexpr size_t OFF_GATES = OFF_SSQ3 + MTOK * 4;
constexpr size_t OFF_KC = OFF_GATES + (size_t)MTOK * 24 * 4;
constexpr size_t OFF_VC = OFF_KC + 16 * 256 * 64 * 2;
constexpr size_t OFF_BAR = OFF_VC + 16 * 256 * 64 * 2;
constexpr size_t OFF_PCNT = OFF_BAR + XCD_BAR_WORDS_C * 4;
constexpr size_t OFF_QCNT = OFF_PCNT + 256 * 256;
constexpr size_t OFF_B = 30 * MiB;
constexpr size_t OFF_H = 94 * MiB;
constexpr size_t OFF_XB = OFF_H;
constexpr size_t OFF_Q = OFF_H + 64 * MiB;
constexpr size_t OFF_KV = OFF_H + 96 * MiB;
constexpr size_t OFF_CAT = OFF_H + 256 * MiB;
constexpr int HIDP = 4096 + 64;
constexpr size_t OFF_WFF2P = OFF_CAT + 64 * MiB;
constexpr size_t WS_END = OFF_WFF2P + 9 * MiB;
static_assert(OFF_QCNT + 8 * 256 <= OFF_B, "ws map");

struct Params {
  const float* x; const float* norm1_g; const float* w_in; const float* dw_w; const float* dw_b; const float* cln_g; const float* cln_b;
  const float* ck_pe; const float* ck_w1; const float* ck_w2; const float* cv_pe; const float* cv_w1; const float* cv_w2;
  const float* w_out; const float* norm2_g; const float* w_ff1; const float* w_ff2; const float* norm_f_g;
  float* out; unsigned char* ws;
};

DI unsigned pk2(float a, float b) { f32x2 v = {a, b}; bf16v2 r = __builtin_convertvector(v, bf16v2); return __builtin_bit_cast(unsigned, r); }
DI float bf2f(unsigned short u) { return __uint_as_float((unsigned)u << 16); }
DI float sigmoidf_(float v) { return __builtin_amdgcn_rcpf(1.0f + __builtin_amdgcn_exp2f(-v * LOG2E)); }
DI float gelu_tanh(float v) { const float u = 0.7978845608028654f * (v + 0.044715f * v * v * v); const float e = __builtin_amdgcn_exp2f(2.0f * LOG2E * u); const float th = 1.0f - 2.0f * __builtin_amdgcn_rcpf(e + 1.0f); return 0.5f * v * (1.0f + th); }
DI float wave_sum(float v) { v += __shfl_xor(v, 1); v += __shfl_xor(v, 2); v += __shfl_xor(v, 4); v += __shfl_xor(v, 8); v += __shfl_xor(v, 16); v += __shfl_xor(v, 32); return v; }

DI void st_nt(u32x4* p, u32x4 v) { __builtin_nontemporal_store(v, p); }
DI void st_nt(f32x4* p, f32x4 v) { __builtin_nontemporal_store(v, p); }
DI int get_tid() { int t = threadIdx.x; asm volatile("" : "+v"(t)); return t; }

#define XB_TMO      128
#define XB_XCNT(j)  (256  + 64 * (j))
#define XB_XSUB(j)  (1280 + 64 * (j))
#define XB_XGEN(j)  (2304 + 64 * (j))
#define XB_TOP      3328
#define XB_TOPGEN   3392
#define XCD_BAR_WORDS 3456
#define XB_SPIN_CAP (1u << 22)
DI unsigned xb_ld(unsigned* p) { return __hip_atomic_load(p, __ATOMIC_RELAXED, __HIP_MEMORY_SCOPE_AGENT); }
DI unsigned xb_add(unsigned* p, unsigned v) { return __hip_atomic_fetch_add(p, v, __ATOMIC_RELAXED, __HIP_MEMORY_SCOPE_AGENT); }
DI unsigned xb_xcc_id() { return (unsigned)__builtin_amdgcn_s_getreg((3 << 11) | 20) & 0xFu; }
#define XB_SPIN(cond, bar) do { unsigned _sp = 0; while (cond) { __builtin_amdgcn_s_sleep(1); \
    if ((++_sp & 255u) == 0u) { if (xb_ld(&(bar)[XB_TMO])) break; if (_sp > XB_SPIN_CAP) { atomicAdd(&(bar)[XB_TMO], 1u); break; } } } } while (0)
struct XcdBarrier { unsigned* bar; unsigned x; volatile LAS unsigned* st; };
DI XcdBarrier xcd_barrier_post(unsigned* bar, volatile LAS unsigned* st) {
  XcdBarrier b; b.bar = bar; b.x = xb_xcc_id(); b.st = st;
  if (threadIdx.x == 0) (void)xb_add(&bar[XB_XCNT(b.x)], 1u);
  return b;
}
DI void xcd_barrier_complete(unsigned* bar, unsigned x, unsigned& nloc, unsigned& nx) {
  const unsigned G = gridDim.x;
  unsigned sum, cnt, mine, sp = 0u;
  for (;;) {
    sum = 0u; cnt = 0u; mine = 0u;
#pragma unroll
    for (unsigned j = 0; j < 16; ++j) { const unsigned c = xb_ld(&bar[XB_XCNT(j)]); sum += c; cnt += (c > 0u) ? 1u : 0u; mine = (j == x) ? c : mine; }
    if (sum == G) break;
    __builtin_amdgcn_s_sleep(1);
    if ((++sp & 255u) == 0u) { if (xb_ld(&bar[XB_TMO])) break; if (sp > XB_SPIN_CAP) { atomicAdd(&bar[XB_TMO], 1u); break; } }
  }
  nloc = mine > 0u ? mine : 1u; nx = cnt > 0u ? cnt : 1u;
}
DI void xcd_barrier(const XcdBarrier& b) {
  asm volatile("s_waitcnt vmcnt(0)" ::: "memory");
  __syncthreads();
  if (threadIdx.x == 0) {
    unsigned* bar = b.bar;
    __builtin_amdgcn_s_waitcnt(0);
    unsigned nloc = b.st[0], nx = b.st[1];
    if (nloc == 0u) { xcd_barrier_complete(bar, b.x, nloc, nx); b.st[0] = nloc; b.st[1] = nx; }
    const unsigned old = xb_add(&bar[XB_XSUB(b.x)], 1u);
    const unsigned gen = old / nloc;
    if (old + 1u == (gen + 1u) * nloc) {
      __builtin_amdgcn_fence(__ATOMIC_RELEASE, "agent");
      asm volatile("s_waitcnt vmcnt(0)" ::: "memory");
      const unsigned og = xb_add(&bar[XB_TOP], 1u);
      const unsigned tg = og / nx;
      if (og + 1u == (tg + 1u) * nx) xb_add(&bar[XB_TOPGEN], 1u);
      else XB_SPIN(xb_ld(&bar[XB_TOPGEN]) == tg, bar);
      __builtin_amdgcn_fence(__ATOMIC_ACQUIRE, "agent");
      xb_add(&bar[XB_XGEN(b.x)], 1u);
      asm volatile("s_waitcnt vmcnt(0)" ::: "memory");
    } else {
      XB_SPIN(xb_ld(&bar[XB_XGEN(b.x)]) == gen, bar);
      __builtin_amdgcn_fence(__ATOMIC_ACQUIRE, "agent");
      asm volatile("s_waitcnt vmcnt(0)" ::: "memory");
    }
  }
  __syncthreads();
}
namespace pg8 {
constexpr int BM = 256, BK = 64, HALF = 128, HTB = HALF * BK * 2, STAGE_BYTES = 8 * HTB, NXCD = 8, WGM = 8;
DI int lds_byte(int r, int c) { const int st = (r >> 4) * 2 + (c >> 5), rr = r & 15, cc = c & 31, ob = rr * 64 + cc * 2; return st * 1024 + (ob ^ (((ob >> 9) & 1) << 5)); }
DI void stage_rc(int b, int& R, int& C) { const int st = b / 1024, sb = b % 1024, swz = sb ^ (((sb >> 9) & 1) << 5); R = (st >> 1) * 16 + swz / 64; C = (st & 1) * 32 + (swz % 64) / 2; }
DI int perm32(int rho) { const int n = rho >> 4, i = rho & 15; return 8 * (i >> 2) + 4 * n + (i & 3); }

struct Unit { int pm, pn; };
struct Gemm { const bf16_t* A; const bf16_t* Bt; int lda, ldb, K; size_t tstepA, tstepB, kstepA, kstepB; };

struct StaticOrder {
  int nM, nN, nwg, G, c;
  DI void init(int M, int N, int G_, int c_) { nM = M / BM; nN = N / BM; nwg = nM * nN; G = G_; c = c_; }
  DI bool next(int i, Unit& u) const {
    const long L = (long)i * G + c; if (L >= nwg) return false;
    int wgid = (int)L; { const int q = nwg / NXCD, r = nwg % NXCD, xcd = wgid % NXCD, off = wgid / NXCD; wgid = (xcd < r ? xcd * (q + 1) : r * (q + 1) + (xcd - r) * q) + off; }
    const int nig = WGM * nN, gid = wgid / nig, fm = gid * WGM, gsz = (nM - fm) < WGM ? (nM - fm) : WGM;
    u.pm = fm + ((wgid % nig) % gsz); u.pn = (wgid % nig) / gsz; return true;
  }
};
struct SingleUnit {
  int pm, pn;
  DI bool next(int i, Unit& u) const { if (i != 0) return false; u.pm = pm; u.pn = pn; return true; }
};

template <class Epi, class Sched, bool ALIGN_EPI = false, bool SP2 = false>
DI void gemm_phase(LAS unsigned char* lds, const Gemm g, const Sched& S, const Epi& E) {
  const int tid = get_tid(), wid = __builtin_amdgcn_readfirstlane(tid >> 6), lane = tid & 63, wr = wid >> 2, wc = wid & 3, fr = lane & 15, fq = lane >> 4;
  const int K = g.K, nt = K / BK;
  unsigned voffA[2], voffB[2];
#pragma unroll
  for (int i = 0; i < 2; ++i) { int R, C; stage_rc(tid * 16 + i * 8192, R, C); const int Rb = Epi::PERM ? ((R & ~31) + perm32(R & 31)) : R;
    voffA[i] = (unsigned)(R * g.lda + C) * 2u; voffB[i] = (unsigned)(Rb * g.ldb + C) * 2u; }
  const size_t kstepA = g.kstepA, kstepB = g.kstepB;
  const size_t hstepA = (size_t)HALF * g.lda * 2, hstepB = (size_t)HALF * g.ldb * 2;
  const unsigned ldsw = (unsigned)wid * 1024u;
  const int aoff = lds_byte(wr * 64 + fr, fq * 8), boff = lds_byte(wc * 32 + fr, fq * 8);
#define PG8_SA(b, h) (((b) * 2 + (h)) * HTB)
#define PG8_SB(b, h) ((4 + (b) * 2 + (h)) * HTB)
#define PG8_STAGE(bufoff, gbase, voff) do { _Pragma("unroll") for (int _i = 0; _i < 2; ++_i) \
    __builtin_amdgcn_global_load_lds((const unsigned*)((const char*)(gbase) + (voff)[_i]), (LAS unsigned*)(lds + (bufoff) + ldsw + _i * 8192), 16, 0, 0); } while (0)
#define PG8_LDA(dst, b, h) do { _Pragma("unroll") for (int m = 0; m < 4; ++m) _Pragma("unroll") for (int k = 0; k < 2; ++k) dst[m][k] = *(const LAS bf16x8*)(lds + PG8_SA(b, h) + aoff + m * 2048 + k * 1024); } while (0)
#define PG8_LDB(dst, b, h) do { _Pragma("unroll") for (int n = 0; n < 2; ++n) _Pragma("unroll") for (int k = 0; k < 2; ++k) dst[n][k] = *(const LAS bf16x8*)(lds + PG8_SB(b, h) + boff + n * 2048 + k * 1024); } while (0)
#define PG8_MMA(ai, bj, At, Bt) do { __builtin_amdgcn_s_setprio(1); _Pragma("unroll") for (int m = 0; m < 4; ++m) _Pragma("unroll") for (int n = 0; n < 2; ++n) _Pragma("unroll") for (int k = 0; k < 2; ++k) \
    acc[ai][bj][m][n] = __builtin_amdgcn_mfma_f32_16x16x32_bf16(Bt[n][k], At[m][k], acc[ai][bj][m][n], 0, 0, 0); __builtin_amdgcn_s_setprio(0); } while (0)
#define PG8_WAIT_V(n) asm volatile("s_waitcnt vmcnt(" #n ")" ::: "memory")
#define PG8_WAIT_L(n) asm volatile("s_waitcnt lgkmcnt(" #n ")" ::: "memory")
#define PG8_BAR __builtin_amdgcn_s_barrier()
#define PG8_SCHED __builtin_amdgcn_sched_barrier(0)
  Unit cur, nxt; int ui = 0;
  if (!S.next(0, cur)) return;
  f32x4 acc[2][2][4][2];
#pragma unroll
  for (int a = 0; a < 2; ++a)
#pragma unroll
    for (int b = 0; b < 2; ++b)
#pragma unroll
      for (int m = 0; m < 4; ++m)
#pragma unroll
        for (int n = 0; n < 2; ++n) acc[a][b][m][n] = (f32x4){0.f, 0.f, 0.f, 0.f};
  bf16x8 At[4][2], B0[2][2], B1[2][2];
  const char* cA = (const char*)g.A + (size_t)cur.pm * g.tstepA; const char* cB = (const char*)g.Bt + (size_t)cur.pn * g.tstepB;
  if constexpr (SP2) {
    PG8_STAGE(PG8_SB(0, 0), cB, voffB); PG8_STAGE(PG8_SB(0, 1), cB + hstepB, voffB); PG8_STAGE(PG8_SA(0, 0), cA, voffA); PG8_STAGE(PG8_SA(0, 1), cA + hstepA, voffA);
    if (wr == 1) PG8_BAR;
    PG8_WAIT_V(2); PG8_BAR;
    PG8_STAGE(PG8_SB(1, 0), cB + kstepB, voffB); PG8_STAGE(PG8_SA(1, 0), cA + kstepA, voffA); PG8_STAGE(PG8_SB(1, 1), cB + hstepB + kstepB, voffB);
    PG8_WAIT_V(6); PG8_BAR;
  } else {
    PG8_STAGE(PG8_SB(0, 0), cB, voffB); PG8_STAGE(PG8_SA(0, 0), cA, voffA); PG8_STAGE(PG8_SB(0, 1), cB + hstepB, voffB); PG8_STAGE(PG8_SA(0, 1), cA + hstepA, voffA);
    if (wr == 1) PG8_BAR;
    PG8_WAIT_V(4); PG8_BAR;
    PG8_STAGE(PG8_SB(1, 0), cB + kstepB, voffB); PG8_STAGE(PG8_SA(1, 0), cA + kstepA, voffA); PG8_STAGE(PG8_SB(1, 1), cB + hstepB + kstepB, voffB);
    PG8_WAIT_V(6); PG8_BAR;
  }
  for (;;) {
    const bool has_next = S.next(ui + 1, nxt);
    const char* nA = has_next ? (const char*)g.A + (size_t)nxt.pm * g.tstepA : cA; const char* nB = has_next ? (const char*)g.Bt + (size_t)nxt.pn * g.tstepB : cB;
    for (int t = 0; t < nt; t += 2) {
      const bool last = (t == nt - 2);
      const char* a1 = cA + (size_t)(t + 1) * kstepA;
      const char* a2 = last ? nA : cA + (size_t)(t + 2) * kstepA; const char* b2 = last ? nB : cB + (size_t)(t + 2) * kstepB;
      const char* a3 = a2 + kstepA; const char* b3 = b2 + kstepB;
      if constexpr (SP2) {
        PG8_LDB(B0, 0, 0); PG8_LDB(B1, 0, 1); PG8_SCHED; PG8_LDA(At, 0, 0); PG8_STAGE(PG8_SA(1, 1), a1 + hstepA, voffA);
        PG8_WAIT_V(8); PG8_WAIT_L(0); PG8_BAR; PG8_MMA(0, 0, At, B0); PG8_MMA(0, 1, At, B1); PG8_BAR; PG8_SCHED;
        PG8_LDA(At, 0, 1); PG8_STAGE(PG8_SB(0, 0), b2, voffB); PG8_STAGE(PG8_SB(0, 1), b2 + hstepB, voffB); PG8_STAGE(PG8_SA(0, 0), a2, voffA);
        PG8_WAIT_V(8); PG8_WAIT_L(0); PG8_BAR; PG8_MMA(1, 0, At, B0); PG8_MMA(1, 1, At, B1); PG8_BAR; PG8_SCHED;
        PG8_LDB(B0, 1, 0); PG8_LDB(B1, 1, 1); PG8_SCHED; PG8_LDA(At, 1, 0); PG8_STAGE(PG8_SA(0, 1), a2 + hstepA, voffA);
        PG8_WAIT_V(8); PG8_WAIT_L(0); PG8_BAR; PG8_MMA(0, 0, At, B0); PG8_MMA(0, 1, At, B1); PG8_BAR; PG8_SCHED;
        PG8_LDA(At, 1, 1); PG8_STAGE(PG8_SB(1, 0), b3, voffB); PG8_STAGE(PG8_SB(1, 1), b3 + hstepB, voffB); PG8_STAGE(PG8_SA(1, 0), a3, voffA);
        PG8_WAIT_V(8); PG8_WAIT_L(0); PG8_BAR; PG8_MMA(1, 0, At, B0); PG8_MMA(1, 1, At, B1); PG8_BAR; PG8_SCHED;
      } else {
        PG8_LDB(B0, 0, 0); PG8_SCHED; PG8_LDA(At, 0, 0); PG8_STAGE(PG8_SA(1, 1), a1 + hstepA, voffA);
        PG8_WAIT_L(8); PG8_BAR; PG8_WAIT_L(0); PG8_MMA(0, 0, At, B0); PG8_BAR; PG8_SCHED;
        PG8_LDB(B1, 0, 1); PG8_STAGE(PG8_SB(0, 0), b2, voffB);
        PG8_BAR; PG8_WAIT_L(0); PG8_MMA(0, 1, At, B1); PG8_BAR;
        PG8_LDA(At, 0, 1); PG8_STAGE(PG8_SA(0, 0), a2, voffA);
        PG8_BAR; PG8_WAIT_L(0); PG8_MMA(1, 0, At, B0); PG8_BAR; PG8_SCHED;
        PG8_STAGE(PG8_SB(0, 1), b2 + hstepB, voffB);
        PG8_WAIT_V(6); PG8_BAR; PG8_MMA(1, 1, At, B1); PG8_BAR;
        PG8_LDB(B0, 1, 0); PG8_SCHED; PG8_LDA(At, 1, 0); PG8_STAGE(PG8_SA(0, 1), a2 + hstepA, voffA);
        PG8_WAIT_L(8); PG8_BAR; PG8_WAIT_L(0); PG8_MMA(0, 0, At, B0); PG8_BAR; PG8_SCHED;
        PG8_LDB(B1, 1, 1); PG8_STAGE(PG8_SB(1, 0), b3, voffB);
        PG8_BAR; PG8_WAIT_L(0); PG8_MMA(0, 1, At, B1); PG8_BAR;
        PG8_LDA(At, 1, 1); PG8_STAGE(PG8_SA(1, 0), a3, voffA);
        PG8_BAR; PG8_WAIT_L(0); PG8_MMA(1, 0, At, B0); PG8_BAR; PG8_SCHED;
        PG8_STAGE(PG8_SB(1, 1), b3 + hstepB, voffB);
        PG8_WAIT_V(6); PG8_BAR; PG8_MMA(1, 1, At, B1); PG8_BAR;
      }
    }
    if constexpr (ALIGN_EPI) { if (wr == 0) PG8_BAR; }
    if constexpr (!Epi::AFTER_DRAIN) { E(acc, cur, wr, wc, fr, fq); }
    if (!has_next) break;
#pragma unroll
    for (int a = 0; a < 2; ++a)
#pragma unroll
      for (int b = 0; b < 2; ++b)
#pragma unroll
        for (int m = 0; m < 4; ++m)
#pragma unroll
          for (int n = 0; n < 2; ++n) acc[a][b][m][n] = (f32x4){0.f, 0.f, 0.f, 0.f};
    cur = nxt; cA = nA; cB = nB; ++ui;
    if constexpr (ALIGN_EPI) { if (wr == 1) PG8_BAR; }
  }
  PG8_WAIT_V(0);
  if constexpr (!ALIGN_EPI) { if (wr == 0) PG8_BAR; }
  PG8_BAR;
  if constexpr (Epi::AFTER_DRAIN) { E.fused(acc, cur, wr, wc, fr, fq, lds, wid, lane); }
#undef PG8_SA
#undef PG8_SB
#undef PG8_STAGE
#undef PG8_LDA
#undef PG8_LDB
#undef PG8_MMA
#undef PG8_WAIT_V
#undef PG8_WAIT_L
#undef PG8_BAR
#undef PG8_SCHED
}
}

struct Epi1 {
  static constexpr bool PERM = true, AFTER_DRAIN = false;
  const float* rs; bf16_t* uv; bf16_t* q; bf16_t* kv; float* gates;
  DI void operator()(const f32x4 (&acc)[2][2][4][2], const pg8::Unit& u, int wr, int wc, int fr, int fq) const {
    const int pn = u.pn;
#pragma unroll
    for (int ai = 0; ai < 2; ++ai)
#pragma unroll
      for (int m = 0; m < 4; ++m) {
        const int r = u.pm * 256 + ai * 128 + wr * 64 + m * 16 + fr;
        const float s = rs[r];
#pragma unroll
        for (int bj = 0; bj < 2; ++bj) {
          const int cl = bj * 128 + wc * 32 + 8 * fq;
          f32x4 v0 = acc[ai][bj][m][0] * s, v1 = acc[ai][bj][m][1] * s;
          if (pn < 4) {
            u32x4 w; w.x = pk2(v0[0], v0[1]); w.y = pk2(v0[2], v0[3]); w.z = pk2(v1[0], v1[1]); w.w = pk2(v1[2], v1[3]);
            *(u32x4*)(uv + (size_t)r * 1024 + pn * 256 + cl) = w;
          } else if (pn < 6) {
            v0 = v0 * QSCALE; v1 = v1 * QSCALE;
            u32x4 w; w.x = pk2(v0[0], v0[1]); w.y = pk2(v0[2], v0[3]); w.z = pk2(v1[0], v1[1]); w.w = pk2(v1[2], v1[3]);
            *(u32x4*)(q + (size_t)r * 512 + (pn - 4) * 256 + cl) = w;
          } else if (pn < 9) {
            const int kvidx = (pn - 6) * 256 + cl, br = kvidx >> 7, gg = (kvidx >> 6) & 1, d = kvidx & 63, b = r >> 12, t = r & 4095;
            u32x4 w; w.x = pk2(v0[0], v0[1]); w.y = pk2(v0[2], v0[3]); w.z = pk2(v1[0], v1[1]); w.w = pk2(v1[2], v1[3]);
            *(u32x4*)(kv + ((size_t)(((br * 8 + b) * 2 + gg) * 4096 + t)) * 64 + d) = w;
          } else {
            if (cl < 24) {
              f32x4 g0, g1;
#pragma unroll
              for (int j = 0; j < 4; ++j) { g0[j] = sigmoidf_(v0[j]); g1[j] = sigmoidf_(v1[j]); }
              *(f32x4*)(gates + (size_t)r * 24 + cl) = g0; *(f32x4*)(gates + (size_t)r * 24 + cl + 4) = g1;
            }
          }
        }
      }
  }
};
template <bool WRITE_IO, bool WRITE_B> struct EpiRes {
  static constexpr bool PERM = true, AFTER_DRAIN = false;
  const bf16_t* base; float* io; bf16_t* xb; float* ssq;
  DI void operator()(const f32x4 (&acc)[2][2][4][2], const pg8::Unit& u, int wr, int wc, int fr, int fq) const {
#pragma unroll
    for (int ai = 0; ai < 2; ++ai)
#pragma unroll
      for (int m = 0; m < 4; ++m) {
        const int r = u.pm * 256 + ai * 128 + wr * 64 + m * 16 + fr;
        float ss = 0.f;
#pragma unroll
        for (int bj = 0; bj < 2; ++bj) {
          const size_t off = (size_t)r * 1024 + u.pn * 256 + bj * 128 + wc * 32 + 8 * fq;
          const u32x4 xw = *(const u32x4*)(base + off);
          const f32x4 b0 = (f32x4){__uint_as_float(xw.x << 16), __uint_as_float(xw.x & 0xffff0000u), __uint_as_float(xw.y << 16), __uint_as_float(xw.y & 0xffff0000u)};
          const f32x4 b1 = (f32x4){__uint_as_float(xw.z << 16), __uint_as_float(xw.z & 0xffff0000u), __uint_as_float(xw.w << 16), __uint_as_float(xw.w & 0xffff0000u)};
          const f32x4 v0 = acc[ai][bj][m][0] + b0, v1 = acc[ai][bj][m][1] + b1;
          if (WRITE_IO) { *(f32x4*)(io + off) = v0; *(f32x4*)(io + off + 4) = v1; }
          if (WRITE_B) { u32x4 w; w.x = pk2(v0[0], v0[1]); w.y = pk2(v0[2], v0[3]); w.z = pk2(v1[0], v1[1]); w.w = pk2(v1[2], v1[3]); *(u32x4*)(xb + off) = w; }
          ss += (v0[0] * v0[0] + v0[1] * v0[1]) + (v0[2] * v0[2] + v0[3] * v0[3]) + (v1[0] * v1[0] + v1[1] * v1[1]) + (v1[2] * v1[2] + v1[3] * v1[3]);
        }
        ss += __shfl_xor(ss, 16); ss += __shfl_xor(ss, 32);
        if (fq == 0) atomicAdd(ssq + r, ss);
      }
  }
};
struct EpiFF1 {
  static constexpr bool PERM = true, AFTER_DRAIN = false;
  const float* ssq; bf16_t* hid;
  DI void operator()(const f32x4 (&acc)[2][2][4][2], const pg8::Unit& u, int wr, int wc, int fr, int fq) const {
#pragma unroll
    for (int ai = 0; ai < 2; ++ai)
#pragma unroll
      for (int m = 0; m < 4; ++m) {
        const int r = u.pm * 256 + ai * 128 + wr * 64 + m * 16 + fr;
        const float s = __builtin_amdgcn_rsqf(ssq[r] * (1.0f / 1024.0f) + EPSN);
#pragma unroll
        for (int bj = 0; bj < 2; ++bj) {
          f32x4 v0 = acc[ai][bj][m][0] * s, v1 = acc[ai][bj][m][1] * s;
#pragma unroll
          for (int j = 0; j < 4; ++j) { const float a = fmaxf(v0[j], 0.f), b = fmaxf(v1[j], 0.f); v0[j] = a * a; v1[j] = b * b; }
          u32x4 w; w.x = pk2(v0[0], v0[1]); w.y = pk2(v0[2], v0[3]); w.z = pk2(v1[0], v1[1]); w.w = pk2(v1[2], v1[3]);
          { const int c = u.pn * 256 + bj * 128 + wc * 32 + 8 * fq;
            st_nt((u32x4*)(hid + ((((size_t)u.pm * 64 + (c >> 6)) * 256 + (r & 255)) * 64 + (c & 63))), w); }
        }
      }
  }
};
struct EpiFinal {
  static constexpr bool PERM = true, AFTER_DRAIN = false;
  const bf16_t* xb; float* io; float* ssq; unsigned* cnt; const float* gn; int fuse;
  DI void operator()(f32x4 (&acc)[2][2][4][2], const pg8::Unit& u, int wr, int wc, int fr, int fq) const {
#pragma unroll
    for (int ai = 0; ai < 2; ++ai)
#pragma unroll
      for (int m = 0; m < 4; ++m) {
        const int r = u.pm * 256 + ai * 128 + wr * 64 + m * 16 + fr;
        float ss = 0.f;
#pragma unroll
        for (int bj = 0; bj < 2; ++bj) {
          const size_t off = (size_t)r * 1024 + u.pn * 256 + bj * 128 + wc * 32 + 8 * fq;
          const u32x4 xw = *(const u32x4*)(xb + off);
          const f32x4 b0 = (f32x4){__uint_as_float(xw.x << 16), __uint_as_float(xw.x & 0xffff0000u), __uint_as_float(xw.y << 16), __uint_as_float(xw.y & 0xffff0000u)};
          const f32x4 b1 = (f32x4){__uint_as_float(xw.z << 16), __uint_as_float(xw.z & 0xffff0000u), __uint_as_float(xw.w << 16), __uint_as_float(xw.w & 0xffff0000u)};
          const f32x4 v0 = acc[ai][bj][m][0] + b0, v1 = acc[ai][bj][m][1] + b1;
          acc[ai][bj][m][0] = v0; acc[ai][bj][m][1] = v1;
          if (!fuse) { *(f32x4*)(io + off) = v0; *(f32x4*)(io + off + 4) = v1; }
          ss += (v0[0] * v0[0] + v0[1] * v0[1]) + (v0[2] * v0[2] + v0[3] * v0[3]) + (v1[0] * v1[0] + v1[1] * v1[1]) + (v1[2] * v1[2] + v1[3] * v1[3]);
        }
        ss += __shfl_xor(ss, 16); ss += __shfl_xor(ss, 32);
        if (fq == 0) atomicAdd(ssq + r, ss);
      }
    if (!fuse) return;
    asm volatile("s_waitcnt vmcnt(0)" ::: "memory");
    unsigned* c = cnt + 64 * (u.pm * 2 + wr);
    if (fr == 0 && fq == 0) __hip_atomic_fetch_add(c, 1u, __ATOMIC_RELAXED, __HIP_MEMORY_SCOPE_AGENT);
    { unsigned sp = 0; while ((unsigned)__builtin_amdgcn_readfirstlane(__hip_atomic_load(c, __ATOMIC_RELAXED, __HIP_MEMORY_SCOPE_AGENT)) < 16u) { __builtin_amdgcn_s_sleep(2); if (++sp > (1u << 22)) break; } }
    f32x4 g[2][2];
#pragma unroll
    for (int bj = 0; bj < 2; ++bj)
#pragma unroll
      for (int n = 0; n < 2; ++n) g[bj][n] = *(const f32x4*)(gn + u.pn * 256 + bj * 128 + wc * 32 + 8 * fq + 4 * n);
#pragma unroll
    for (int ai = 0; ai < 2; ++ai)
#pragma unroll
      for (int m = 0; m < 4; ++m) {
        const int r = u.pm * 256 + ai * 128 + wr * 64 + m * 16 + fr;
        const float s = __builtin_amdgcn_rsqf(__hip_atomic_load(ssq + r, __ATOMIC_RELAXED, __HIP_MEMORY_SCOPE_AGENT) * (1.0f / 1024.0f) + EPSN);
#pragma unroll
        for (int bj = 0; bj < 2; ++bj) {
          const size_t off = (size_t)r * 1024 + u.pn * 256 + bj * 128 + wc * 32 + 8 * fq;
          st_nt((f32x4*)(io + off), acc[ai][bj][m][0] * s * g[bj][0]); st_nt((f32x4*)(io + off + 4), acc[ai][bj][m][1] * s * g[bj][1]);
        }
      }
  }
};
constexpr int HSTR = 528;
struct EpiCmp {
  static constexpr bool PERM = false, AFTER_DRAIN = true;
  const float* bias1; const bf16_t* w2t; bf16_t* outp;
  DI void fused(const f32x4 (&acc)[2][2][4][2], const pg8::Unit& u, int wr, int wc, int fr, int fq, LAS unsigned char* lds, int wid, int lane) const {
#pragma unroll
    for (int bj = 0; bj < 2; ++bj)
#pragma unroll
      for (int n = 0; n < 2; ++n) {
        const int c = bj * 128 + wc * 32 + n * 16 + 4 * fq;
        const f32x4 bv = *(const f32x4*)(bias1 + c);
#pragma unroll
        for (int ai = 0; ai < 2; ++ai)
#pragma unroll
          for (int m = 0; m < 4; ++m) {
            const int r = ai * 128 + wr * 64 + m * 16 + fr;
            const f32x4 v = acc[ai][bj][m][n] + bv;
            u32x2 w; w.x = pk2(gelu_tanh(v[0]), gelu_tanh(v[1])); w.y = pk2(gelu_tanh(v[2]), gelu_tanh(v[3]));
            *(LAS u32x2*)(lds + r * HSTR + c * 2) = w;
          }
      }
    __syncthreads();
    f32x4 o[2][4];
#pragma unroll
    for (int mb = 0; mb < 2; ++mb)
#pragma unroll
      for (int nb = 0; nb < 4; ++nb) o[mb][nb] = (f32x4){0.f, 0.f, 0.f, 0.f};
    bf16x8 wf[8][4];
#pragma unroll
    for (int ks = 0; ks < 8; ++ks)
#pragma unroll
      for (int nb = 0; nb < 4; ++nb) wf[ks][nb] = *(const bf16x8*)(w2t + (16 * nb + fr) * 256 + 32 * ks + 8 * fq);
#pragma unroll
    for (int ks = 0; ks < 8; ++ks) {
      bf16x8 hf[2];
#pragma unroll
      for (int mb = 0; mb < 2; ++mb) hf[mb] = *(const LAS bf16x8*)(lds + (32 * wid + 16 * mb + fr) * HSTR + (32 * ks + 8 * fq) * 2);
#pragma unroll
      for (int mb = 0; mb < 2; ++mb)
#pragma unroll
        for (int nb = 0; nb < 4; ++nb) o[mb][nb] = __builtin_amdgcn_mfma_f32_16x16x32_bf16(wf[ks][nb], hf[mb], o[mb][nb], 0, 0, 0);
    }
#pragma unroll
    for (int mb = 0; mb < 2; ++mb)
#pragma unroll
      for (int nb = 0; nb < 4; ++nb) {
        const int row = 32 * wid + 16 * mb + fr;
        u32x2 w; w.x = pk2(o[mb][nb][0], o[mb][nb][1]); w.y = pk2(o[mb][nb][2], o[mb][nb][3]);
        *(u32x2*)(outp + ((size_t)u.pm * 256 + row) * 64 + 16 * nb + 4 * fq) = w;
      }
    __syncthreads();
  }
};

struct TJob { const float* src; bf16_t* dst; const float* g; int K, N, kt, nt, ldd, blk; };
DI TJob transpose_job(const Params& p, int job) {
  unsigned char* ws = p.ws; TJob t;
  if (job < 640) t = TJob{p.w_in, (bf16_t*)(ws + OFF_WIN), p.norm1_g, 1024, 2328, job / 40, job % 40, 1024, 0};
  else if (job < 896) { const int j = job - 640; t = TJob{p.w_out, (bf16_t*)(ws + OFF_WOUT), nullptr, 1024, 1024, j / 16, j % 16, 1024, 0}; }
  else if (job < 1920) { const int j = job - 896; t = TJob{p.w_ff1, (bf16_t*)(ws + OFF_WFF1), p.norm2_g, 1024, 4096, j / 64, j % 64, 1024, 0}; }
  else if (job < 2944) { const int j = job - 1920; t = TJob{p.w_ff2, (bf16_t*)(ws + OFF_WFF2P), nullptr, 4096, 1024, j / 16, j % 16, 4096, 1}; }
  else if (job < 3072) { const int j = job - 2944; t = TJob{p.ck_w1, (bf16_t*)(ws + OFF_CW1), nullptr, 2048, 256, j / 4, j % 4, 2048, 0}; }
  else if (job < 3200) { const int j = job - 3072; t = TJob{p.cv_w1, (bf16_t*)(ws + OFF_CW1) + 256 * 2048, nullptr, 2048, 256, j / 4, j % 4, 2048, 0}; }
  else if (job < 3204) { const int j = job - 3200; t = TJob{p.ck_w2, (bf16_t*)(ws + OFF_CW2), nullptr, 256, 64, j, 0, 256, 0}; }
  else { const int j = job - 3204; t = TJob{p.cv_w2, (bf16_t*)(ws + OFF_CW2) + 64 * 256, nullptr, 256, 64, j, 0, 256, 0}; }
  return t;
}
DI void transpose_pair(const TJob& ta, const TJob& tb, bool has_b, LAS float* tl) {
  const int tid = get_tid();
  f32x4 va[2], vb[2];
#pragma unroll
  for (int i = 0; i < 2; ++i) {
    const int idx = tid + 512 * i, row = idx >> 4, c4 = idx & 15;
    { const int n = ta.nt * 64 + 4 * c4; va[i] = (f32x4){0.f, 0.f, 0.f, 0.f}; if (n < ta.N) va[i] = *(const f32x4*)(ta.src + (size_t)(ta.kt * 64 + row) * ta.N + n); if (ta.g) va[i] = va[i] * ta.g[ta.kt * 64 + row]; }
    vb[i] = (f32x4){0.f, 0.f, 0.f, 0.f};
    if (has_b) { const int n = tb.nt * 64 + 4 * c4; if (n < tb.N) vb[i] = *(const f32x4*)(tb.src + (size_t)(tb.kt * 64 + row) * tb.N + n); if (tb.g) vb[i] = vb[i] * tb.g[tb.kt * 64 + row]; }
  }
#pragma unroll
  for (int i = 0; i < 2; ++i) {
    const int idx = tid + 512 * i, row = idx >> 4, c4 = idx & 15;
#pragma unroll
    for (int e = 0; e < 4; ++e) { tl[row * 65 + 4 * c4 + e] = va[i][e]; tl[4160 + row * 65 + 4 * c4 + e] = vb[i][e]; }
  }
  __syncthreads();
  {
    const int nrow = tid >> 3, kc = tid & 7;
    float e[8];
#pragma unroll
    for (int j = 0; j < 8; ++j) e[j] = tl[(8 * kc + j) * 65 + nrow];
    u32x4 w; w.x = pk2(e[0], e[1]); w.y = pk2(e[2], e[3]); w.z = pk2(e[4], e[5]); w.w = pk2(e[6], e[7]);
    { const int n = ta.nt * 64 + nrow; const size_t di = ta.blk ? ((((size_t)(n >> 8) * (ta.K >> 6) + ta.kt) * 256 + (n & 255)) * 64 + 8 * kc) : ((size_t)n * ta.ldd + ta.kt * 64 + 8 * kc); *(u32x4*)(ta.dst + di) = w; }
    if (has_b) {
#pragma unroll
      for (int j = 0; j < 8; ++j) e[j] = tl[4160 + (8 * kc + j) * 65 + nrow];
      w.x = pk2(e[0], e[1]); w.y = pk2(e[2], e[3]); w.z = pk2(e[4], e[5]); w.w = pk2(e[6], e[7]);
      { const int n = tb.nt * 64 + nrow; const size_t di = tb.blk ? ((((size_t)(n >> 8) * (tb.K >> 6) + tb.kt) * 256 + (n & 255)) * 64 + 8 * kc) : ((size_t)n * tb.ldd + tb.kt * 64 + 8 * kc); *(u32x4*)(tb.dst + di) = w; }
    }
  }
  __syncthreads();
}

DI void p0_prologue(const Params& p, LAS unsigned char* lds) {
  const int tid = get_tid(), lane = tid & 63, wid = tid >> 6, G = gridDim.x, bx = blockIdx.x;
  unsigned char* ws = p.ws;
  {
    bf16_t* xb = (bf16_t*)(ws + OFF_XB); float* rs1 = (float*)(ws + OFF_RS1);
    for (int r0 = (bx * 8 + wid) * 4; r0 < MTOK; r0 += G * 32) {
      f32x4 a[4][2], c[4][2];
#pragma unroll
      for (int rr = 0; rr < 4; ++rr)
#pragma unroll
        for (int i = 0; i < 2; ++i) { const float* s = p.x + (size_t)(r0 + rr) * 1024 + (lane + 64 * i) * 8; a[rr][i] = __builtin_nontemporal_load((const f32x4*)s); c[rr][i] = __builtin_nontemporal_load((const f32x4*)(s + 4)); }
#pragma unroll
      for (int rr = 0; rr < 4; ++rr) {
        float ss = 0.f;
#pragma unroll
        for (int i = 0; i < 2; ++i) {
          const f32x4 av = a[rr][i], bv = c[rr][i];
          ss += (av[0] * av[0] + av[1] * av[1]) + (av[2] * av[2] + av[3] * av[3]) + (bv[0] * bv[0] + bv[1] * bv[1]) + (bv[2] * bv[2] + bv[3] * bv[3]);
          u32x4 w; w.x = pk2(av[0], av[1]); w.y = pk2(av[2], av[3]); w.z = pk2(bv[0], bv[1]); w.w = pk2(bv[2], bv[3]);
          *(u32x4*)(xb + (size_t)(r0 + rr) * 1024 + (lane + 64 * i) * 8) = w;
        }
        ss = wave_sum(ss);
        if (lane == 0) rs1[r0 + rr] = __builtin_amdgcn_rsqf(ss * (1.0f / 1024.0f) + EPSN);
      }
    }
  }
  { float* z = (float*)(ws + OFF_SSQ2); for (int i = bx * 512 + tid; i < 2 * MTOK; i += G * 512) z[i] = 0.f; }
  for (int pair = bx; pair < 256; pair += G) {
    LAS float* red = (LAS float*)lds;
    const int kv = pair >> 7, n = (pair & 127) * 2 + (tid & 1), ksl = tid >> 1;
    const float* pe = kv ? p.cv_pe : p.ck_pe; const float* w1 = kv ? p.cv_w1 : p.ck_w1;
    float s = 0.f;
#pragma unroll
    for (int k = 0; k < 8; ++k) s += pe[ksl * 8 + k] * w1[(size_t)(ksl * 8 + k) * 256 + n];
    s += __shfl_xor(s, 2); s += __shfl_xor(s, 4); s += __shfl_xor(s, 8); s += __shfl_xor(s, 16); s += __shfl_xor(s, 32);
    if (lane < 2) red[wid * 2 + lane] = s;
    __syncthreads();
    if (tid < 2) { float t = 0.f; for (int i = 0; i < 8; ++i) t += red[i * 2 + tid]; ((float*)(ws + OFF_CB1))[kv * 256 + (pair & 127) * 2 + tid] = t; }
    __syncthreads();
  }
  for (int job = bx; job < 3208; job += 2 * G) {
    const bool has_b = (job + G) < 3208;
    const TJob ta = transpose_job(p, job), tb = transpose_job(p, has_b ? job + G : job);
    transpose_pair(ta, tb, has_b, (LAS float*)lds);
  }
}

constexpr int USTR = 1040;
constexpr int YSTR = 516;
constexpr int C_WOFF = 66560;
DI void conv_load_taps(const Params& p, LAS unsigned char* lds) {
  LAS float* Wp = (LAS float*)(lds + C_WOFF);
  for (int idx = get_tid(); idx < 32 * 256; idx += 512) {
    const int w = idx >> 8, cp = idx & 255;
    f32x2 t = (f32x2){0.f, 0.f};
    if (w < 31) t = *(const f32x2*)(p.dw_w + w * 512 + 2 * cp);
    *(LAS f32x2*)(Wp + ((w >> 2) * 256 + cp) * 8 + (w & 3) * 2) = t;
  }
}
DI void conv_tile(const Params& p, LAS unsigned char* lds, int tile) {
  const int tid = get_tid(), lane = tid & 63, wid = tid >> 6;
  const int b = tile >> 7, t0 = (tile & 127) * 32;
  const bf16_t* uv = (const bf16_t*)(p.ws + OFF_B);
  bf16_t* cat = (bf16_t*)(p.ws + OFF_CAT);
  LAS unsigned char* U = lds; LAS float* Y = (LAS float*)lds;
  const LAS float* Wp = (const LAS float*)(lds + C_WOFF);
  {
    u32x4 vv[8], gv[8];
#pragma unroll
    for (int it = 0; it < 8; ++it) {
      const int idx = tid + 512 * it, row = idx >> 6, ch = idx & 63, t = t0 - 30 + row;
      const int tc = t < 0 ? 0 : (row < 62 ? t : t0);
      const size_t m = (size_t)b * 4096 + tc;
      vv[it] = *(const u32x4*)(uv + m * 1024 + ch * 8); gv[it] = *(const u32x4*)(uv + m * 1024 + 512 + ch * 8);
    }
#pragma unroll
    for (int it = 0; it < 8; ++it) {
      const int idx = tid + 512 * it, row = idx >> 6, ch = idx & 63, t = t0 - 30 + row;
      u32x4 w = (u32x4){0u, 0u, 0u, 0u};
      if (t >= 0 && row < 62) {
#pragma unroll
        for (int j = 0; j < 4; ++j) {
          const float v0 = __uint_as_float(vv[it][j] << 16), v1 = __uint_as_float(vv[it][j] & 0xffff0000u), g0 = __uint_as_float(gv[it][j] << 16), g1 = __uint_as_float(gv[it][j] & 0xffff0000u);
          w[j] = pk2(v0 * sigmoidf_(g0), v1 * sigmoidf_(g1));
        }
      }
      if (row < 63) *(LAS u32x4*)(U + row * USTR + ch * 16) = w;
    }
  }
  __syncthreads();
  const int half = tid >> 8, cp = tid & 255;
  float a0[16], a1[16];
  {
    const f32x2 bias = *(const f32x2*)(p.dw_b + 2 * cp);
#pragma unroll
    for (int o = 0; o < 16; ++o) { a0[o] = bias.x; a1[o] = bias.y; }
#pragma unroll
    for (int og = 0; og < 2; ++og) {
      const LAS unsigned char* ub = U + (half * 16 + og * 8) * USTR + cp * 4;
#pragma unroll 1
      for (int w4 = 0; w4 < 8; ++w4) {
        const f32x4 wa = *(const LAS f32x4*)(Wp + (w4 * 256 + cp) * 8), wb = *(const LAS f32x4*)(Wp + (w4 * 256 + cp) * 8 + 4);
        const float wt0[4] = {wa[0], wa[2], wb[0], wb[2]}, wt1[4] = {wa[1], wa[3], wb[1], wb[3]};
        float u0[11], u1[11];
#pragma unroll
        for (int r = 0; r < 11; ++r) { const unsigned uu = *(const LAS unsigned*)(ub + (w4 * 4 + r) * USTR); u0[r] = __uint_as_float(uu << 16); u1[r] = __uint_as_float(uu & 0xffff0000u); }
#pragma unroll
        for (int o = 0; o < 8; ++o)
#pragma unroll
          for (int k = 0; k < 4; ++k) { a0[og * 8 + o] += u0[o + k] * wt0[k]; a1[og * 8 + o] += u1[o + k] * wt1[k]; }
      }
    }
  }
  __syncthreads();
#pragma unroll
  for (int o = 0; o < 16; ++o) *(LAS f32x2*)(Y + (half * 16 + o) * YSTR + 2 * cp) = (f32x2){a0[o], a1[o]};
  __syncthreads();
  {
    const f32x4 g0 = *(const f32x4*)(p.cln_g + lane * 8), g1 = *(const f32x4*)(p.cln_g + lane * 8 + 4), b0 = *(const f32x4*)(p.cln_b + lane * 8), b1 = *(const f32x4*)(p.cln_b + lane * 8 + 4);
#pragma unroll
    for (int i = 0; i < 4; ++i) {
      const int tok = wid * 4 + i;
      const f32x4 y0 = *(const LAS f32x4*)(Y + tok * YSTR + lane * 8), y1 = *(const LAS f32x4*)(Y + tok * YSTR + lane * 8 + 4);
      float s = (y0[0] + y0[1]) + (y0[2] + y0[3]) + (y1[0] + y1[1]) + (y1[2] + y1[3]);
      s = wave_sum(s);
      const float mu = s * (1.0f / 512.0f);
      const f32x4 d0 = y0 - mu, d1 = y1 - mu;
      float q = (d0[0] * d0[0] + d0[1] * d0[1]) + (d0[2] * d0[2] + d0[3] * d0[3]) + (d1[0] * d1[0] + d1[1] * d1[1]) + (d1[2] * d1[2] + d1[3] * d1[3]);
      q = wave_sum(q);
      const float rstd = __builtin_amdgcn_rsqf(q * (1.0f / 512.0f) + EPSN);
      f32x4 o0 = d0 * rstd * g0 + b0, o1 = d1 * rstd * g1 + b1;
#pragma unroll
      for (int j = 0; j < 4; ++j) { o0[j] = o0[j] * sigmoidf_(o0[j]); o1[j] = o1[j] * sigmoidf_(o1[j]); }
      u32x4 w; w.x = pk2(o0[0], o0[1]); w.y = pk2(o0[2], o0[3]); w.z = pk2(o1[0], o1[1]); w.w = pk2(o1[2], o1[3]);
      *(u32x4*)(cat + ((size_t)b * 4096 + t0 + tok) * 1024 + lane * 8) = w;
    }
  }
  __syncthreads();
}

constexpr int KVSTR = 144;
constexpr int VSTR = 144;
constexpr int A_GRP = 4 * 64 * KVSTR;
constexpr int A_KOFF = 0, A_VOFF = 2 * 64 * KVSTR;
constexpr int A_SLAB = 2 * A_GRP;
constexpr int SLAB_FLOATS = 32 * 65;
constexpr int A_SEL = A_SLAB + 8 * SLAB_FLOATS * 4;
constexpr int A_OR = A_SEL + 512;
constexpr int A_CNT = A_OR + 16;
constexpr int A_NXT = A_CNT + 32;
constexpr int A_LINV = A_NXT + 32;
static_assert(A_LINV + 1024 <= LDS_BYTES - 16, "attention LDS map");

DI void group_sync(LAS unsigned* cnt, unsigned& tgt, int lane) {
  tgt += 4u;
  __builtin_amdgcn_fence(__ATOMIC_RELEASE, "workgroup");
  if (lane == 0) __hip_atomic_fetch_add(cnt, 1u, __ATOMIC_RELAXED, __HIP_MEMORY_SCOPE_WORKGROUP);
  while ((int)(__hip_atomic_load(cnt, __ATOMIC_RELAXED, __HIP_MEMORY_SCOPE_WORKGROUP) - tgt) < 0) __builtin_amdgcn_s_sleep(0);
  __builtin_amdgcn_fence(__ATOMIC_ACQUIRE, "workgroup");
}

constexpr float ATT_THR = 8.0f;
template <int KIND, bool MASKED>
DI void attn_scores(LAS unsigned char* kbuf, int jc, const bf16x8 (&qf)[4], float slope2, float sc, int tq, int jt, unsigned long long mymask, float mref, f32x16 (&S)[2], int q, int h) {
  float base2; int kmin = -1, kmax = 64;
  if (KIND <= 1) {
    const int lim = 64 * jt + tq - 31 - 1024 * jc - 64 * h;
    base2 = -slope2 * (float)lim - mref; kmax = lim >> 4;
  } else {
    base2 = slope2 * (float)(64 * (jc - jt) + 4 * h - tq) - mref;
    if (MASKED && jc == jt) kmax = tq - 4 * h;
    if (MASKED && KIND == 3 && jc == jt - 8) kmin = tq - 4 * h;
    if (KIND == 2) base2 = ((mymask >> jc) & 1ull) ? base2 : -1e30f;
  }
#pragma unroll
  for (int kb = 0; kb < 2; ++kb) {
#pragma unroll
    for (int i = 0; i < 16; ++i) S[kb][i] = __builtin_fmaf(sc, (float)(32 * kb + 8 * (i >> 2) + (i & 3)), base2);
#pragma unroll
    for (int ks = 0; ks < 4; ++ks) {
      const bf16x8 kf = *(const LAS bf16x8*)(kbuf + (32 * kb + q) * KVSTR + 32 * ks + 16 * h);
      S[kb] = __builtin_amdgcn_mfma_f32_32x32x16_bf16(kf, qf[ks], S[kb], 0, 0, 0);
    }
  }
  if (MASKED) {
    const unsigned range = (unsigned)(kmax - kmin);
#pragma unroll
    for (int kb = 0; kb < 2; ++kb)
#pragma unroll
      for (int i = 0; i < 16; ++i) {
        const int keyc = 32 * kb + 8 * (i >> 2) + (i & 3);
        const bool ok = (kmax > kmin) && ((unsigned)(keyc - kmin - 1) < range);
        S[kb][i] = ok ? S[kb][i] : -INFINITY;
      }
  }
}
DI float attn_exp_sum(f32x16 (&S)[2]) {
  float ps = 0.f;
#pragma unroll
  for (int kb = 0; kb < 2; ++kb)
#pragma unroll
    for (int i = 0; i < 16; ++i) { const float pv = __builtin_amdgcn_exp2f(S[kb][i]); S[kb][i] = pv; ps += pv; asm volatile("" : "+v"(ps)); }
  return ps;
}
constexpr float ATT_SUM_CAP = 16777216.0f;
template <int KIND, bool MASKED>
DI void attn_tile(LAS unsigned char* kbuf, LAS unsigned char* vbuf, int jc, const bf16x8 (&qf)[4], float slope2, float sc, int tq, int jt, unsigned long long mymask,
                  float& m_run, float& l_run, float l2inv, f32x16 (&O)[2], LAS float* slab, int q, int h, int q4, int p4, int g1) {
  f32x16 S[2];
  attn_scores<KIND, MASKED>(kbuf, jc, qf, slope2, sc, tq, jt, mymask, m_run, S, q, h);
  {
    float ps = attn_exp_sum(S);
    if (__any(!(ps < ATT_SUM_CAP))) {
      asm volatile("s_nop 0" ::: "memory");
      attn_scores<KIND, MASKED>(kbuf, jc, qf, slope2, sc, tq, jt, mymask, m_run, S, q, h);
      float mx = fmaxf(S[0][0], S[1][0]);
#pragma unroll
      for (int i = 1; i < 16; ++i) mx = fmaxf(fmaxf(mx, S[0][i]), S[1][i]);
      mx = fmaxf(mx, __shfl_xor(mx, 32));
      const float d = fmaxf(mx, 0.f), alpha = __builtin_amdgcn_exp2f(-d);
      m_run += d; l_run *= alpha;
#pragma unroll
      for (int kb = 0; kb < 2; ++kb)
#pragma unroll
        for (int i = 0; i < 16; ++i) S[kb][i] -= d;
      if (KIND != 0) {
#pragma unroll
        for (int db = 0; db < 2; ++db)
#pragma unroll
          for (int i = 0; i < 16; ++i) O[db][i] *= alpha;
      }
      if (KIND == 1) { for (int jj = h; jj < 65; jj += 2) slab[q * 65 + jj] *= alpha; }
      ps = attn_exp_sum(S);
    }
    l_run += ps;
  }
  if (KIND == 1) {
    float s4[8], rx[8];
#pragma unroll
    for (int kb = 0; kb < 2; ++kb)
#pragma unroll
      for (int gi = 0; gi < 4; ++gi) {
        float t4 = S[kb][4 * gi] + S[kb][4 * gi + 1]; asm volatile("" : "+v"(t4)); t4 += S[kb][4 * gi + 2]; asm volatile("" : "+v"(t4)); t4 += S[kb][4 * gi + 3];
        s4[4 * kb + gi] = t4; rx[4 * kb + gi] = __shfl_xor(S[kb][4 * gi + 3], 32);
      }
    LAS float* rowp = slab + q * 65 + 16 * jc + h;
    float old[9], val[9];
#pragma unroll
    for (int m = 0; m < 9; ++m) {
      const float own = (m < 8) ? s4[m < 8 ? m : 7] : 0.f;
      const float a1 = (m < 8) ? rx[m < 8 ? m : 7] : 0.f;
      const float a0 = (m > 0) ? rx[m > 0 ? m - 1 : 0] : 0.f;
      val[m] = own + (h ? a1 : a0);
    }
#pragma unroll
    for (int m = 0; m < 9; ++m) old[m] = (m < 8 || h == 0) ? rowp[2 * m] : 0.f;
#pragma unroll
    for (int m = 0; m < 9; ++m) if (m < 8 || h == 0) rowp[2 * m] = old[m] + val[m];
  }
  if (KIND != 0) {
#pragma unroll
    for (int kb = 0; kb < 2; ++kb)
#pragma unroll
      for (int s = 0; s < 2; ++s) {
        u32x4 pw;
        pw.x = pk2(S[kb][8 * s + 0], S[kb][8 * s + 1]); pw.y = pk2(S[kb][8 * s + 2], S[kb][8 * s + 3]);
        pw.z = pk2(S[kb][8 * s + 4], S[kb][8 * s + 5]); pw.w = pk2(S[kb][8 * s + 6], S[kb][8 * s + 7]);
        const bf16x8 pf = __builtin_bit_cast(bf16x8, pw);
#pragma unroll
        for (int db = 0; db < 2; ++db) {
          LAS unsigned char* va = vbuf + (32 * kb + 16 * s + 4 * h + q4) * VSTR + (32 * db + 16 * g1) * 2 + 8 * p4;
          const s16x4 lo = __builtin_amdgcn_ds_read_tr16_b64_v4i16((LAS s16x4*)va);
          const s16x4 hi = __builtin_amdgcn_ds_read_tr16_b64_v4i16((LAS s16x4*)(va + 8 * VSTR));
          const bf16x8 vf = __builtin_shufflevector(lo, hi, 0, 1, 2, 3, 4, 5, 6, 7);
          O[db] = __builtin_amdgcn_mfma_f32_32x32x16_bf16(vf, pf, O[db], 0, 0, 0);
        }
      }
  }
}

template <int KIND>
DI void attn_branch(LAS unsigned char* gl, LAS unsigned* cnt, unsigned& tgt, const bf16_t* Kg, const bf16_t* Vg, unsigned long long tmask, const bf16x8 (&qf)[4], float slope2, int tq, int jt,
                    unsigned long long mymask, float& m_run, float& l_run, float invl, f32x16 (&O)[2], LAS float* slab) {
  const int gt = get_tid() & 255, lane = gt & 63, q = lane & 31, h = lane >> 5;
  const int i16 = lane & 15, q4 = i16 >> 2, p4 = i16 & 3, g1 = (lane >> 4) & 1;
  const float sc = (KIND <= 1) ? slope2 * 16.0f : slope2;
  const int woff = (gt >> 3) * KVSTR + (gt & 7) * 16;
  int j = __builtin_ctzll(tmask); tmask &= tmask - 1;
  const u32x4 z4 = (u32x4){0u, 0u, 0u, 0u};
  u32x4 ka = *(const u32x4*)(Kg + (size_t)j * 4096 + gt * 8), kb = *(const u32x4*)(Kg + (size_t)j * 4096 + 2048 + gt * 8), va = z4, vb = z4;
  if (KIND != 0) { va = *(const u32x4*)(Vg + (size_t)j * 4096 + gt * 8); vb = *(const u32x4*)(Vg + (size_t)j * 4096 + 2048 + gt * 8); }
  int buf = 0;
  for (;;) {
    LAS unsigned char* kbuf = gl + A_KOFF + buf * (64 * KVSTR); LAS unsigned char* vbuf = gl + A_VOFF + buf * (64 * VSTR);
    *(LAS u32x4*)(kbuf + woff) = ka; *(LAS u32x4*)(kbuf + 32 * KVSTR + woff) = kb;
    if (KIND != 0) { *(LAS u32x4*)(vbuf + woff) = va; *(LAS u32x4*)(vbuf + 32 * VSTR + woff) = vb; }
    group_sync(cnt, tgt, lane);
    const int jc = j;
    const bool more = (tmask != 0ull);
    if (more) {
      j = __builtin_ctzll(tmask); tmask &= tmask - 1;
      ka = *(const u32x4*)(Kg + (size_t)j * 4096 + gt * 8); kb = *(const u32x4*)(Kg + (size_t)j * 4096 + 2048 + gt * 8);
      if (KIND != 0) { va = *(const u32x4*)(Vg + (size_t)j * 4096 + gt * 8); vb = *(const u32x4*)(Vg + (size_t)j * 4096 + 2048 + gt * 8); }
    }
    if (KIND <= 1 || jc == jt || (KIND == 3 && jc == jt - 8)) attn_tile<KIND, true>(kbuf, vbuf, jc, qf, slope2, sc, tq, jt, mymask, m_run, l_run, invl, O, slab, q, h, q4, p4, g1);
    else attn_tile<KIND, (KIND <= 1)>(kbuf, vbuf, jc, qf, slope2, sc, tq, jt, mymask, m_run, l_run, invl, O, slab, q, h, q4, p4, g1);
    buf ^= 1;
    if (!more) break;
  }
  group_sync(cnt, tgt, lane);
}

DI int queue_pop(unsigned* qbase, unsigned xcc) {
  for (unsigned qq = 0; qq < 8u; ++qq) {
    const unsigned x2 = (xcc + qq) & 7u;
    const unsigned i = __hip_atomic_fetch_add(qbase + 64 * x2, 1u, __ATOMIC_RELAXED, __HIP_MEMORY_SCOPE_AGENT);
    if (i < 256u) return (int)(x2 * 256u + i);
  }
  return -1;
}
DI void attn_item(const Params& p, LAS unsigned char* lds, int grp, unsigned& tgt, int enc, int& nenc, unsigned xcc) {
  const int gt = get_tid() & 255, lane = gt & 63, hh = __builtin_amdgcn_readfirstlane(gt >> 6), q = lane & 31, h = lane >> 5;
  const int bg = 2 * (enc >> 8) + (enc & 1), jt32 = 127 - ((enc & 255) >> 1);
  int popv = -1;
  if (gt == 0) popv = queue_pop((unsigned*)(p.ws + OFF_QCNT), xcc);
  const int b = bg >> 1, g = bg & 1, head = g * 4 + hh, jt = jt32 >> 1, tq = (jt32 & 1) * 32 + q, t = jt * 64 + tq;
  const size_t mrow = (size_t)b * 4096 + t;
  const bf16_t* Qp = (const bf16_t*)(p.ws + OFF_Q);
  const bf16_t* KV = (const bf16_t*)(p.ws + OFF_KV);
  const float* gates = (const float*)(p.ws + OFF_GATES);
  bf16_t* cat = (bf16_t*)(p.ws + OFF_CAT);
  float* osc = (float*)(p.ws + OFF_B) + mrow * 512 + head * 64 + 4 * h;
  LAS unsigned char* gl = lds + grp * A_GRP;
  LAS float* slab = (LAS float*)(lds + A_SLAB) + (grp * 4 + hh) * SLAB_FLOATS;
  LAS unsigned long long* selm = (LAS unsigned long long*)(lds + A_SEL) + grp * 32;
  LAS unsigned long long* orm = (LAS unsigned long long*)(lds + A_OR) + grp;
  LAS unsigned* cnt = (LAS unsigned*)(lds + A_CNT + 16 * grp);
  for (int i = lane; i < SLAB_FLOATS; i += 64) slab[i] = 0.f;
  if (gt == 0) *orm = 0ull;
  bf16x8 qf[4];
#pragma unroll
  for (int ks = 0; ks < 4; ++ks) qf[ks] = *(const bf16x8*)(Qp + mrow * 512 + head * 64 + 16 * ks + 8 * h);
  const float slope2 = __builtin_amdgcn_exp2f(-(float)(head + 1)) * LOG2E;
  const float g_cmp = gates[mrow * 24 + head * 3 + 0], g_sel = gates[mrow * 24 + head * 3 + 1], g_win = gates[mrow * 24 + head * 3 + 2];
  const size_t bgoff = (size_t)bg * 4096 * 64;
  const bf16_t* Ksel = KV + (size_t)2 * 16 * 4096 * 64 + bgoff; const bf16_t* Vsel = KV + (size_t)3 * 16 * 4096 * 64 + bgoff;
  const bf16_t* Kwin = KV + (size_t)4 * 16 * 4096 * 64 + bgoff; const bf16_t* Vwin = KV + (size_t)5 * 16 * 4096 * 64 + bgoff;
  const bf16_t* Kc = (const bf16_t*)(p.ws + OFF_KC) + (size_t)bg * 256 * 64; const bf16_t* Vc = (const bf16_t*)(p.ws + OFF_VC) + (size_t)bg * 256 * 64;
  f32x16 O[2];
#pragma unroll
  for (int db = 0; db < 2; ++db)
#pragma unroll
    for (int i = 0; i < 16; ++i) O[db][i] = 0.f;
  {
    const int ncmp = 4 * jt + 2 * (jt32 & 1) + 1, ntile = (ncmp + 63) >> 6;
    const unsigned long long cm = (1ull << ntile) - 1ull;
    float m_run = 0.f, l_run = 0.f;
    attn_branch<1>(gl, cnt, tgt, Kc, Vc, cm, qf, slope2, tq, jt, 0ull, m_run, l_run, 0.f, O, slab);
    const float lt = l_run + __shfl_xor(l_run, 32);
    const float invl = lt > 0.f ? __builtin_amdgcn_rcpf(lt) : 0.f;
    if (h == 0) ((LAS float*)(lds + A_LINV))[(grp * 4 + hh) * 32 + q] = invl;
    const float gsc = g_cmp * invl;
#pragma unroll
    for (int db = 0; db < 2; ++db)
#pragma unroll
      for (int gi = 0; gi < 4; ++gi) {
        *(f32x4*)(osc + 32 * db + 8 * gi) = (f32x4){O[db][4 * gi], O[db][4 * gi + 1], O[db][4 * gi + 2], O[db][4 * gi + 3]} * gsc;
        O[db][4 * gi] = 0.f; O[db][4 * gi + 1] = 0.f; O[db][4 * gi + 2] = 0.f; O[db][4 * gi + 3] = 0.f;
      }
  }
  group_sync(cnt, tgt, lane);
  {
    const LAS float* slabs = (const LAS float*)(lds + A_SLAB) + grp * 4 * SLAB_FLOATS;
    unsigned long long worm = 0ull;
    unsigned key[8], prefix[8];
#pragma unroll
    for (int tt = 0; tt < 8; ++tt) {
      const int tok = hh * 8 + tt;
      float v = 0.f;
#pragma unroll
      for (int h2 = 0; h2 < 4; ++h2) v += slabs[h2 * SLAB_FLOATS + tok * 65 + lane] * ((const LAS float*)(lds + A_LINV))[(grp * 4 + h2) * 32 + tok];
      if (lane == 0 || lane == jt || lane == jt - 1) v = 1e30f; else if (lane > jt) v = -1e30f;
      unsigned k = __float_as_uint(v); k = (k & 0x80000000u) ? ~k : (k | 0x80000000u);
      key[tt] = k; prefix[tt] = 0u;
    }
#pragma unroll
    for (int bit = 31; bit >= 0; --bit)
#pragma unroll
      for (int tt = 0; tt < 8; ++tt) {
        const unsigned cand = prefix[tt] | (1u << bit);
        const unsigned long long mge = __ballot(key[tt] >= cand);
        prefix[tt] = (__popcll(mge) >= 16) ? cand : prefix[tt];
      }
#pragma unroll
    for (int tt = 0; tt < 8; ++tt) {
      const unsigned long long mgt = __ballot(key[tt] > prefix[tt]), meq = __ballot(key[tt] == prefix[tt]);
      const int need = 16 - __popcll(mgt);
      const int rank_eq = __popcll(meq & ((1ull << lane) - 1ull));
      const unsigned long long msk = mgt | __ballot((key[tt] == prefix[tt]) && (rank_eq < need));
      if (lane == 0) selm[hh * 8 + tt] = msk;
      worm |= msk;
    }
    if (lane == 0) atomicOr((unsigned long long*)orm, worm);
  }
  if (gt == 0) *(LAS int*)(lds + A_NXT + 16 * grp) = popv;
  group_sync(cnt, tgt, lane);
  nenc = *(const LAS int*)(lds + A_NXT + 16 * grp);
  const unsigned long long mymask = selm[q];
  const unsigned long long ormask = *orm;
  const unsigned long long causal = (jt >= 63) ? ~0ull : ((2ull << jt) - 1ull);
  const int jlo = jt >= 8 ? jt - 8 : 0;
  {
    float m_run = 0.f, l_run = 0.f;
    attn_branch<2>(gl, cnt, tgt, Ksel, Vsel, ormask & causal, qf, slope2, tq, jt, mymask, m_run, l_run, 0.f, O, slab);
    const float lt = l_run + __shfl_xor(l_run, 32);
    const float sc = lt > 0.f ? g_sel / lt : 0.f;
#pragma unroll
    for (int db = 0; db < 2; ++db)
#pragma unroll
      for (int gi = 0; gi < 4; ++gi) {
        const f32x4 pv = *(const f32x4*)(osc + 32 * db + 8 * gi);
        *(f32x4*)(osc + 32 * db + 8 * gi) = pv + (f32x4){O[db][4 * gi], O[db][4 * gi + 1], O[db][4 * gi + 2], O[db][4 * gi + 3]} * sc;
        O[db][4 * gi] = 0.f; O[db][4 * gi + 1] = 0.f; O[db][4 * gi + 2] = 0.f; O[db][4 * gi + 3] = 0.f;
      }
  }
  {
    const unsigned long long wm = causal & ~((1ull << jlo) - 1ull);
    float m_run = 0.f, l_run = 0.f;
    attn_branch<3>(gl, cnt, tgt, Kwin, Vwin, wm, qf, slope2, tq, jt, 0ull, m_run, l_run, 0.f, O, slab);
    const float lt = l_run + __shfl_xor(l_run, 32);
    const float sc = lt > 0.f ? g_win / lt : 0.f;
#pragma unroll
    for (int db = 0; db < 2; ++db)
#pragma unroll
      for (int gi = 0; gi < 4; ++gi) {
        const f32x4 v = *(const f32x4*)(osc + 32 * db + 8 * gi) + (f32x4){O[db][4 * gi], O[db][4 * gi + 1], O[db][4 * gi + 2], O[db][4 * gi + 3]} * sc;
        u32x2 w; w.x = pk2(v[0], v[1]); w.y = pk2(v[2], v[3]);
        *(u32x2*)(cat + mrow * 1024 + 512 + head * 64 + 32 * db + 8 * gi + 4 * h) = w;
      }
  }
}

__global__ void __launch_bounds__(512, 2) fwd_megakernel(Params p) {
  extern __shared__ __attribute__((aligned(16))) unsigned char smem[];
  LAS unsigned char* lds = (LAS unsigned char*)smem;
  cg::grid_group grid = cg::this_grid();
  const int G = gridDim.x, bx = blockIdx.x;
  unsigned char* ws = p.ws;
  if (p.ws == nullptr) grid.sync();
  volatile LAS unsigned* bst = (volatile LAS unsigned*)(lds + LDS_BYTES - 16);
  if (threadIdx.x == 0) { bst[0] = 0u; bst[1] = 0u; }
  __syncthreads();
  const XcdBarrier gbar = xcd_barrier_post((unsigned*)(ws + OFF_BAR), bst);

  p0_prologue(p, lds);
  xcd_barrier(gbar);

  {
    pg8::Gemm g{(const bf16_t*)(ws + OFF_XB), (const bf16_t*)(ws + OFF_WIN), 1024, 1024, 1024, (size_t)256 * 1024 * 2, (size_t)256 * 1024 * 2, 128, 128};
    pg8::StaticOrder S; S.init(MTOK, 2560, G, bx);
    Epi1 E{(const float*)(ws + OFF_RS1), (bf16_t*)(ws + OFF_B), (bf16_t*)(ws + OFF_Q), (bf16_t*)(ws + OFF_KV), (float*)(ws + OFF_GATES)};
    pg8::gemm_phase<Epi1, pg8::StaticOrder, true, true>(lds, g, S, E);
  }
  xcd_barrier(gbar);

  {
    const int ncmp = (G > 64) ? 32 : 0;
    if (bx < ncmp) {
      const int kv = bx >> 4, pm = bx & 15;
      pg8::Gemm g{(const bf16_t*)(ws + OFF_KV) + (size_t)kv * 16 * 4096 * 64, (const bf16_t*)(ws + OFF_CW1) + (size_t)kv * 256 * 2048, 1024, 2048, 2048, (size_t)4096 * 64 * 2, 0, 128, 128};
      pg8::SingleUnit S{pm, 0};
      EpiCmp E{(const float*)(ws + OFF_CB1) + kv * 256, (const bf16_t*)(ws + OFF_CW2) + kv * 64 * 256, (bf16_t*)(ws + (kv ? OFF_VC : OFF_KC))};
      pg8::gemm_phase<EpiCmp, pg8::SingleUnit, false, true>(lds, g, S, E);
    } else {
      conv_load_taps(p, lds);
      for (int tile = bx - ncmp; tile < 1024; tile += G - ncmp) conv_tile(p, lds, tile);
    }
    if (ncmp == 0) {
      for (int un = bx; un < 32; un += G) {
        const int kv = un >> 4, pm = un & 15;
        pg8::Gemm g{(const bf16_t*)(ws + OFF_KV) + (size_t)kv * 16 * 4096 * 64, (const bf16_t*)(ws + OFF_CW1) + (size_t)kv * 256 * 2048, 1024, 2048, 2048, (size_t)4096 * 64 * 2, 0, 128, 128};
        pg8::SingleUnit S{pm, 0};
        EpiCmp E{(const float*)(ws + OFF_CB1) + kv * 256, (const bf16_t*)(ws + OFF_CW2) + kv * 64 * 256, (bf16_t*)(ws + (kv ? OFF_VC : OFF_KC))};
        pg8::gemm_phase<EpiCmp, pg8::SingleUnit, false, true>(lds, g, S, E);
      }
    }
  }
  xcd_barrier(gbar);

  {
    const int tid3 = get_tid(), grp = __builtin_amdgcn_readfirstlane(tid3 >> 8);
    if (tid3 < 2) *(LAS unsigned*)(lds + A_CNT + 16 * tid3) = 0u;
    __syncthreads();
    unsigned tgt = 0u;
    const int gt3 = tid3 & 255, lane3 = tid3 & 63;
    const unsigned xcc = xb_xcc_id();
    LAS unsigned* cnt3 = (LAS unsigned*)(lds + A_CNT + 16 * grp);
    if (gt3 == 0) *(LAS int*)(lds + A_NXT + 16 * grp) = queue_pop((unsigned*)(ws + OFF_QCNT), xcc);
    group_sync(cnt3, tgt, lane3);
    int enc = *(const LAS int*)(lds + A_NXT + 16 * grp);
    group_sync(cnt3, tgt, lane3);
    while (enc >= 0) { int nenc = -1; attn_item(p, lds, grp, tgt, enc, nenc, xcc); enc = nenc; }
  }
  xcd_barrier(gbar);

  {
    pg8::Gemm g{(const bf16_t*)(ws + OFF_CAT), (const bf16_t*)(ws + OFF_WOUT), 1024, 1024, 1024, (size_t)256 * 1024 * 2, (size_t)256 * 1024 * 2, 128, 128};
    pg8::StaticOrder S; S.init(MTOK, 1024, G, bx);
    EpiRes<false, true> E{(const bf16_t*)(ws + OFF_XB), p.out, (bf16_t*)(ws + OFF_B), (float*)(ws + OFF_SSQ2)};
    pg8::gemm_phase<EpiRes<false, true>, pg8::StaticOrder, true, true>(lds, g, S, E);
  }
  xcd_barrier(gbar);

  {
    pg8::Gemm g{(const bf16_t*)(ws + OFF_B), (const bf16_t*)(ws + OFF_WFF1), 1024, 1024, 1024, (size_t)256 * 1024 * 2, (size_t)256 * 1024 * 2, 128, 128};
    pg8::StaticOrder S; S.init(MTOK, 4096, G, bx);
    EpiFF1 E{(const float*)(ws + OFF_SSQ2), (bf16_t*)(ws + OFF_H)};
    pg8::gemm_phase<EpiFF1, pg8::StaticOrder, false, true>(lds, g, S, E);
  }
  xcd_barrier(gbar);

  const int fuse_final = (G == 256) ? 1 : 0;
  {
    pg8::Gemm g{(const bf16_t*)(ws + OFF_H), (const bf16_t*)(ws + OFF_WFF2P), 64, 64, 4096, (size_t)2 * MiB, (size_t)2 * MiB, 32768, 32768};
    pg8::StaticOrder S; S.init(MTOK, 1024, G, bx);
    EpiFinal E{(const bf16_t*)(ws + OFF_B), p.out, (float*)(ws + OFF_SSQ3), (unsigned*)(ws + OFF_PCNT), p.norm_f_g, fuse_final};
    pg8::gemm_phase<EpiFinal, pg8::StaticOrder, true, true>(lds, g, S, E);
  }
  if (!fuse_final) {
    xcd_barrier(gbar);
    const int tid = get_tid(), lane = tid & 63, wid = tid >> 6;
    const float* ssq = (const float*)(ws + OFF_SSQ3);
    f32x4 gn[4];
#pragma unroll
    for (int i = 0; i < 4; ++i) gn[i] = *(const f32x4*)(p.norm_f_g + (lane + 64 * i) * 4);
    for (int r = bx * 8 + wid; r < MTOK; r += G * 8) {
      const float s = __builtin_amdgcn_rsqf(ssq[r] * (1.0f / 1024.0f) + EPSN);
      float* row = p.out + (size_t)r * 1024;
#pragma unroll
      for (int i = 0; i < 4; ++i) { f32x4 v = *(const f32x4*)(row + (lane + 64 * i) * 4); v = v * s * gn[i]; *(f32x4*)(row + (lane + 64 * i) * 4) = v; }
    }
  }
}

extern "C" void kernel_launch(void* const* d_in, const int* in_sizes, int n_in, void* d_out, int out_size, void* d_ws, size_t ws_size, hipStream_t stream) {
  constexpr size_t kDynLds = LDS_BYTES;
  static int grid_blocks = 0;
  if (!grid_blocks) {
    int dev = 0, cus = 0, per_cu = 0;
    (void)hipGetDevice(&dev);
    (void)hipDeviceGetAttribute(&cus, hipDeviceAttributeMultiprocessorCount, dev);
    (void)hipFuncSetAttribute((const void*)fwd_megakernel, hipFuncAttributeMaxDynamicSharedMemorySize, (int)kDynLds);
    (void)hipOccupancyMaxActiveBlocksPerMultiprocessor(&per_cu, (const void*)fwd_megakernel, 512, kDynLds);
    if (per_cu < 1) fprintf(stderr, "kernel_launch: occupancy query says %d blocks per CU\n", per_cu);
    grid_blocks = cus > 0 ? cus : 256;
    if (ws_size < WS_END) fprintf(stderr, "kernel_launch: workspace too small: %zu < %zu\n", ws_size, (size_t)WS_END);
  }
  (void)hipMemsetAsync((unsigned char*)d_ws + OFF_BAR, 0, XCD_BAR_WORDS * 4 + 256 * 256 + 8 * 256, stream);
  Params p{};
  p.x = (const float*)d_in[0]; p.norm1_g = (const float*)d_in[1]; p.w_in = (const float*)d_in[2]; p.dw_w = (const float*)d_in[3]; p.dw_b = (const float*)d_in[4];
  p.cln_g = (const float*)d_in[5]; p.cln_b = (const float*)d_in[6]; p.ck_pe = (const float*)d_in[7]; p.ck_w1 = (const float*)d_in[8]; p.ck_w2 = (const float*)d_in[9];
  p.cv_pe = (const float*)d_in[10]; p.cv_w1 = (const float*)d_in[11]; p.cv_w2 = (const float*)d_in[12]; p.w_out = (const float*)d_in[13]; p.norm2_g = (const float*)d_in[14];
  p.w_ff1 = (const float*)d_in[15]; p.w_ff2 = (const float*)d_in[16]; p.norm_f_g = (const float*)d_in[17];
  p.out = (float*)d_out; p.ws = (unsigned char*)d_ws;
  void* args[] = {&p};
  hipError_t e = hipLaunchCooperativeKernel((const void*)fwd_megakernel, dim3(grid_blocks), dim3(512), args, kDynLds, stream);
  if (e != hipSuccess) fprintf(stderr, "cooperative launch failed: %s (grid %d)\n", hipGetErrorString(e), grid_blocks);
}
```

```cpp
#include <hip/hip_runtime.h>
#include <hip/hip_cooperative_groups.h>
#include <cstdio>
namespace cg = cooperative_groups;

#define LAS __attribute__((address_space(3)))
#define DI __device__ __forceinline__
typedef unsigned short bf16_t;
typedef short bf16x8 __attribute__((ext_vector_type(8)));
typedef short s16x4 __attribute__((ext_vector_type(4)));
typedef float f32x4 __attribute__((ext_vector_type(4)));
typedef float f32x2 __attribute__((ext_vector_type(2)));
typedef float f32x16 __attribute__((ext_vector_type(16)));
typedef unsigned u32x4 __attribute__((ext_vector_type(4)));
typedef unsigned u32x2 __attribute__((ext_vector_type(2)));
typedef __bf16 bf16v2 __attribute__((ext_vector_type(2)));

constexpr float LOG2E = 1.4426950408889634f;
constexpr float EPSN = 1e-6f;
constexpr int LDS_BYTES = 147456;
constexpr int MTOK = 32768, TSEQ = 4096, DM = 1024, DFF = 4096;
constexpr float QSCALE = 0.125f * LOG2E;

constexpr size_t MiB = 1024 * 1024;
constexpr size_t XCD_BAR_WORDS_C = 3456;
constexpr size_t OFF_WIN = 0;
constexpr size_t OFF_WOUT = OFF_WIN + 2560 * 1024 * 2;
constexpr size_t OFF_WFF1 = OFF_WOUT + 1024 * 1024 * 2;
constexpr size_t OFF_WFF2 = OFF_WFF1 + 4096 * 1024 * 2;
constexpr size_t OFF_CW1 = OFF_WFF2 + 4096 * 1024 * 2;
constexpr size_t OFF_CW2 = OFF_CW1 + 2 * 256 * 2048 * 2;
constexpr size_t OFF_CB1 = OFF_CW2 + 2 * 64 * 256 * 2;
constexpr size_t OFF_RS1 = OFF_CB1 + 2 * 256 * 4;
constexpr size_t OFF_SSQ2 = OFF_RS1 + MTOK * 4;
constexpr size_t OFF_SSQ3 = OFF_SSQ2 + MTOK * 4;
constexpr size_t OFF_GATES = OFF_SSQ3 + MTOK * 4;
constexpr size_t OFF_KC = OFF_GATES + (size_t)MTOK * 24 * 4;
constexpr size_t OFF_VC = OFF_KC + 16 * 256 * 64 * 2;
constexpr size_t OFF_BAR = OFF_VC + 16 * 256 * 64 * 2;
constexpr size_t OFF_PCNT = OFF_BAR + XCD_BAR_WORDS_C * 4;
constexpr size_t OFF_QCNT = OFF_PCNT + 256 * 256;
constexpr size_t OFF_B = 30 * MiB;
constexpr size_t OFF_H = 94 * MiB;
constexpr size_t OFF_XB = OFF_H;
constexpr size_t OFF_Q = OFF_H + 64 * MiB;
constexpr size_t OFF_KV = OFF_H + 96 * MiB;
constexpr size_t OFF_CAT = OFF_H + 256 * MiB;
constexpr int HIDP = 4096 + 64;
constexpr size_t OFF_WFF2P = OFF_CAT + 64 * MiB;
constexpr size_t WS_END = OFF_WFF2P + 9 * MiB;
static_assert(OFF_QCNT + 8 * 256 <= OFF_B, "ws map");

struct Params {
  const float* x; const float* norm1_g; const float* w_in; const float* dw_w; const float* dw_b; const float* cln_g; const float* cln_b;
  const float* ck_pe; const float* ck_w1; const float* ck_w2; const float* cv_pe; const float* cv_w1; const float* cv_w2;
  const float* w_out; const float* norm2_g; const float* w_ff1; const float* w_ff2; const float* norm_f_g;
  float* out; unsigned char* ws;
};

DI unsigned pk2(float a, float b) { f32x2 v = {a, b}; bf16v2 r = __builtin_convertvector(v, bf16v2); return __builtin_bit_cast(unsigned, r); }
DI float bf2f(unsigned short u) { return __uint_as_float((unsigned)u << 16); }
DI float sigmoidf_(float v) { return __builtin_amdgcn_rcpf(1.0f + __builtin_amdgcn_exp2f(-v * LOG2E)); }
DI float gelu_tanh(float v) { const float u = 0.7978845608028654f * (v + 0.044715f * v * v * v); const float e = __builtin_amdgcn_exp2f(2.0f * LOG2E * u); const float th = 1.0f - 2.0f * __builtin_amdgcn_rcpf(e + 1.0f); return 0.5f * v * (1.0f + th); }
DI float wave_sum(float v) { v += __shfl_xor(v, 1); v += __shfl_xor(v, 2); v += __shfl_xor(v, 4); v += __shfl_xor(v, 8); v += __shfl_xor(v, 16); v += __shfl_xor(v, 32); return v; }

DI void st_nt(u32x4* p, u32x4 v) { __builtin_nontemporal_store(v, p); }
DI void st_nt(f32x4* p, f32x4 v) { __builtin_nontemporal_store(v, p); }
DI int get_tid() { int t = threadIdx.x; asm volatile("" : "+v"(t)); return t; }

#define XB_TMO      128
#define XB_XCNT(j)  (256  + 64 * (j))
#define XB_XSUB(j)  (1280 + 64 * (j))
#define XB_XGEN(j)  (2304 + 64 * (j))
#define XB_TOP      3328
#define XB_TOPGEN   3392
#define XCD_BAR_WORDS 3456
#define XB_SPIN_CAP (1u << 22)
DI unsigned xb_ld(unsigned* p) { return __hip_atomic_load(p, __ATOMIC_RELAXED, __HIP_MEMORY_SCOPE_AGENT); }
DI unsigned xb_add(unsigned* p, unsigned v) { return __hip_atomic_fetch_add(p, v, __ATOMIC_RELAXED, __HIP_MEMORY_SCOPE_AGENT); }
DI unsigned xb_xcc_id() { return (unsigned)__builtin_amdgcn_s_getreg((3 << 11) | 20) & 0xFu; }
#define XB_SPIN(cond, bar) do { unsigned _sp = 0; while (cond) { __builtin_amdgcn_s_sleep(1); \
    if ((++_sp & 255u) == 0u) { if (xb_ld(&(bar)[XB_TMO])) break; if (_sp > XB_SPIN_CAP) { atomicAdd(&(bar)[XB_TMO], 1u); break; } } } } while (0)
struct XcdBarrier { unsigned* bar; unsigned x; volatile LAS unsigned* st; };
DI XcdBarrier xcd_barrier_post(unsigned* bar, volatile LAS unsigned* st) {
  XcdBarrier b; b.bar = bar; b.x = xb_xcc_id(); b.st = st;
  if (threadIdx.x == 0) (void)xb_add(&bar[XB_XCNT(b.x)], 1u);
  return b;
}
DI void xcd_barrier_complete(unsigned* bar, unsigned x, unsigned& nloc, unsigned& nx) {
  const unsigned G = gridDim.x;
  unsigned sum, cnt, mine, sp = 0u;
  for (;;) {
    sum = 0u; cnt = 0u; mine = 0u;
#pragma unroll
    for (unsigned j = 0; j < 16; ++j) { const unsigned c = xb_ld(&bar[XB_XCNT(j)]); sum += c; cnt += (c > 0u) ? 1u : 0u; mine = (j == x) ? c : mine; }
    if (sum == G) break;
    __builtin_amdgcn_s_sleep(1);
    if ((++sp & 255u) == 0u) { if (xb_ld(&bar[XB_TMO])) break; if (sp > XB_SPIN_CAP) { atomicAdd(&bar[XB_TMO], 1u); break; } }
  }
  nloc = mine > 0u ? mine : 1u; nx = cnt > 0u ? cnt : 1u;
}
DI void xcd_barrier(const XcdBarrier& b) {
  asm volatile("s_waitcnt vmcnt(0)" ::: "memory");
  __syncthreads();
  if (threadIdx.x == 0) {
    unsigned* bar = b.bar;
    __builtin_amdgcn_s_waitcnt(0);
    unsigned nloc = b.st[0], nx = b.st[1];
    if (nloc == 0u) { xcd_barrier_complete(bar, b.x, nloc, nx); b.st[0] = nloc; b.st[1] = nx; }
    const unsigned old = xb_add(&bar[XB_XSUB(b.x)], 1u);
    const unsigned gen = old / nloc;
    if (old + 1u == (gen + 1u) * nloc) {
      __builtin_amdgcn_fence(__ATOMIC_RELEASE, "agent");
      asm volatile("s_waitcnt vmcnt(0)" ::: "memory");
      const unsigned og = xb_add(&bar[XB_TOP], 1u);
      const unsigned tg = og / nx;
      if (og + 1u == (tg + 1u) * nx) xb_add(&bar[XB_TOPGEN], 1u);
      else XB_SPIN(xb_ld(&bar[XB_TOPGEN]) == tg, bar);
      __builtin_amdgcn_fence(__ATOMIC_ACQUIRE, "agent");
      xb_add(&bar[XB_XGEN(b.x)], 1u);
      asm volatile("s_waitcnt vmcnt(0)" ::: "memory");
    } else {
      XB_SPIN(xb_ld(&bar[XB_XGEN(b.x)]) == gen, bar);
      __builtin_amdgcn_fence(__ATOMIC_ACQUIRE, "agent");
      asm volatile("s_waitcnt vmcnt(0)" ::: "memory");
    }
  }
  __syncthreads();
}
namespace pg8 {
constexpr int BM = 256, BK = 64, HALF = 128, HTB = HALF * BK * 2, STAGE_BYTES = 8 * HTB, NXCD = 8, WGM = 8;
DI int lds_byte(int r, int c) { const int st = (r >> 4) * 2 + (c >> 5), rr = r & 15, cc = c & 31, ob = rr * 64 + cc * 2; return st * 1024 + (ob ^ (((ob >> 9) & 1) << 5)); }
DI void stage_rc(int b, int& R, int& C) { const int st = b / 1024, sb = b % 1024, swz = sb ^ (((sb >> 9) & 1) << 5); R = (st >> 1) * 16 + swz / 64; C = (st & 1) * 32 + (swz % 64) / 2; }
DI int perm32(int rho) { const int n = rho >> 4, i = rho & 15; return 8 * (i >> 2) + 4 * n + (i & 3); }

struct Unit { int pm, pn; };
struct Gemm { const bf16_t* A; const bf16_t* Bt; int lda, ldb, K; size_t tstepA, tstepB, kstepA, kstepB; };

struct StaticOrder {
  int nM, nN, nwg, G, c;
  DI void init(int M, int N, int G_, int c_) { nM = M / BM; nN = N / BM; nwg = nM * nN; G = G_; c = c_; }
  DI bool next(int i, Unit& u) const {
    const long L = (long)i * G + c; if (L >= nwg) return false;
    int wgid = (int)L; { const int q = nwg / NXCD, r = nwg % NXCD, xcd = wgid % NXCD, off = wgid / NXCD; wgid = (xcd < r ? xcd * (q + 1) : r * (q + 1) + (xcd - r) * q) + off; }
    const int nig = WGM * nN, gid = wgid / nig, fm = gid * WGM, gsz = (nM - fm) < WGM ? (nM - fm) : WGM;
    u.pm = fm + ((wgid % nig) % gsz); u.pn = (wgid % nig) / gsz; return true;
  }
};
struct SingleUnit {
  int pm, pn;
  DI bool next(int i, Unit& u) const { if (i != 0) return false; u.pm = pm; u.pn = pn; return true; }
};

template <class Epi, class Sched, bool ALIGN_EPI = false, bool SP2 = false>
DI void gemm_phase(LAS unsigned char* lds, const Gemm g, const Sched& S, const Epi& E) {
  const int tid = get_tid(), wid = __builtin_amdgcn_readfirstlane(tid >> 6), lane = tid & 63, wr = wid >> 2, wc = wid & 3, fr = lane & 15, fq = lane >> 4;
  const int K = g.K, nt = K / BK;
  unsigned voffA[2], voffB[2];
#pragma unroll
  for (int i = 0; i < 2; ++i) { int R, C; stage_rc(tid * 16 + i * 8192, R, C); const int Rb = Epi::PERM ? ((R & ~31) + perm32(R & 31)) : R;
    voffA[i] = (unsigned)(R * g.lda + C) * 2u; voffB[i] = (unsigned)(Rb * g.ldb + C) * 2u; }
  const size_t kstepA = g.kstepA, kstepB = g.kstepB;
  const size_t hstepA = (size_t)HALF * g.lda * 2, hstepB = (size_t)HALF * g.ldb * 2;
  const unsigned ldsw = (unsigned)wid * 1024u;
  const int aoff = lds_byte(wr * 64 + fr, fq * 8), boff = lds_byte(wc * 32 + fr, fq * 8);
#define PG8_SA(b, h) (((b) * 2 + (h)) * HTB)
#define PG8_SB(b, h) ((4 + (b) * 2 + (h)) * HTB)
#define PG8_STAGE(bufoff, gbase, voff) do { _Pragma("unroll") for (int _i = 0; _i < 2; ++_i) \
    __builtin_amdgcn_global_load_lds((const unsigned*)((const char*)(gbase) + (voff)[_i]), (LAS unsigned*)(lds + (bufoff) + ldsw + _i * 8192), 16, 0, 0); } while (0)
#define PG8_LDA(dst, b, h) do { _Pragma("unroll") for (int m = 0; m < 4; ++m) _Pragma("unroll") for (int k = 0; k < 2; ++k) dst[m][k] = *(const LAS bf16x8*)(lds + PG8_SA(b, h) + aoff + m * 2048 + k * 1024); } while (0)
#define PG8_LDB(dst, b, h) do { _Pragma("unroll") for (int n = 0; n < 2; ++n) _Pragma("unroll") for (int k = 0; k < 2; ++k) dst[n][k] = *(const LAS bf16x8*)(lds + PG8_SB(b, h) + boff + n * 2048 + k * 1024); } while (0)
#define PG8_MMA(ai, bj, At, Bt) do { __builtin_amdgcn_s_setprio(1); _Pragma("unroll") for (int m = 0; m < 4; ++m) _Pragma("unroll") for (int n = 0; n < 2; ++n) _Pragma("unroll") for (int k = 0; k < 2; ++k) \
    acc[ai][bj][m][n] = __builtin_amdgcn_mfma_f32_16x16x32_bf16(Bt[n][k], At[m][k], acc[ai][bj][m][n], 0, 0, 0); __builtin_amdgcn_s_setprio(0); } while (0)
#define PG8_WAIT_V(n) asm volatile("s_waitcnt vmcnt(" #n ")" ::: "memory")
#define PG8_WAIT_L(n) asm volatile("s_waitcnt lgkmcnt(" #n ")" ::: "memory")
#define PG8_BAR __builtin_amdgcn_s_barrier()
#define PG8_SCHED __builtin_amdgcn_sched_barrier(0)
  Unit cur, nxt; int ui = 0;
  if (!S.next(0, cur)) return;
  f32x4 acc[2][2][4][2];
#pragma unroll
  for (int a = 0; a < 2; ++a)
#pragma unroll
    for (int b = 0; b < 2; ++b)
#pragma unroll
      for (int m = 0; m < 4; ++m)
#pragma unroll
        for (int n = 0; n < 2; ++n) acc[a][b][m][n] = (f32x4){0.f, 0.f, 0.f, 0.f};
  bf16x8 At[4][2], B0[2][2], B1[2][2];
  const char* cA = (const char*)g.A + (size_t)cur.pm * g.tstepA; const char* cB = (const char*)g.Bt + (size_t)cur.pn * g.tstepB;
  if constexpr (SP2) {
    PG8_STAGE(PG8_SB(0, 0), cB, voffB); PG8_STAGE(PG8_SB(0, 1), cB + hstepB, voffB); PG8_STAGE(PG8_SA(0, 0), cA, voffA); PG8_STAGE(PG8_SA(0, 1), cA + hstepA, voffA);
    if (wr == 1) PG8_BAR;
    PG8_WAIT_V(2); PG8_BAR;
    PG8_STAGE(PG8_SB(1, 0), cB + kstepB, voffB); PG8_STAGE(PG8_SA(1, 0), cA + kstepA, voffA); PG8_STAGE(PG8_SB(1, 1), cB + hstepB + kstepB, voffB);
    PG8_WAIT_V(6); PG8_BAR;
  } else {
    PG8_STAGE(PG8_SB(0, 0), cB, voffB); PG8_STAGE(PG8_SA(0, 0), cA, voffA); PG8_STAGE(PG8_SB(0, 1), cB + hstepB, voffB); PG8_STAGE(PG8_SA(0, 1), cA + hstepA, voffA);
    if (wr == 1) PG8_BAR;
    PG8_WAIT_V(4); PG8_BAR;
    PG8_STAGE(PG8_SB(1, 0), cB + kstepB, voffB); PG8_STAGE(PG8_SA(1, 0), cA + kstepA, voffA); PG8_STAGE(PG8_SB(1, 1), cB + hstepB + kstepB, voffB);
    PG8_WAIT_V(6); PG8_BAR;
  }
  for (;;) {
    const bool has_next = S.next(ui + 1, nxt);
    const char* nA = has_next ? (const char*)g.A + (size_t)nxt.pm * g.tstepA : cA; const char* nB = has_next ? (const char*)g.Bt + (size_t)nxt.pn * g.tstepB : cB;
    for (int t = 0; t < nt; t += 2) {
      const bool last = (t == nt - 2);
      const char* a1 = cA + (size_t)(t + 1) * kstepA;
      const char* a2 = last ? nA : cA + (size_t)(t + 2) * kstepA; const char* b2 = last ? nB : cB + (size_t)(t + 2) * kstepB;
      const char* a3 = a2 + kstepA; const char* b3 = b2 + kstepB;
      if constexpr (SP2) {
        PG8_LDB(B0, 0, 0); PG8_LDB(B1, 0, 1); PG8_SCHED; PG8_LDA(At, 0, 0); PG8_STAGE(PG8_SA(1, 1), a1 + hstepA, voffA);
        PG8_WAIT_V(8); PG8_WAIT_L(0); PG8_BAR; PG8_MMA(0, 0, At, B0); PG8_MMA(0, 1, At, B1); PG8_BAR; PG8_SCHED;
        PG8_LDA(At, 0, 1); PG8_STAGE(PG8_SB(0, 0), b2, voffB); PG8_STAGE(PG8_SB(0, 1), b2 + hstepB, voffB); PG8_STAGE(PG8_SA(0, 0), a2, voffA);
        PG8_WAIT_V(8); PG8_WAIT_L(0); PG8_BAR; PG8_MMA(1, 0, At, B0); PG8_MMA(1, 1, At, B1); PG8_BAR; PG8_SCHED;
        PG8_LDB(B0, 1, 0); PG8_LDB(B1, 1, 1); PG8_SCHED; PG8_LDA(At, 1, 0); PG8_STAGE(PG8_SA(0, 1), a2 + hstepA, voffA);
        PG8_WAIT_V(8); PG8_WAIT_L(0); PG8_BAR; PG8_MMA(0, 0, At, B0); PG8_MMA(0, 1, At, B1); PG8_BAR; PG8_SCHED;
        PG8_LDA(At, 1, 1); PG8_STAGE(PG8_SB(1, 0), b3, voffB); PG8_STAGE(PG8_SB(1, 1), b3 + hstepB, voffB); PG8_STAGE(PG8_SA(1, 0), a3, voffA);
        PG8_WAIT_V(8); PG8_WAIT_L(0); PG8_BAR; PG8_MMA(1, 0, At, B0); PG8_MMA(1, 1, At, B1); PG8_BAR; PG8_SCHED;
      } else {
        PG8_LDB(B0, 0, 0); PG8_SCHED; PG8_LDA(At, 0, 0); PG8_STAGE(PG8_SA(1, 1), a1 + hstepA, voffA);
        PG8_WAIT_L(8); PG8_BAR; PG8_WAIT_L(0); PG8_MMA(0, 0, At, B0); PG8_BAR; PG8_SCHED;
        PG8_LDB(B1, 0, 1); PG8_STAGE(PG8_SB(0, 0), b2, voffB);
        PG8_BAR; PG8_WAIT_L(0); PG8_MMA(0, 1, At, B1); PG8_BAR;
        PG8_LDA(At, 0, 1); PG8_STAGE(PG8_SA(0, 0), a2, voffA);
        PG8_BAR; PG8_WAIT_L(0); PG8_MMA(1, 0, At, B0); PG8_BAR; PG8_SCHED;
        PG8_STAGE(PG8_SB(0, 1), b2 + hstepB, voffB);
        PG8_WAIT_V(6); PG8_BAR; PG8_MMA(1, 1, At, B1); PG8_BAR;
        PG8_LDB(B0, 1, 0); PG8_SCHED; PG8_LDA(At, 1, 0); PG8_STAGE(PG8_SA(0, 1), a2 + hstepA, voffA);
        PG8_WAIT_L(8); PG8_BAR; PG8_WAIT_L(0); PG8_MMA(0, 0, At, B0); PG8_BAR; PG8_SCHED;
        PG8_LDB(B1, 1, 1); PG8_STAGE(PG8_SB(1, 0), b3, voffB);
        PG8_BAR; PG8_WAIT_L(0); PG8_MMA(0, 1, At, B1); PG8_BAR;
        PG8_LDA(At, 1, 1); PG8_STAGE(PG8_SA(1, 0), a3, voffA);
        PG8_BAR; PG8_WAIT_L(0); PG8_MMA(1, 0, At, B0); PG8_BAR; PG8_SCHED;
        PG8_STAGE(PG8_SB(1, 1), b3 + hstepB, voffB);
        PG8_WAIT_V(6); PG8_BAR; PG8_MMA(1, 1, At, B1); PG8_BAR;
      }
    }
    if constexpr (ALIGN_EPI) { if (wr == 0) PG8_BAR; }
    if constexpr (!Epi::AFTER_DRAIN) { E(acc, cur, wr, wc, fr, fq); }
    if (!has_next) break;
#pragma unroll
    for (int a = 0; a < 2; ++a)
#pragma unroll
      for (int b = 0; b < 2; ++b)
#pragma unroll
        for (int m = 0; m < 4; ++m)
#pragma unroll
          for (int n = 0; n < 2; ++n) acc[a][b][m][n] = (f32x4){0.f, 0.f, 0.f, 0.f};
    cur = nxt; cA = nA; cB = nB; ++ui;
    if constexpr (ALIGN_EPI) { if (wr == 1) PG8_BAR; }
  }
  PG8_WAIT_V(0);
  if constexpr (!ALIGN_EPI) { if (wr == 0) PG8_BAR; }
  PG8_BAR;
  if constexpr (Epi::AFTER_DRAIN) { E.fused(acc, cur, wr, wc, fr, fq, lds, wid, lane); }
#undef PG8_SA
#undef PG8_SB
#undef PG8_STAGE
#undef PG8_LDA
#undef PG8_LDB
#undef PG8_MMA
#undef PG8_WAIT_V
#undef PG8_WAIT_L
#undef PG8_BAR
#undef PG8_SCHED
}
}

struct Epi1 {
  static constexpr bool PERM = true, AFTER_DRAIN = false;
  const float* rs; bf16_t* uv; bf16_t* q; bf16_t* kv; float* gates;
  DI void operator()(const f32x4 (&acc)[2][2][4][2], const pg8::Unit& u, int wr, int wc, int fr, int fq) const {
    const int pn = u.pn;
    float rsv[2][4];
#pragma unroll
    for (int ai = 0; ai < 2; ++ai)
#pragma unroll
      for (int m = 0; m < 4; ++m) rsv[ai][m] = rs[u.pm * 256 + ai * 128 + wr * 64 + m * 16 + fr];
#pragma unroll
    for (int ai = 0; ai < 2; ++ai)
#pragma unroll
      for (int m = 0; m < 4; ++m) {
        const int r = u.pm * 256 + ai * 128 + wr * 64 + m * 16 + fr;
        const float s = rsv[ai][m];
#pragma unroll
        for (int bj = 0; bj < 2; ++bj) {
          const int cl = bj * 128 + wc * 32 + 8 * fq;
          f32x4 v0 = acc[ai][bj][m][0] * s, v1 = acc[ai][bj][m][1] * s;
          if (pn < 4) {
            u32x4 w; w.x = pk2(v0[0], v0[1]); w.y = pk2(v0[2], v0[3]); w.z = pk2(v1[0], v1[1]); w.w = pk2(v1[2], v1[3]);
            *(u32x4*)(uv + (size_t)r * 1024 + pn * 256 + cl) = w;
          } else if (pn < 6) {
            v0 = v0 * QSCALE; v1 = v1 * QSCALE;
            u32x4 w; w.x = pk2(v0[0], v0[1]); w.y = pk2(v0[2], v0[3]); w.z = pk2(v1[0], v1[1]); w.w = pk2(v1[2], v1[3]);
            *(u32x4*)(q + (size_t)r * 512 + (pn - 4) * 256 + cl) = w;
          } else if (pn < 9) {
            const int kvidx = (pn - 6) * 256 + cl, br = kvidx >> 7, gg = (kvidx >> 6) & 1, d = kvidx & 63, b = r >> 12, t = r & 4095;
            u32x4 w; w.x = pk2(v0[0], v0[1]); w.y = pk2(v0[2], v0[3]); w.z = pk2(v1[0], v1[1]); w.w = pk2(v1[2], v1[3]);
            *(u32x4*)(kv + ((size_t)(((br * 8 + b) * 2 + gg) * 4096 + t)) * 64 + d) = w;
          } else {
            if (cl < 24) {
              f32x4 g0, g1;
#pragma unroll
              for (int j = 0; j < 4; ++j) { g0[j] = sigmoidf_(v0[j]); g1[j] = sigmoidf_(v1[j]); }
              *(f32x4*)(gates + (size_t)r * 24 + cl) = g0; *(f32x4*)(gates + (size_t)r * 24 + cl + 4) = g1;
            }
          }
        }
      }
  }
};
template <bool WRITE_IO, bool WRITE_B> struct EpiRes {
  static constexpr bool PERM = true, AFTER_DRAIN = false;
  const bf16_t* base; float* io; bf16_t* xb; float* ssq;
  DI void operator()(const f32x4 (&acc)[2][2][4][2], const pg8::Unit& u, int wr, int wc, int fr, int fq) const {
    u32x4 xin[2][4][2];
#pragma unroll
    for (int ai = 0; ai < 2; ++ai)
#pragma unroll
      for (int m = 0; m < 4; ++m)
#pragma unroll
        for (int bj = 0; bj < 2; ++bj) xin[ai][m][bj] = *(const u32x4*)(base + (size_t)(u.pm * 256 + ai * 128 + wr * 64 + m * 16 + fr) * 1024 + u.pn * 256 + bj * 128 + wc * 32 + 8 * fq);
    __builtin_amdgcn_sched_barrier(0);
#pragma unroll
    for (int ai = 0; ai < 2; ++ai)
#pragma unroll
      for (int m = 0; m < 4; ++m) {
        const int r = u.pm * 256 + ai * 128 + wr * 64 + m * 16 + fr;
        float ss = 0.f;
#pragma unroll
        for (int bj = 0; bj < 2; ++bj) {
          const size_t off = (size_t)r * 1024 + u.pn * 256 + bj * 128 + wc * 32 + 8 * fq;
          const u32x4 xw = xin[ai][m][bj];
          const f32x4 b0 = (f32x4){__uint_as_float(xw.x << 16), __uint_as_float(xw.x & 0xffff0000u), __uint_as_float(xw.y << 16), __uint_as_float(xw.y & 0xffff0000u)};
          const f32x4 b1 = (f32x4){__uint_as_float(xw.z << 16), __uint_as_float(xw.z & 0xffff0000u), __uint_as_float(xw.w << 16), __uint_as_float(xw.w & 0xffff0000u)};
          const f32x4 v0 = acc[ai][bj][m][0] + b0, v1 = acc[ai][bj][m][1] + b1;
          if (WRITE_IO) { *(f32x4*)(io + off) = v0; *(f32x4*)(io + off + 4) = v1; }
          if (WRITE_B) { u32x4 w; w.x = pk2(v0[0], v0[1]); w.y = pk2(v0[2], v0[3]); w.z = pk2(v1[0], v1[1]); w.w = pk2(v1[2], v1[3]); *(u32x4*)(xb + off) = w; }
          ss += (v0[0] * v0[0] + v0[1] * v0[1]) + (v0[2] * v0[2] + v0[3] * v0[3]) + (v1[0] * v1[0] + v1[1] * v1[1]) + (v1[2] * v1[2] + v1[3] * v1[3]);
        }
        ss += __shfl_xor(ss, 16); ss += __shfl_xor(ss, 32);
        if (fq == 0) atomicAdd(ssq + r, ss);
      }
  }
};
struct EpiFF1 {
  static constexpr bool PERM = true, AFTER_DRAIN = false;
  const float* ssq; bf16_t* hid;
  DI void operator()(const f32x4 (&acc)[2][2][4][2], const pg8::Unit& u, int wr, int wc, int fr, int fq) const {
    float sq[2][4];
#pragma unroll
    for (int ai = 0; ai < 2; ++ai)
#pragma unroll
      for (int m = 0; m < 4; ++m) sq[ai][m] = ssq[u.pm * 256 + ai * 128 + wr * 64 + m * 16 + fr];
#pragma unroll
    for (int ai = 0; ai < 2; ++ai)
#pragma unroll
      for (int m = 0; m < 4; ++m) {
        const int r = u.pm * 256 + ai * 128 + wr * 64 + m * 16 + fr;
        const float s = __builtin_amdgcn_rsqf(sq[ai][m] * (1.0f / 1024.0f) + EPSN);
#pragma unroll
        for (int bj = 0; bj < 2; ++bj) {
          f32x4 v0 = acc[ai][bj][m][0] * s, v1 = acc[ai][bj][m][1] * s;
#pragma unroll
          for (int j = 0; j < 4; ++j) { const float a = fmaxf(v0[j], 0.f), b = fmaxf(v1[j], 0.f); v0[j] = a * a; v1[j] = b * b; }
          u32x4 w; w.x = pk2(v0[0], v0[1]); w.y = pk2(v0[2], v0[3]); w.z = pk2(v1[0], v1[1]); w.w = pk2(v1[2], v1[3]);
          { const int c = u.pn * 256 + bj * 128 + wc * 32 + 8 * fq;
            st_nt((u32x4*)(hid + ((((size_t)u.pm * 64 + (c >> 6)) * 256 + (r & 255)) * 64 + (c & 63))), w); }
        }
      }
  }
};
struct EpiFinal {
  static constexpr bool PERM = true, AFTER_DRAIN = false;
  const bf16_t* xb; float* io; float* ssq; unsigned* cnt; const float* gn; int fuse;
  DI void operator()(f32x4 (&acc)[2][2][4][2], const pg8::Unit& u, int wr, int wc, int fr, int fq) const {
    u32x4 xin[2][4][2];
#pragma unroll
    for (int ai = 0; ai < 2; ++ai)
#pragma unroll
      for (int m = 0; m < 4; ++m)
#pragma unroll
        for (int bj = 0; bj < 2; ++bj) xin[ai][m][bj] = *(const u32x4*)(xb + (size_t)(u.pm * 256 + ai * 128 + wr * 64 + m * 16 + fr) * 1024 + u.pn * 256 + bj * 128 + wc * 32 + 8 * fq);
    __builtin_amdgcn_sched_barrier(0);
#pragma unroll
    for (int ai = 0; ai < 2; ++ai)
#pragma unroll
      for (int m = 0; m < 4; ++m) {
        const int r = u.pm * 256 + ai * 128 + wr * 64 + m * 16 + fr;
        float ss = 0.f;
#pragma unroll
        for (int bj = 0; bj < 2; ++bj) {
          const size_t off = (size_t)r * 1024 + u.pn * 256 + bj * 128 + wc * 32 + 8 * fq;
          const u32x4 xw = xin[ai][m][bj];
          const f32x4 b0 = (f32x4){__uint_as_float(xw.x << 16), __uint_as_float(xw.x & 0xffff0000u), __uint_as_float(xw.y << 16), __uint_as_float(xw.y & 0xffff0000u)};
          const f32x4 b1 = (f32x4){__uint_as_float(xw.z << 16), __uint_as_float(xw.z & 0xffff0000u), __uint_as_float(xw.w << 16), __uint_as_float(xw.w & 0xffff0000u)};
          const f32x4 v0 = acc[ai][bj][m][0] + b0, v1 = acc[ai][bj][m][1] + b1;
          acc[ai][bj][m][0] = v0; acc[ai][bj][m][1] = v1;
          if (!fuse) { *(f32x4*)(io + off) = v0; *(f32x4*)(io + off + 4) = v1; }
          ss += (v0[0] * v0[0] + v0[1] * v0[1]) + (v0[2] * v0[2] + v0[3] * v0[3]) + (v1[0] * v1[0] + v1[1] * v1[1]) + (v1[2] * v1[2] + v1[3] * v1[3]);
        }
        ss += __shfl_xor(ss, 16); ss += __shfl_xor(ss, 32);
        if (fq == 0) atomicAdd(ssq + r, ss);
      }
    if (!fuse) return;
    asm volatile("s_waitcnt vmcnt(0)" ::: "memory");
    unsigned* c = cnt + 64 * (u.pm * 2 + wr);
    if (fr == 0 && fq == 0) __hip_atomic_fetch_add(c, 1u, __ATOMIC_RELAXED, __HIP_MEMORY_SCOPE_AGENT);
    { unsigned sp = 0; while ((unsigned)__builtin_amdgcn_readfirstlane(__hip_atomic_load(c, __ATOMIC_RELAXED, __HIP_MEMORY_SCOPE_AGENT)) < 16u) { __builtin_amdgcn_s_sleep(2); if (++sp > (1u << 22)) break; } }
    f32x4 g[2][2];
#pragma unroll
    for (int bj = 0; bj < 2; ++bj)
#pragma unroll
      for (int n = 0; n < 2; ++n) g[bj][n] = *(const f32x4*)(gn + u.pn * 256 + bj * 128 + wc * 32 + 8 * fq + 4 * n);
    float sq[2][4];
#pragma unroll
    for (int ai = 0; ai < 2; ++ai)
#pragma unroll
      for (int m = 0; m < 4; ++m) sq[ai][m] = __hip_atomic_load(ssq + u.pm * 256 + ai * 128 + wr * 64 + m * 16 + fr, __ATOMIC_RELAXED, __HIP_MEMORY_SCOPE_AGENT);
#pragma unroll
    for (int ai = 0; ai < 2; ++ai)
#pragma unroll
      for (int m = 0; m < 4; ++m) {
        const int r = u.pm * 256 + ai * 128 + wr * 64 + m * 16 + fr;
        const float s = __builtin_amdgcn_rsqf(sq[ai][m] * (1.0f / 1024.0f) + EPSN);
#pragma unroll
        for (int bj = 0; bj < 2; ++bj) {
          const size_t off = (size_t)r * 1024 + u.pn * 256 + bj * 128 + wc * 32 + 8 * fq;
          st_nt((f32x4*)(io + off), acc[ai][bj][m][0] * s * g[bj][0]); st_nt((f32x4*)(io + off + 4), acc[ai][bj][m][1] * s * g[bj][1]);
        }
      }
  }
};
constexpr int HSTR = 528;
struct EpiCmp {
  static constexpr bool PERM = false, AFTER_DRAIN = true;
  const float* bias1; const bf16_t* w2t; bf16_t* outp;
  DI void fused(const f32x4 (&acc)[2][2][4][2], const pg8::Unit& u, int wr, int wc, int fr, int fq, LAS unsigned char* lds, int wid, int lane) const {
#pragma unroll
    for (int bj = 0; bj < 2; ++bj)
#pragma unroll
      for (int n = 0; n < 2; ++n) {
        const int c = bj * 128 + wc * 32 + n * 16 + 4 * fq;
        const f32x4 bv = *(const f32x4*)(bias1 + c);
#pragma unroll
        for (int ai = 0; ai < 2; ++ai)
#pragma unroll
          for (int m = 0; m < 4; ++m) {
            const int r = ai * 128 + wr * 64 + m * 16 + fr;
            const f32x4 v = acc[ai][bj][m][n] + bv;
            u32x2 w; w.x = pk2(gelu_tanh(v[0]), gelu_tanh(v[1])); w.y = pk2(gelu_tanh(v[2]), gelu_tanh(v[3]));
            *(LAS u32x2*)(lds + r * HSTR + c * 2) = w;
          }
      }
    __syncthreads();
    f32x4 o[2][4];
#pragma unroll
    for (int mb = 0; mb < 2; ++mb)
#pragma unroll
      for (int nb = 0; nb < 4; ++nb) o[mb][nb] = (f32x4){0.f, 0.f, 0.f, 0.f};
    bf16x8 wf[8][4];
#pragma unroll
    for (int ks = 0; ks < 8; ++ks)
#pragma unroll
      for (int nb = 0; nb < 4; ++nb) wf[ks][nb] = *(const bf16x8*)(w2t + (16 * nb + fr) * 256 + 32 * ks + 8 * fq);
#pragma unroll
    for (int ks = 0; ks < 8; ++ks) {
      bf16x8 hf[2];
#pragma unroll
      for (int mb = 0; mb < 2; ++mb) hf[mb] = *(const LAS bf16x8*)(lds + (32 * wid + 16 * mb + fr) * HSTR + (32 * ks + 8 * fq) * 2);
#pragma unroll
      for (int mb = 0; mb < 2; ++mb)
#pragma unroll
        for (int nb = 0; nb < 4; ++nb) o[mb][nb] = __builtin_amdgcn_mfma_f32_16x16x32_bf16(wf[ks][nb], hf[mb], o[mb][nb], 0, 0, 0);
    }
#pragma unroll
    for (int mb = 0; mb < 2; ++mb)
#pragma unroll
      for (int nb = 0; nb < 4; ++nb) {
        const int row = 32 * wid + 16 * mb + fr;
        u32x2 w; w.x = pk2(o[mb][nb][0], o[mb][nb][1]); w.y = pk2(o[mb][nb][2], o[mb][nb][3]);
        *(u32x2*)(outp + ((size_t)u.pm * 256 + row) * 64 + 16 * nb + 4 * fq) = w;
      }
    __syncthreads();
  }
};

struct TJob { const float* src; bf16_t* dst; const float* g; int K, N, kt, nt, ldd, blk; };
DI TJob transpose_job(const Params& p, int job) {
  unsigned char* ws = p.ws; TJob t;
  if (job < 640) t = TJob{p.w_in, (bf16_t*)(ws + OFF_WIN), p.norm1_g, 1024, 2328, job / 40, job % 40, 1024, 0};
  else if (job < 896) { const int j = job - 640; t = TJob{p.w_out, (bf16_t*)(ws + OFF_WOUT), nullptr, 1024, 1024, j / 16, j % 16, 1024, 0}; }
  else if (job < 1920) { const int j = job - 896; t = TJob{p.w_ff1, (bf16_t*)(ws + OFF_WFF1), p.norm2_g, 1024, 4096, j / 64, j % 64, 1024, 0}; }
  else if (job < 2944) { const int j = job - 1920; t = TJob{p.w_ff2, (bf16_t*)(ws + OFF_WFF2P), nullptr, 4096, 1024, j / 16, j % 16, 4096, 1}; }
  else if (job < 3072) { const int j = job - 2944; t = TJob{p.ck_w1, (bf16_t*)(ws + OFF_CW1), nullptr, 2048, 256, j / 4, j % 4, 2048, 0}; }
  else if (job < 3200) { const int j = job - 3072; t = TJob{p.cv_w1, (bf16_t*)(ws + OFF_CW1) + 256 * 2048, nullptr, 2048, 256, j / 4, j % 4, 2048, 0}; }
  else if (job < 3204) { const int j = job - 3200; t = TJob{p.ck_w2, (bf16_t*)(ws + OFF_CW2), nullptr, 256, 64, j, 0, 256, 0}; }
  else { const int j = job - 3204; t = TJob{p.cv_w2, (bf16_t*)(ws + OFF_CW2) + 64 * 256, nullptr, 256, 64, j, 0, 256, 0}; }
  return t;
}
DI void transpose_pair(const TJob& ta, const TJob& tb, bool has_b, LAS float* tl) {
  const int tid = get_tid();
  f32x4 va[2], vb[2];
#pragma unroll
  for (int i = 0; i < 2; ++i) {
    const int idx = tid + 512 * i, row = idx >> 4, c4 = idx & 15;
    { const int n = ta.nt * 64 + 4 * c4; va[i] = (f32x4){0.f, 0.f, 0.f, 0.f}; if (n < ta.N) va[i] = *(const f32x4*)(ta.src + (size_t)(ta.kt * 64 + row) * ta.N + n); if (ta.g) va[i] = va[i] * ta.g[ta.kt * 64 + row]; }
    vb[i] = (f32x4){0.f, 0.f, 0.f, 0.f};
    if (has_b) { const int n = tb.nt * 64 + 4 * c4; if (n < tb.N) vb[i] = *(const f32x4*)(tb.src + (size_t)(tb.kt * 64 + row) * tb.N + n); if (tb.g) vb[i] = vb[i] * tb.g[tb.kt * 64 + row]; }
  }
#pragma unroll
  for (int i = 0; i < 2; ++i) {
    const int idx = tid + 512 * i, row = idx >> 4, c4 = idx & 15;
#pragma unroll
    for (int e = 0; e < 4; ++e) { tl[row * 65 + 4 * c4 + e] = va[i][e]; tl[4160 + row * 65 + 4 * c4 + e] = vb[i][e]; }
  }
  __syncthreads();
  {
    const int nrow = tid >> 3, kc = tid & 7;
    float e[8];
#pragma unroll
    for (int j = 0; j < 8; ++j) e[j] = tl[(8 * kc + j) * 65 + nrow];
    u32x4 w; w.x = pk2(e[0], e[1]); w.y = pk2(e[2], e[3]); w.z = pk2(e[4], e[5]); w.w = pk2(e[6], e[7]);
    { const int n = ta.nt * 64 + nrow; const size_t di = ta.blk ? ((((size_t)(n >> 8) * (ta.K >> 6) + ta.kt) * 256 + (n & 255)) * 64 + 8 * kc) : ((size_t)n * ta.ldd + ta.kt * 64 + 8 * kc); *(u32x4*)(ta.dst + di) = w; }
    if (has_b) {
#pragma unroll
      for (int j = 0; j < 8; ++j) e[j] = tl[4160 + (8 * kc + j) * 65 + nrow];
      w.x = pk2(e[0], e[1]); w.y = pk2(e[2], e[3]); w.z = pk2(e[4], e[5]); w.w = pk2(e[6], e[7]);
      { const int n = tb.nt * 64 + nrow; const size_t di = tb.blk ? ((((size_t)(n >> 8) * (tb.K >> 6) + tb.kt) * 256 + (n & 255)) * 64 + 8 * kc) : ((size_t)n * tb.ldd + tb.kt * 64 + 8 * kc); *(u32x4*)(tb.dst + di) = w; }
    }
  }
  __syncthreads();
}

DI void p0_prologue(const Params& p, LAS unsigned char* lds) {
  const int tid = get_tid(), lane = tid & 63, wid = tid >> 6, G = gridDim.x, bx = blockIdx.x;
  unsigned char* ws = p.ws;
  {
    bf16_t* xb = (bf16_t*)(ws + OFF_XB); float* rs1 = (float*)(ws + OFF_RS1);
    for (int r0 = (bx * 8 + wid) * 4; r0 < MTOK; r0 += G * 32) {
      f32x4 a[4][2], c[4][2];
#pragma unroll
      for (int rr = 0; rr < 4; ++rr)
#pragma unroll
        for (int i = 0; i < 2; ++i) { const float* s = p.x + (size_t)(r0 + rr) * 1024 + (lane + 64 * i) * 8; a[rr][i] = __builtin_nontemporal_load((const f32x4*)s); c[rr][i] = __builtin_nontemporal_load((const f32x4*)(s + 4)); }
#pragma unroll
      for (int rr = 0; rr < 4; ++rr) {
        float ss = 0.f;
#pragma unroll
        for (int i = 0; i < 2; ++i) {
          const f32x4 av = a[rr][i], bv = c[rr][i];
          ss += (av[0] * av[0] + av[1] * av[1]) + (av[2] * av[2] + av[3] * av[3]) + (bv[0] * bv[0] + bv[1] * bv[1]) + (bv[2] * bv[2] + bv[3] * bv[3]);
          u32x4 w; w.x = pk2(av[0], av[1]); w.y = pk2(av[2], av[3]); w.z = pk2(bv[0], bv[1]); w.w = pk2(bv[2], bv[3]);
          *(u32x4*)(xb + (size_t)(r0 + rr) * 1024 + (lane + 64 * i) * 8) = w;
        }
        ss = wave_sum(ss);
        if (lane == 0) rs1[r0 + rr] = __builtin_amdgcn_rsqf(ss * (1.0f / 1024.0f) + EPSN);
      }
    }
  }
  { float* z = (float*)(ws + OFF_SSQ2); for (int i = bx * 512 + tid; i < 2 * MTOK; i += G * 512) z[i] = 0.f; }
  for (int pair = bx; pair < 256; pair += G) {
    LAS float* red = (LAS float*)lds;
    const int kv = pair >> 7, n = (pair & 127) * 2 + (tid & 1), ksl = tid >> 1;
    const float* pe = kv ? p.cv_pe : p.ck_pe; const float* w1 = kv ? p.cv_w1 : p.ck_w1;
    float s = 0.f;
#pragma unroll
    for (int k = 0; k < 8; ++k) s += pe[ksl * 8 + k] * w1[(size_t)(ksl * 8 + k) * 256 + n];
    s += __shfl_xor(s, 2); s += __shfl_xor(s, 4); s += __shfl_xor(s, 8); s += __shfl_xor(s, 16); s += __shfl_xor(s, 32);
    if (lane < 2) red[wid * 2 + lane] = s;
    __syncthreads();
    if (tid < 2) { float t = 0.f; for (int i = 0; i < 8; ++i) t += red[i * 2 + tid]; ((float*)(ws + OFF_CB1))[kv * 256 + (pair & 127) * 2 + tid] = t; }
    __syncthreads();
  }
  for (int job = bx; job < 3208; job += 2 * G) {
    const bool has_b = (job + G) < 3208;
    const TJob ta = transpose_job(p, job), tb = transpose_job(p, has_b ? job + G : job);
    transpose_pair(ta, tb, has_b, (LAS float*)lds);
  }
}

constexpr int USTR = 1040;
constexpr int YSTR = 516;
constexpr int C_WOFF = 66560;
DI void conv_load_taps(const Params& p, LAS unsigned char* lds) {
  LAS float* Wp = (LAS float*)(lds + C_WOFF);
  for (int idx = get_tid(); idx < 32 * 256; idx += 512) {
    const int w = idx >> 8, cp = idx & 255;
    f32x2 t = (f32x2){0.f, 0.f};
    if (w < 31) t = *(const f32x2*)(p.dw_w + w * 512 + 2 * cp);
    *(LAS f32x2*)(Wp + ((w >> 2) * 256 + cp) * 8 + (w & 3) * 2) = t;
  }
}
DI void conv_tile(const Params& p, LAS unsigned char* lds, int tile) {
  const int tid = get_tid(), lane = tid & 63, wid = tid >> 6;
  const int b = tile >> 7, t0 = (tile & 127) * 32;
  const bf16_t* uv = (const bf16_t*)(p.ws + OFF_B);
  bf16_t* cat = (bf16_t*)(p.ws + OFF_CAT);
  LAS unsigned char* U = lds; LAS float* Y = (LAS float*)lds;
  const LAS float* Wp = (const LAS float*)(lds + C_WOFF);
  {
    u32x4 vv[8], gv[8];
#pragma unroll
    for (int it = 0; it < 8; ++it) {
      const int idx = tid + 512 * it, row = idx >> 6, ch = idx & 63, t = t0 - 30 + row;
      const int tc = t < 0 ? 0 : (row < 62 ? t : t0);
      const size_t m = (size_t)b * 4096 + tc;
      vv[it] = *(const u32x4*)(uv + m * 1024 + ch * 8); gv[it] = *(const u32x4*)(uv + m * 1024 + 512 + ch * 8);
    }
#pragma unroll
    for (int it = 0; it < 8; ++it) {
      const int idx = tid + 512 * it, row = idx >> 6, ch = idx & 63, t = t0 - 30 + row;
      u32x4 w = (u32x4){0u, 0u, 0u, 0u};
      if (t >= 0 && row < 62) {
#pragma unroll
        for (int j = 0; j < 4; ++j) {
          const float v0 = __uint_as_float(vv[it][j] << 16), v1 = __uint_as_float(vv[it][j] & 0xffff0000u), g0 = __uint_as_float(gv[it][j] << 16), g1 = __uint_as_float(gv[it][j] & 0xffff0000u);
          w[j] = pk2(v0 * sigmoidf_(g0), v1 * sigmoidf_(g1));
        }
      }
      if (row < 63) *(LAS u32x4*)(U + row * USTR + ch * 16) = w;
    }
  }
  __syncthreads();
  const int half = tid >> 8, cp = tid & 255;
  float a0[16], a1[16];
  {
    const f32x2 bias = *(const f32x2*)(p.dw_b + 2 * cp);
#pragma unroll
    for (int o = 0; o < 16; ++o) { a0[o] = bias.x; a1[o] = bias.y; }
#pragma unroll
    for (int og = 0; og < 2; ++og) {
      const LAS unsigned char* ub = U + (half * 16 + og * 8) * USTR + cp * 4;
#pragma unroll 1
      for (int w4 = 0; w4 < 8; ++w4) {
        const f32x4 wa = *(const LAS f32x4*)(Wp + (w4 * 256 + cp) * 8), wb = *(const LAS f32x4*)(Wp + (w4 * 256 + cp) * 8 + 4);
        const float wt0[4] = {wa[0], wa[2], wb[0], wb[2]}, wt1[4] = {wa[1], wa[3], wb[1], wb[3]};
        float u0[11], u1[11];
#pragma unroll
        for (int r = 0; r < 11; ++r) { const unsigned uu = *(const LAS unsigned*)(ub + (w4 * 4 + r) * USTR); u0[r] = __uint_as_float(uu << 16); u1[r] = __uint_as_float(uu & 0xffff0000u); }
#pragma unroll
        for (int o = 0; o < 8; ++o)
#pragma unroll
          for (int k = 0; k < 4; ++k) { a0[og * 8 + o] += u0[o + k] * wt0[k]; a1[og * 8 + o] += u1[o + k] * wt1[k]; }
      }
    }
  }
  __syncthreads();
#pragma unroll
  for (int o = 0; o < 16; ++o) *(LAS f32x2*)(Y + (half * 16 + o) * YSTR + 2 * cp) = (f32x2){a0[o], a1[o]};
  __syncthreads();
  {
    const f32x4 g0 = *(const f32x4*)(p.cln_g + lane * 8), g1 = *(const f32x4*)(p.cln_g + lane * 8 + 4), b0 = *(const f32x4*)(p.cln_b + lane * 8), b1 = *(const f32x4*)(p.cln_b + lane * 8 + 4);
#pragma unroll
    for (int i = 0; i < 4; ++i) {
      const int tok = wid * 4 + i;
      const f32x4 y0 = *(const LAS f32x4*)(Y + tok * YSTR + lane * 8), y1 = *(const LAS f32x4*)(Y + tok * YSTR + lane * 8 + 4);
      float s = (y0[0] + y0[1]) + (y0[2] + y0[3]) + (y1[0] + y1[1]) + (y1[2] + y1[3]);
      s = wave_sum(s);
      const float mu = s * (1.0f / 512.0f);
      const f32x4 d0 = y0 - mu, d1 = y1 - mu;
      float q = (d0[0] * d0[0] + d0[1] * d0[1]) + (d0[2] * d0[2] + d0[3] * d0[3]) + (d1[0] * d1[0] + d1[1] * d1[1]) + (d1[2] * d1[2] + d1[3] * d1[3]);
      q = wave_sum(q);
      const float rstd = __builtin_amdgcn_rsqf(q * (1.0f / 512.0f) + EPSN);
      f32x4 o0 = d0 * rstd * g0 + b0, o1 = d1 * rstd * g1 + b1;
#pragma unroll
      for (int j = 0; j < 4; ++j) { o0[j] = o0[j] * sigmoidf_(o0[j]); o1[j] = o1[j] * sigmoidf_(o1[j]); }
      u32x4 w; w.x = pk2(o0[0], o0[1]); w.y = pk2(o0[2], o0[3]); w.z = pk2(o1[0], o1[1]); w.w = pk2(o1[2], o1[3]);
      *(u32x4*)(cat + ((size_t)b * 4096 + t0 + tok) * 1024 + lane * 8) = w;
    }
  }
  __syncthreads();
}

constexpr int KVSTR = 144;
constexpr int VSTR = 144;
constexpr int A_GRP = 4 * 64 * KVSTR;
constexpr int A_KOFF = 0, A_VOFF = 2 * 64 * KVSTR;
constexpr int A_SLAB = 2 * A_GRP;
constexpr int SLAB_FLOATS = 32 * 65;
constexpr int A_SEL = A_SLAB + 8 * SLAB_FLOATS * 4;
constexpr int A_OR = A_SEL + 512;
constexpr int A_CNT = A_OR + 16;
constexpr int A_NXT = A_CNT + 32;
constexpr int A_LINV = A_NXT + 32;
static_assert(A_LINV + 1024 <= LDS_BYTES - 16, "attention LDS map");

DI void group_sync(LAS unsigned* cnt, unsigned& tgt, int lane) {
  tgt += 4u;
  __builtin_amdgcn_fence(__ATOMIC_RELEASE, "workgroup");
  if (lane == 0) __hip_atomic_fetch_add(cnt, 1u, __ATOMIC_RELAXED, __HIP_MEMORY_SCOPE_WORKGROUP);
  while ((int)(__hip_atomic_load(cnt, __ATOMIC_RELAXED, __HIP_MEMORY_SCOPE_WORKGROUP) - tgt) < 0) __builtin_amdgcn_s_sleep(0);
  __builtin_amdgcn_fence(__ATOMIC_ACQUIRE, "workgroup");
}

constexpr float ATT_THR = 8.0f;
template <int KIND, bool MASKED>
DI void attn_scores(LAS unsigned char* kbuf, int jc, const bf16x8 (&qf)[4], float slope2, float sc, int tq, int jt, unsigned long long mymask, float mref, f32x16 (&S)[2], int q, int h) {
  float base2; int kmin = -1, kmax = 64;
  if (KIND <= 1) {
    const int lim = 64 * jt + tq - 31 - 1024 * jc - 64 * h;
    base2 = -slope2 * (float)lim - mref; kmax = lim >> 4;
  } else {
    base2 = slope2 * (float)(64 * (jc - jt) + 4 * h - tq) - mref;
    if (MASKED && jc == jt) kmax = tq - 4 * h;
    if (MASKED && KIND == 3 && jc == jt - 8) kmin = tq - 4 * h;
    if (KIND == 2) base2 = ((mymask >> jc) & 1ull) ? base2 : -1e30f;
  }
#pragma unroll
  for (int kb = 0; kb < 2; ++kb) {
#pragma unroll
    for (int i = 0; i < 16; ++i) S[kb][i] = __builtin_fmaf(sc, (float)(32 * kb + 8 * (i >> 2) + (i & 3)), base2);
#pragma unroll
    for (int ks = 0; ks < 4; ++ks) {
      const bf16x8 kf = *(const LAS bf16x8*)(kbuf + (32 * kb + q) * KVSTR + 32 * ks + 16 * h);
      S[kb] = __builtin_amdgcn_mfma_f32_32x32x16_bf16(kf, qf[ks], S[kb], 0, 0, 0);
    }
  }
  if (MASKED) {
    const unsigned range = (unsigned)(kmax - kmin);
#pragma unroll
    for (int kb = 0; kb < 2; ++kb)
#pragma unroll
      for (int i = 0; i < 16; ++i) {
        const int keyc = 32 * kb + 8 * (i >> 2) + (i & 3);
        const bool ok = (kmax > kmin) && ((unsigned)(keyc - kmin - 1) < range);
        S[kb][i] = ok ? S[kb][i] : -INFINITY;
      }
  }
}
DI float attn_exp_sum(f32x16 (&S)[2]) {
  float ps = 0.f;
#pragma unroll
  for (int kb = 0; kb < 2; ++kb)
#pragma unroll
    for (int i = 0; i < 16; ++i) { const float pv = __builtin_amdgcn_exp2f(S[kb][i]); S[kb][i] = pv; ps += pv; asm volatile("" : "+v"(ps)); }
  return ps;
}
constexpr float ATT_SUM_CAP = 16777216.0f;
template <int KIND, bool MASKED>
DI void attn_tile(LAS unsigned char* kbuf, LAS unsigned char* vbuf, int jc, const bf16x8 (&qf)[4], float slope2, float sc, int tq, int jt, unsigned long long mymask,
                  float& m_run, float& l_run, float l2inv, f32x16 (&O)[2], LAS float* slab, int q, int h, int q4, int p4, int g1) {
  f32x16 S[2];
  attn_scores<KIND, MASKED>(kbuf, jc, qf, slope2, sc, tq, jt, mymask, m_run, S, q, h);
  {
    float ps = attn_exp_sum(S);
    if (__any(!(ps < ATT_SUM_CAP))) {
      asm volatile("s_nop 0" ::: "memory");
      attn_scores<KIND, MASKED>(kbuf, jc, qf, slope2, sc, tq, jt, mymask, m_run, S, q, h);
      float mx = fmaxf(S[0][0], S[1][0]);
#pragma unroll
      for (int i = 1; i < 16; ++i) mx = fmaxf(fmaxf(mx, S[0][i]), S[1][i]);
      mx = fmaxf(mx, __shfl_xor(mx, 32));
      const float d = fmaxf(mx, 0.f), alpha = __builtin_amdgcn_exp2f(-d);
      m_run += d; l_run *= alpha;
#pragma unroll
      for (int kb = 0; kb < 2; ++kb)
#pragma unroll
        for (int i = 0; i < 16; ++i) S[kb][i] -= d;
      if (KIND != 0) {
#pragma unroll
        for (int db = 0; db < 2; ++db)
#pragma unroll
          for (int i = 0; i < 16; ++i) O[db][i] *= alpha;
      }
      if (KIND == 1) { for (int jj = h; jj < 65; jj += 2) slab[q * 65 + jj] *= alpha; }
      ps = attn_exp_sum(S);
    }
    l_run += ps;
  }
  if (KIND == 1) {
    float s4[8], rx[8];
#pragma unroll
    for (int kb = 0; kb < 2; ++kb)
#pragma unroll
      for (int gi = 0; gi < 4; ++gi) {
        float t4 = S[kb][4 * gi] + S[kb][4 * gi + 1]; asm volatile("" : "+v"(t4)); t4 += S[kb][4 * gi + 2]; asm volatile("" : "+v"(t4)); t4 += S[kb][4 * gi + 3];
        s4[4 * kb + gi] = t4; rx[4 * kb + gi] = __shfl_xor(S[kb][4 * gi + 3], 32);
      }
    LAS float* rowp = slab + q * 65 + 16 * jc + h;
    float old[9], val[9];
#pragma unroll
    for (int m = 0; m < 9; ++m) {
      const float own = (m < 8) ? s4[m < 8 ? m : 7] : 0.f;
      const float a1 = (m < 8) ? rx[m < 8 ? m : 7] : 0.f;
      const float a0 = (m > 0) ? rx[m > 0 ? m - 1 : 0] : 0.f;
      val[m] = own + (h ? a1 : a0);
    }
#pragma unroll
    for (int m = 0; m < 9; ++m) old[m] = (m < 8 || h == 0) ? rowp[2 * m] : 0.f;
#pragma unroll
    for (int m = 0; m < 9; ++m) if (m < 8 || h == 0) rowp[2 * m] = old[m] + val[m];
  }
  if (KIND != 0) {
#pragma unroll
    for (int kb = 0; kb < 2; ++kb)
#pragma unroll
      for (int s = 0; s < 2; ++s) {
        u32x4 pw;
        pw.x = pk2(S[kb][8 * s + 0], S[kb][8 * s + 1]); pw.y = pk2(S[kb][8 * s + 2], S[kb][8 * s + 3]);
        pw.z = pk2(S[kb][8 * s + 4], S[kb][8 * s + 5]); pw.w = pk2(S[kb][8 * s + 6], S[kb][8 * s + 7]);
        const bf16x8 pf = __builtin_bit_cast(bf16x8, pw);
#pragma unroll
        for (int db = 0; db < 2; ++db) {
          LAS unsigned char* va = vbuf + (32 * kb + 16 * s + 4 * h + q4) * VSTR + (32 * db + 16 * g1) * 2 + 8 * p4;
          const s16x4 lo = __builtin_amdgcn_ds_read_tr16_b64_v4i16((LAS s16x4*)va);
          const s16x4 hi = __builtin_amdgcn_ds_read_tr16_b64_v4i16((LAS s16x4*)(va + 8 * VSTR));
          const bf16x8 vf = __builtin_shufflevector(lo, hi, 0, 1, 2, 3, 4, 5, 6, 7);
          O[db] = __builtin_amdgcn_mfma_f32_32x32x16_bf16(vf, pf, O[db], 0, 0, 0);
        }
      }
  }
}

template <int KIND>
DI void attn_branch(LAS unsigned char* gl, LAS unsigned* cnt, unsigned& tgt, const bf16_t* Kg, const bf16_t* Vg, unsigned long long tmask, const bf16x8 (&qf)[4], float slope2, int tq, int jt,
                    unsigned long long mymask, float& m_run, float& l_run, float invl, f32x16 (&O)[2], LAS float* slab) {
  const int gt = get_tid() & 255, lane = gt & 63, q = lane & 31, h = lane >> 5;
  const int i16 = lane & 15, q4 = i16 >> 2, p4 = i16 & 3, g1 = (lane >> 4) & 1;
  const float sc = (KIND <= 1) ? slope2 * 16.0f : slope2;
  const int woff = (gt >> 3) * KVSTR + (gt & 7) * 16;
  int j = __builtin_ctzll(tmask); tmask &= tmask - 1;
  const u32x4 z4 = (u32x4){0u, 0u, 0u, 0u};
  u32x4 ka = *(const u32x4*)(Kg + (size_t)j * 4096 + gt * 8), kb = *(const u32x4*)(Kg + (size_t)j * 4096 + 2048 + gt * 8), va = z4, vb = z4;
  if (KIND != 0) { va = *(const u32x4*)(Vg + (size_t)j * 4096 + gt * 8); vb = *(const u32x4*)(Vg + (size_t)j * 4096 + 2048 + gt * 8); }
  int buf = 0;
  for (;;) {
    LAS unsigned char* kbuf = gl + A_KOFF + buf * (64 * KVSTR); LAS unsigned char* vbuf = gl + A_VOFF + buf * (64 * VSTR);
    *(LAS u32x4*)(kbuf + woff) = ka; *(LAS u32x4*)(kbuf + 32 * KVSTR + woff) = kb;
    if (KIND != 0) { *(LAS u32x4*)(vbuf + woff) = va; *(LAS u32x4*)(vbuf + 32 * VSTR + woff) = vb; }
    group_sync(cnt, tgt, lane);
    const int jc = j;
    const bool more = (tmask != 0ull);
    if (more) {
      j = __builtin_ctzll(tmask); tmask &= tmask - 1;
      ka = *(const u32x4*)(Kg + (size_t)j * 4096 + gt * 8); kb = *(const u32x4*)(Kg + (size_t)j * 4096 + 2048 + gt * 8);
      if (KIND != 0) { va = *(const u32x4*)(Vg + (size_t)j * 4096 + gt * 8); vb = *(const u32x4*)(Vg + (size_t)j * 4096 + 2048 + gt * 8); }
    }
    if (KIND <= 1 || jc == jt || (KIND == 3 && jc == jt - 8)) attn_tile<KIND, true>(kbuf, vbuf, jc, qf, slope2, sc, tq, jt, mymask, m_run, l_run, invl, O, slab, q, h, q4, p4, g1);
    else attn_tile<KIND, (KIND <= 1)>(kbuf, vbuf, jc, qf, slope2, sc, tq, jt, mymask, m_run, l_run, invl, O, slab, q, h, q4, p4, g1);
    buf ^= 1;
    if (!more) break;
  }
  group_sync(cnt, tgt, lane);
}

DI int queue_pop(unsigned* qbase, unsigned xcc) {
  for (unsigned qq = 0; qq < 8u; ++qq) {
    const unsigned x2 = (xcc + qq) & 7u;
    const unsigned i = __hip_atomic_fetch_add(qbase + 64 * x2, 1u, __ATOMIC_RELAXED, __HIP_MEMORY_SCOPE_AGENT);
    if (i < 256u) return (int)(x2 * 256u + i);
  }
  return -1;
}
DI void attn_item(const Params& p, LAS unsigned char* lds, int grp, unsigned& tgt, int enc, int& nenc, unsigned xcc) {
  const int gt = get_tid() & 255, lane = gt & 63, hh = __builtin_amdgcn_readfirstlane(gt >> 6), q = lane & 31, h = lane >> 5;
  const int bg = 2 * (enc >> 8) + (enc & 1), jt32 = 127 - ((enc & 255) >> 1);
  int popv = -1;
  if (gt == 0) popv = queue_pop((unsigned*)(p.ws + OFF_QCNT), xcc);
  const int b = bg >> 1, g = bg & 1, head = g * 4 + hh, jt = jt32 >> 1, tq = (jt32 & 1) * 32 + q, t = jt * 64 + tq;
  const size_t mrow = (size_t)b * 4096 + t;
  const bf16_t* Qp = (const bf16_t*)(p.ws + OFF_Q);
  const bf16_t* KV = (const bf16_t*)(p.ws + OFF_KV);
  const float* gates = (const float*)(p.ws + OFF_GATES);
  bf16_t* cat = (bf16_t*)(p.ws + OFF_CAT);
  float* osc = (float*)(p.ws + OFF_B) + mrow * 512 + head * 64 + 4 * h;
  LAS unsigned char* gl = lds + grp * A_GRP;
  LAS float* slab = (LAS float*)(lds + A_SLAB) + (grp * 4 + hh) * SLAB_FLOATS;
  LAS unsigned long long* selm = (LAS unsigned long long*)(lds + A_SEL) + grp * 32;
  LAS unsigned long long* orm = (LAS unsigned long long*)(lds + A_OR) + grp;
  LAS unsigned* cnt = (LAS unsigned*)(lds + A_CNT + 16 * grp);
  for (int i = lane; i < SLAB_FLOATS; i += 64) slab[i] = 0.f;
  if (gt == 0) *orm = 0ull;
  bf16x8 qf[4];
#pragma unroll
  for (int ks = 0; ks < 4; ++ks) qf[ks] = *(const bf16x8*)(Qp + mrow * 512 + head * 64 + 16 * ks + 8 * h);
  const float slope2 = __builtin_amdgcn_exp2f(-(float)(head + 1)) * LOG2E;
  const float g_cmp = gates[mrow * 24 + head * 3 + 0], g_sel = gates[mrow * 24 + head * 3 + 1], g_win = gates[mrow * 24 + head * 3 + 2];
  const size_t bgoff = (size_t)bg * 4096 * 64;
  const bf16_t* Ksel = KV + (size_t)2 * 16 * 4096 * 64 + bgoff; const bf16_t* Vsel = KV + (size_t)3 * 16 * 4096 * 64 + bgoff;
  const bf16_t* Kwin = KV + (size_t)4 * 16 * 4096 * 64 + bgoff; const bf16_t* Vwin = KV + (size_t)5 * 16 * 4096 * 64 + bgoff;
  const bf16_t* Kc = (const bf16_t*)(p.ws + OFF_KC) + (size_t)bg * 256 * 64; const bf16_t* Vc = (const bf16_t*)(p.ws + OFF_VC) + (size_t)bg * 256 * 64;
  f32x16 O[2];
#pragma unroll
  for (int db = 0; db < 2; ++db)
#pragma unroll
    for (int i = 0; i < 16; ++i) O[db][i] = 0.f;
  {
    const int ncmp = 4 * jt + 2 * (jt32 & 1) + 1, ntile = (ncmp + 63) >> 6;
    const unsigned long long cm = (1ull << ntile) - 1ull;
    float m_run = 0.f, l_run = 0.f;
    attn_branch<1>(gl, cnt, tgt, Kc, Vc, cm, qf, slope2, tq, jt, 0ull, m_run, l_run, 0.f, O, slab);
    const float lt = l_run + __shfl_xor(l_run, 32);
    const float invl = lt > 0.f ? __builtin_amdgcn_rcpf(lt) : 0.f;
    if (h == 0) ((LAS float*)(lds + A_LINV))[(grp * 4 + hh) * 32 + q] = invl;
    const float gsc = g_cmp * invl;
#pragma unroll
    for (int db = 0; db < 2; ++db)
#pragma unroll
      for (int gi = 0; gi < 4; ++gi) {
        *(f32x4*)(osc + 32 * db + 8 * gi) = (f32x4){O[db][4 * gi], O[db][4 * gi + 1], O[db][4 * gi + 2], O[db][4 * gi + 3]} * gsc;
        O[db][4 * gi] = 0.f; O[db][4 * gi + 1] = 0.f; O[db][4 * gi + 2] = 0.f; O[db][4 * gi + 3] = 0.f;
      }
  }
  group_sync(cnt, tgt, lane);
  {
    const LAS float* slabs = (const LAS float*)(lds + A_SLAB) + grp * 4 * SLAB_FLOATS;
    unsigned long long worm = 0ull;
    unsigned key[8], prefix[8];
#pragma unroll
    for (int tt = 0; tt < 8; ++tt) {
      const int tok = hh * 8 + tt;
      float v = 0.f;
#pragma unroll
      for (int h2 = 0; h2 < 4; ++h2) v += slabs[h2 * SLAB_FLOATS + tok * 65 + lane] * ((const LAS float*)(lds + A_LINV))[(grp * 4 + h2) * 32 + tok];
      if (lane == 0 || lane == jt || lane == jt - 1) v = 1e30f; else if (lane > jt) v = -1e30f;
      unsigned k = __float_as_uint(v); k = (k & 0x80000000u) ? ~k : (k | 0x80000000u);
      key[tt] = k; prefix[tt] = 0u;
    }
#pragma unroll
    for (int bit = 31; bit >= 0; --bit)
#pragma unroll
      for (int tt = 0; tt < 8; ++tt) {
        const unsigned cand = prefix[tt] | (1u << bit);
        const unsigned long long mge = __ballot(key[tt] >= cand);
        prefix[tt] = (__popcll(mge) >= 16) ? cand : prefix[tt];
      }
#pragma unroll
    for (int tt = 0; tt < 8; ++tt) {
      const unsigned long long mgt = __ballot(key[tt] > prefix[tt]), meq = __ballot(key[tt] == prefix[tt]);
      const int need = 16 - __popcll(mgt);
      const int rank_eq = __popcll(meq & ((1ull << lane) - 1ull));
      const unsigned long long msk = mgt | __ballot((key[tt] == prefix[tt]) && (rank_eq < need));
      if (lane == 0) selm[hh * 8 + tt] = msk;
      worm |= msk;
    }
    if (lane == 0) atomicOr((unsigned long long*)orm, worm);
  }
  if (gt == 0) *(LAS int*)(lds + A_NXT + 16 * grp) = popv;
  group_sync(cnt, tgt, lane);
  nenc = *(const LAS int*)(lds + A_NXT + 16 * grp);
  const unsigned long long mymask = selm[q];
  const unsigned long long ormask = *orm;
  const unsigned long long causal = (jt >= 63) ? ~0ull : ((2ull << jt) - 1ull);
  const int jlo = jt >= 8 ? jt - 8 : 0;
  {
    float m_run = 0.f, l_run = 0.f;
    attn_branch<2>(gl, cnt, tgt, Ksel, Vsel, ormask & causal, qf, slope2, tq, jt, mymask, m_run, l_run, 0.f, O, slab);
    const float lt = l_run + __shfl_xor(l_run, 32);
    const float sc = lt > 0.f ? g_sel / lt : 0.f;
#pragma unroll
    for (int db = 0; db < 2; ++db)
#pragma unroll
      for (int gi = 0; gi < 4; ++gi) {
        const f32x4 pv = *(const f32x4*)(osc + 32 * db + 8 * gi);
        *(f32x4*)(osc + 32 * db + 8 * gi) = pv + (f32x4){O[db][4 * gi], O[db][4 * gi + 1], O[db][4 * gi + 2], O[db][4 * gi + 3]} * sc;
        O[db][4 * gi] = 0.f; O[db][4 * gi + 1] = 0.f; O[db][4 * gi + 2] = 0.f; O[db][4 * gi + 3] = 0.f;
      }
  }
  {
    const unsigned long long wm = causal & ~((1ull << jlo) - 1ull);
    float m_run = 0.f, l_run = 0.f;
    attn_branch<3>(gl, cnt, tgt, Kwin, Vwin, wm, qf, slope2, tq, jt, 0ull, m_run, l_run, 0.f, O, slab);
    const float lt = l_run + __shfl_xor(l_run, 32);
    const float sc = lt > 0.f ? g_win / lt : 0.f;
#pragma unroll
    for (int db = 0; db < 2; ++db)
#pragma unroll
      for (int gi = 0; gi < 4; ++gi) {
        const f32x4 v = *(const f32x4*)(osc + 32 * db + 8 * gi) + (f32x4){O[db][4 * gi], O[db][4 * gi + 1], O[db][4 * gi + 2], O[db][4 * gi + 3]} * sc;
        u32x2 w; w.x = pk2(v[0], v[1]); w.y = pk2(v[2], v[3]);
        *(u32x2*)(cat + mrow * 1024 + 512 + head * 64 + 32 * db + 8 * gi + 4 * h) = w;
      }
  }
}

__global__ void __launch_bounds__(512, 2) fwd_megakernel(Params p) {
  extern __shared__ __attribute__((aligned(16))) unsigned char smem[];
  LAS unsigned char* lds = (LAS unsigned char*)smem;
  cg::grid_group grid = cg::this_grid();
  const int G = gridDim.x, bx = blockIdx.x;
  unsigned char* ws = p.ws;
  if (p.ws == nullptr) grid.sync();
  volatile LAS unsigned* bst = (volatile LAS unsigned*)(lds + LDS_BYTES - 16);
  if (threadIdx.x == 0) { bst[0] = 0u; bst[1] = 0u; }
  __syncthreads();
  const XcdBarrier gbar = xcd_barrier_post((unsigned*)(ws + OFF_BAR), bst);

  p0_prologue(p, lds);
  xcd_barrier(gbar);

  {
    pg8::Gemm g{(const bf16_t*)(ws + OFF_XB), (const bf16_t*)(ws + OFF_WIN), 1024, 1024, 1024, (size_t)256 * 1024 * 2, (size_t)256 * 1024 * 2, 128, 128};
    pg8::StaticOrder S; S.init(MTOK, 2560, G, bx);
    Epi1 E{(const float*)(ws + OFF_RS1), (bf16_t*)(ws + OFF_B), (bf16_t*)(ws + OFF_Q), (bf16_t*)(ws + OFF_KV), (float*)(ws + OFF_GATES)};
    pg8::gemm_phase<Epi1, pg8::StaticOrder, true, true>(lds, g, S, E);
  }
  xcd_barrier(gbar);

  {
    const int ncmp = (G > 64) ? 32 : 0;
    if (bx < ncmp) {
      const int kv = bx >> 4, pm = bx & 15;
      pg8::Gemm g{(const bf16_t*)(ws + OFF_KV) + (size_t)kv * 16 * 4096 * 64, (const bf16_t*)(ws + OFF_CW1) + (size_t)kv * 256 * 2048, 1024, 2048, 2048, (size_t)4096 * 64 * 2, 0, 128, 128};
      pg8::SingleUnit S{pm, 0};
      EpiCmp E{(const float*)(ws + OFF_CB1) + kv * 256, (const bf16_t*)(ws + OFF_CW2) + kv * 64 * 256, (bf16_t*)(ws + (kv ? OFF_VC : OFF_KC))};
      pg8::gemm_phase<EpiCmp, pg8::SingleUnit, false, true>(lds, g, S, E);
    } else {
      conv_load_taps(p, lds);
      for (int tile = bx - ncmp; tile < 1024; tile += G - ncmp) conv_tile(p, lds, tile);
    }
    if (ncmp == 0) {
      for (int un = bx; un < 32; un += G) {
        const int kv = un >> 4, pm = un & 15;
        pg8::Gemm g{(const bf16_t*)(ws + OFF_KV) + (size_t)kv * 16 * 4096 * 64, (const bf16_t*)(ws + OFF_CW1) + (size_t)kv * 256 * 2048, 1024, 2048, 2048, (size_t)4096 * 64 * 2, 0, 128, 128};
        pg8::SingleUnit S{pm, 0};
        EpiCmp E{(const float*)(ws + OFF_CB1) + kv * 256, (const bf16_t*)(ws + OFF_CW2) + kv * 64 * 256, (bf16_t*)(ws + (kv ? OFF_VC : OFF_KC))};
        pg8::gemm_phase<EpiCmp, pg8::SingleUnit, false, true>(lds, g, S, E);
      }
    }
  }
  xcd_barrier(gbar);

  {
    const int tid3 = get_tid(), grp = __builtin_amdgcn_readfirstlane(tid3 >> 8);
    if (tid3 < 2) *(LAS unsigned*)(lds + A_CNT + 16 * tid3) = 0u;
    __syncthreads();
    unsigned tgt = 0u;
    const int gt3 = tid3 & 255, lane3 = tid3 & 63;
    const unsigned xcc = xb_xcc_id();
    LAS unsigned* cnt3 = (LAS unsigned*)(lds + A_CNT + 16 * grp);
    if (gt3 == 0) *(LAS int*)(lds + A_NXT + 16 * grp) = queue_pop((unsigned*)(ws + OFF_QCNT), xcc);
    group_sync(cnt3, tgt, lane3);
    int enc = *(const LAS int*)(lds + A_NXT + 16 * grp);
    group_sync(cnt3, tgt, lane3);
    while (enc >= 0) { int nenc = -1; attn_item(p, lds, grp, tgt, enc, nenc, xcc); enc = nenc; }
  }
  xcd_barrier(gbar);

  {
    pg8::Gemm g{(const bf16_t*)(ws + OFF_CAT), (const bf16_t*)(ws + OFF_WOUT), 1024, 1024, 1024, (size_t)256 * 1024 * 2, (size_t)256 * 1024 * 2, 128, 128};
    pg8::StaticOrder S; S.init(MTOK, 1024, G, bx);
    EpiRes<false, true> E{(const bf16_t*)(ws + OFF_XB), p.out, (bf16_t*)(ws + OFF_B), (float*)(ws + OFF_SSQ2)};
    pg8::gemm_phase<EpiRes<false, true>, pg8::StaticOrder, true, true>(lds, g, S, E);
  }
  xcd_barrier(gbar);

  {
    pg8::Gemm g{(const bf16_t*)(ws + OFF_B), (const bf16_t*)(ws + OFF_WFF1), 1024, 1024, 1024, (size_t)256 * 1024 * 2, (size_t)256 * 1024 * 2, 128, 128};
    pg8::StaticOrder S; S.init(MTOK, 4096, G, bx);
    EpiFF1 E{(const float*)(ws + OFF_SSQ2), (bf16_t*)(ws + OFF_H)};
    pg8::gemm_phase<EpiFF1, pg8::StaticOrder, false, true>(lds, g, S, E);
  }
  xcd_barrier(gbar);

  const int fuse_final = (G == 256) ? 1 : 0;
  {
    pg8::Gemm g{(const bf16_t*)(ws + OFF_H), (const bf16_t*)(ws + OFF_WFF2P), 64, 64, 4096, (size_t)2 * MiB, (size_t)2 * MiB, 32768, 32768};
    pg8::StaticOrder S; S.init(MTOK, 1024, G, bx);
    EpiFinal E{(const bf16_t*)(ws + OFF_B), p.out, (float*)(ws + OFF_SSQ3), (unsigned*)(ws + OFF_PCNT), p.norm_f_g, fuse_final};
    pg8::gemm_phase<EpiFinal, pg8::StaticOrder, true, true>(lds, g, S, E);
  }
  if (!fuse_final) {
    xcd_barrier(gbar);
    const int tid = get_tid(), lane = tid & 63, wid = tid >> 6;
    const float* ssq = (const float*)(ws + OFF_SSQ3);
    f32x4 gn[4];
#pragma unroll
    for (int i = 0; i < 4; ++i) gn[i] = *(const f32x4*)(p.norm_f_g + (lane + 64 * i) * 4);
    for (int r = bx * 8 + wid; r < MTOK; r += G * 8) {
      const float s = __builtin_amdgcn_rsqf(ssq[r] * (1.0f / 1024.0f) + EPSN);
      float* row = p.out + (size_t)r * 1024;
#pragma unroll
      for (int i = 0; i < 4; ++i) { f32x4 v = *(const f32x4*)(row + (lane + 64 * i) * 4); v = v * s * gn[i]; *(f32x4*)(row + (lane + 64 * i) * 4) = v; }
    }
  }
}

extern "C" void kernel_launch(void* const* d_in, const int* in_sizes, int n_in, void* d_out, int out_size, void* d_ws, size_t ws_size, hipStream_t stream) {
  constexpr size_t kDynLds = LDS_BYTES;
  static int grid_blocks = 0;
  if (!grid_blocks) {
    int dev = 0, cus = 0, per_cu = 0;
    (void)hipGetDevice(&dev);
    (void)hipDeviceGetAttribute(&cus, hipDeviceAttributeMultiprocessorCount, dev);
    (void)hipFuncSetAttribute((const void*)fwd_megakernel, hipFuncAttributeMaxDynamicSharedMemorySize, (int)kDynLds);
    (void)hipOccupancyMaxActiveBlocksPerMultiprocessor(&per_cu, (const void*)fwd_megakernel, 512, kDynLds);
    if (per_cu < 1) fprintf(stderr, "kernel_launch: occupancy query says %d blocks per CU\n", per_cu);
    grid_blocks = cus > 0 ? cus : 256;
    if (ws_size < WS_END) fprintf(stderr, "kernel_launch: workspace too small: %zu < %zu\n", ws_size, (size_t)WS_END);
  }
  (void)hipMemsetAsync((unsigned char*)d_ws + OFF_BAR, 0, XCD_BAR_WORDS * 4 + 256 * 256 + 8 * 256, stream);
  Params p{};
  p.x = (const float*)d_in[0]; p.norm1_g = (const float*)d_in[1]; p.w_in = (const float*)d_in[2]; p.dw_w = (const float*)d_in[3]; p.dw_b = (const float*)d_in[4];
  p.cln_g = (const float*)d_in[5]; p.cln_b = (const float*)d_in[6]; p.ck_pe = (const float*)d_in[7]; p.ck_w1 = (const float*)d_in[8]; p.ck_w2 = (const float*)d_in[9];
  p.cv_pe = (const float*)d_in[10]; p.cv_w1 = (const float*)d_in[11]; p.cv_w2 = (const float*)d_in[12]; p.w_out = (const float*)d_in[13]; p.norm2_g = (const float*)d_in[14];
  p.w_ff1 = (const float*)d_in[15]; p.w_ff2 = (const float*)d_in[16]; p.norm_f_g = (const float*)d_in[17];
  p.out = (float*)d_out; p.ws = (unsigned char*)d_ws;
  void* args[] = {&p};
  hipError_t e = hipLaunchCooperativeKernel((const void*)fwd_megakernel, dim3(grid_blocks), dim3(512), args, kDynLds, stream);
  if (e != hipSuccess) fprintf(stderr, "cooperative launch failed: %s (grid %d)\n", hipGetErrorString(e), grid_blocks);
}
```
